# Optimizing an MI355X kernel written in HIP

```python
import math
import jax, jax.numpy as jnp
from jax import lax
import numpy as np

D_MODEL = 4096
BATCH = 4
SEQ = 4096
DEPTH = 4

D_FF = 6144
MLA_HEADS = 16
Q_LORA = 896
KV_LORA = 512
QK_NOPE = 128
QK_ROPE = 64
V_HEAD = 128
MLA_WIDTH = MLA_HEADS * V_HEAD
ATTN_BLOCK = 128
ROPE_THETA = 10000.0
SSD_HEAD_DIM = 64
SSD_HEADS = 32
SSD_GROUPS = 8
SSD_STATE = 128
SSD_CONV = 4
SSD_CHUNK = 128
SSD_WIDTH = SSD_HEADS * SSD_HEAD_DIM
SSD_CONV_DIM = SSD_WIDTH + 2 * SSD_GROUPS * SSD_STATE
MIX_WIDTH = MLA_WIDTH + SSD_WIDTH
IN_COLS = Q_LORA + KV_LORA + QK_ROPE + SSD_WIDTH + SSD_CONV_DIM + SSD_HEADS
EPS = 1e-6

kernel_name = "hybrid_mla_ssd_macaron_trunk"


def rms_norm(x, g):
    xf = x.astype(jnp.float32)
    y = xf * lax.rsqrt(jnp.mean(xf * xf, axis=-1, keepdims=True) + EPS)
    return (y * g.astype(jnp.float32)).astype(x.dtype)


def swiglu(h, w_gate, w_up, w_down):
    return (jax.nn.silu(h @ w_gate) * (h @ w_up)) @ w_down


def rope_tables(positions):
    inv_freq = ROPE_THETA ** (-jnp.arange(0, QK_ROPE, 2, dtype=jnp.float32) / QK_ROPE)
    ang = positions.astype(jnp.float32)[..., None] * inv_freq
    return jnp.cos(ang), jnp.sin(ang)


def apply_rope(x, cos, sin):
    half = x.shape[-1] // 2
    xf = x.astype(jnp.float32)
    x1, x2 = xf[..., :half], xf[..., half:]
    return jnp.concatenate([x1 * cos - x2 * sin, x2 * cos + x1 * sin], axis=-1).astype(x.dtype)


def mla_group(c_q, c_kv, k_pe, positions, q_a_norm, w_q_up, kv_a_norm, w_kv_up):
    b, s, _ = c_q.shape
    q = (rms_norm(c_q, q_a_norm) @ w_q_up).reshape(b, s, MLA_HEADS, QK_NOPE + QK_ROPE)
    kv = (rms_norm(c_kv, kv_a_norm) @ w_kv_up).reshape(b, s, MLA_HEADS, QK_NOPE + V_HEAD)
    cos, sin = rope_tables(positions)
    q_pe = apply_rope(q[..., QK_NOPE:], cos[:, :, None], sin[:, :, None])
    k_pe = apply_rope(k_pe, cos, sin)
    q = jnp.concatenate([q[..., :QK_NOPE], q_pe], axis=-1)
    k = jnp.concatenate([kv[..., :QK_NOPE], jnp.broadcast_to(k_pe[:, :, None], (b, s, MLA_HEADS, QK_ROPE))], axis=-1)
    v = kv[..., QK_NOPE:]
    scale = (QK_NOPE + QK_ROPE) ** -0.5
    outs = []
    for blk in range(s // ATTN_BLOCK):
        q0, q1 = blk * ATTN_BLOCK, (blk + 1) * ATTN_BLOCK
        scores = jnp.einsum("bqhd,bkhd->bhqk", q[:, q0:q1], k[:, :q1]).astype(jnp.float32) * scale
        causal = jnp.arange(q0, q1)[:, None] >= jnp.arange(q1)[None, :]
        scores = jnp.where(causal, scores, -jnp.inf)
        p = jax.nn.softmax(scores, axis=-1).astype(v.dtype)
        outs.append(jnp.einsum("bhqk,bkhd->bqhd", p, v[:, :q1]))
    return jnp.concatenate(outs, axis=1).reshape(b, s, MLA_WIDTH)


def ssd_chunked_scan(x, dt, A, Bm, Cm):
    b, s, h, p = x.shape
    nc, L = s // SSD_CHUNK, SSD_CHUNK
    G, E = SSD_GROUPS, SSD_HEADS // SSD_GROUPS
    xdt = (x * dt[..., None]).reshape(b, nc, L, G, E, p)
    a = (dt * A).reshape(b, nc, L, G, E).transpose(0, 1, 3, 4, 2)
    Bc = Bm.reshape(b, nc, L, G, SSD_STATE)
    Cc = Cm.reshape(b, nc, L, G, SSD_STATE)
    a_cs = jnp.cumsum(a, axis=-1)
    tril = jnp.tril(jnp.ones((L, L), dtype=bool))
    decay = jnp.exp(jnp.where(tril, a_cs[..., :, None] - a_cs[..., None, :], -jnp.inf))
    cb = jnp.einsum("bclgn,bcsgn->bcgls", Cc, Bc)
    y_diag = jnp.einsum("bcgls,bcgels,bcsgep->bclgep", cb, decay, xdt)
    decay_to_end = jnp.exp(a_cs[..., -1:] - a_cs)
    chunk_states = jnp.einsum("bclgn,bcgel,bclgep->bcgepn", Bc, decay_to_end, xdt)
    chunk_decay = jnp.exp(a_cs[..., -1])

    def step(state, inp):
        dec, new = inp
        return dec[..., None, None] * state + new, state

    init = jnp.zeros((b, G, E, p, SSD_STATE), chunk_states.dtype)
    _, states_in = lax.scan(step, init, (jnp.moveaxis(chunk_decay, 1, 0), jnp.moveaxis(chunk_states, 1, 0)))
    states_in = jnp.moveaxis(states_in, 0, 1)
    y_off = jnp.einsum("bclgn,bcgepn,bcgel->bclgep", Cc, states_in, jnp.exp(a_cs))
    return (y_diag + y_off).reshape(b, s, h, p)


def ssd_group(z, xbc, dt, conv_w, conv_b, dt_bias, a_log, d_skip, ssd_norm):
    b, s, _ = xbc.shape
    xpad = jnp.pad(xbc, ((0, 0), (SSD_CONV - 1, 0), (0, 0)))
    conv = conv_b + sum(conv_w[k] * xpad[:, k:k + s] for k in range(SSD_CONV))
    xbc = jax.nn.silu(conv)
    xs = xbc[..., :SSD_WIDTH].reshape(b, s, SSD_HEADS, SSD_HEAD_DIM)
    Bm = xbc[..., SSD_WIDTH:SSD_WIDTH + SSD_GROUPS * SSD_STATE].reshape(b, s, SSD_GROUPS, SSD_STATE)
    Cm = xbc[..., SSD_WIDTH + SSD_GROUPS * SSD_STATE:].reshape(b, s, SSD_GROUPS, SSD_STATE)
    dt = jax.nn.softplus((dt + dt_bias).astype(jnp.float32))
    A = -jnp.exp(a_log.astype(jnp.float32))
    y = ssd_chunked_scan(xs, dt, A, Bm, Cm)
    y = (y + d_skip[:, None] * xs).reshape(b, s, SSD_WIDTH)
    yg = (y * jax.nn.silu(z)).reshape(b, s, SSD_GROUPS, SSD_WIDTH // SSD_GROUPS).astype(jnp.float32)
    yg = yg * lax.rsqrt(jnp.mean(yg * yg, axis=-1, keepdims=True) + EPS)
    return (yg.reshape(b, s, SSD_WIDTH) * ssd_norm).astype(z.dtype)


def hybrid_mixer(h, positions, w_in, q_a_norm, w_q_up, kv_a_norm, w_kv_up,
                 conv_w, conv_b, dt_bias, a_log, d_skip, ssd_norm, w_out):
    proj = h @ w_in
    o1 = Q_LORA
    o2 = o1 + KV_LORA
    o3 = o2 + QK_ROPE
    o4 = o3 + SSD_WIDTH
    o5 = o4 + SSD_CONV_DIM
    c_q, c_kv, k_pe = proj[..., :o1], proj[..., o1:o2], proj[..., o2:o3]
    z, xbc, dt = proj[..., o3:o4], proj[..., o4:o5], proj[..., o5:]
    y_attn = mla_group(c_q, c_kv, k_pe, positions, q_a_norm, w_q_up, kv_a_norm, w_kv_up)
    y_ssd = ssd_group(z, xbc, dt, conv_w, conv_b, dt_bias, a_log, d_skip, ssd_norm)
    return jnp.concatenate([y_attn, y_ssd], axis=-1) @ w_out


def setup_inputs(seed: int = 0) -> dict:
    key = jax.random.key(seed)
    ks = jax.random.split(key, 26)

    def nrm(k, shape, fan_in):
        return jax.random.normal(k, shape, jnp.float32) * (fan_in ** -0.5)

    def gain(k, shape):
        return 1.0 + 0.02 * jax.random.normal(k, shape, jnp.float32)

    L = DEPTH
    dt0 = jnp.exp(jax.random.uniform(ks[17], (L, SSD_HEADS), jnp.float32)
                  * (math.log(0.1) - math.log(0.001)) + math.log(0.001))
    return {
        "x": jax.random.normal(ks[0], (BATCH, SEQ, D_MODEL), jnp.float32),
        "positions": jnp.broadcast_to(jnp.arange(SEQ, dtype=jnp.int32), (BATCH, SEQ)),
        "ffn1_norm": gain(ks[1], (L, D_MODEL)),
        "ffn1_w_gate": nrm(ks[2], (L, D_MODEL, D_FF), D_MODEL),
        "ffn1_w_up": nrm(ks[3], (L, D_MODEL, D_FF), D_MODEL),
        "ffn1_w_down": nrm(ks[4], (L, D_FF, D_MODEL), D_FF),
        "mix_norm": gain(ks[5], (L, D_MODEL)),
        "w_in": nrm(ks[6], (L, D_MODEL, IN_COLS), D_MODEL),
        "q_a_norm": gain(ks[7], (L, Q_LORA)),
        "w_q_up": nrm(ks[8], (L, Q_LORA, MLA_HEADS * (QK_NOPE + QK_ROPE)), Q_LORA),
        "kv_a_norm": gain(ks[9], (L, KV_LORA)),
        "w_kv_up": nrm(ks[10], (L, KV_LORA, MLA_HEADS * (QK_NOPE + V_HEAD)), KV_LORA),
        "conv_w": nrm(ks[11], (L, SSD_CONV, SSD_CONV_DIM), SSD_CONV),
        "conv_b": 0.02 * jax.random.normal(ks[12], (L, SSD_CONV_DIM), jnp.float32),
        "dt_bias": dt0 + jnp.log(-jnp.expm1(-dt0)),
        "a_log": jnp.log(jax.random.uniform(ks[13], (L, SSD_HEADS), jnp.float32, minval=1.0, maxval=16.0)),
        "d_skip": 1.0 + 0.1 * jax.random.normal(ks[14], (L, SSD_HEADS), jnp.float32),
        "ssd_norm": gain(ks[15], (L, SSD_WIDTH)),
        "w_out": nrm(ks[16], (L, MIX_WIDTH, D_MODEL), MIX_WIDTH),
        "ffn2_norm": gain(ks[18], (L, D_MODEL)),
        "ffn2_w_gate": nrm(ks[19], (L, D_MODEL, D_FF), D_MODEL),
        "ffn2_w_up": nrm(ks[20], (L, D_MODEL, D_FF), D_MODEL),
        "ffn2_w_down": nrm(ks[21], (L, D_FF, D_MODEL), D_FF),
        "final_norm": gain(ks[22], (D_MODEL,)),
    }


def reference(x, positions, ffn1_norm, ffn1_w_gate, ffn1_w_up, ffn1_w_down,
              mix_norm, w_in, q_a_norm, w_q_up, kv_a_norm, w_kv_up,
              conv_w, conv_b, dt_bias, a_log, d_skip, ssd_norm, w_out,
              ffn2_norm, ffn2_w_gate, ffn2_w_up, ffn2_w_down, final_norm):
    for l in range(DEPTH):
        x = x + 0.5 * swiglu(rms_norm(x, ffn1_norm[l]), ffn1_w_gate[l], ffn1_w_up[l], ffn1_w_down[l])
        x = x + hybrid_mixer(rms_norm(x, mix_norm[l]), positions, w_in[l], q_a_norm[l], w_q_up[l],
                             kv_a_norm[l], w_kv_up[l], conv_w[l], conv_b[l], dt_bias[l], a_log[l],
                             d_skip[l], ssd_norm[l], w_out[l])
        x = x + 0.5 * swiglu(rms_norm(x, ffn2_norm[l]), ffn2_w_gate[l], ffn2_w_up[l], ffn2_w_down[l])
    return rms_norm(x, final_norm)
```

```cpp
#include <hip/hip_runtime.h>
#include <cstdio>
#include <cstdint>

#ifndef MK_ONE_LAUNCH
#define MK_ONE_LAUNCH 1
#endif

constexpr int BATCH = 4, SEQ = 4096, DM = 4096, DEPTH = 4, FF = 6144;
constexpr int M = BATCH * SEQ;
constexpr int NH = 16, QL = 896, KVL = 512, NOPE = 128, ROPE = 64, VH = 128, QKD = NOPE + ROPE;
constexpr int QW = NH * QKD;
constexpr int KVW = NH * (NOPE + VH);
constexpr int SSD_P = 64, SSD_H = 32, SSD_G = 8, SSD_N = 128, SSD_W = 2048, CONVD = 4096;
constexpr int INC = 7648, INCP = 7680;
constexpr int O_CQ = 0, O_CKV = 896, O_KPE = 1408, O_Z = 1472, O_XBC = 3520, O_DT = 7616;
constexpr float EPS = 1e-6f;
constexpr int NWAVES = 8, NTHREADS = NWAVES * 64;

constexpr size_t MiB = 1u << 20;
constexpr size_t WS_CTL = 0, CTL_ZERO_BYTES = 3 * MiB;
constexpr size_t WS_SS = 1 * MiB;
constexpr int N_SS = 3 * DEPTH + 1;
static_assert(WS_SS + (size_t)N_SS * M * 8 <= CTL_ZERO_BYTES, "ss arrays inside the memset region");
constexpr size_t WS_COS = 3 * MiB, WS_SIN = 5 * MiB;
constexpr size_t WS_SSQ = 7 * MiB;
constexpr size_t WS_X = 8 * MiB;
constexpr size_t WS_XN = 264 * MiB;
constexpr size_t WS_BIG = 392 * MiB;
constexpr size_t WS_SSP = 632 * MiB;
constexpr size_t WS_KPE = 676 * MiB;
constexpr size_t WS_DT = 678 * MiB;
constexpr size_t WS_XBC = 680 * MiB;
constexpr size_t WS_Q = 808 * MiB;
constexpr size_t WS_KV = 904 * MiB;
constexpr size_t WS_MIX = 1032 * MiB;
constexpr size_t WS_W = 1160 * MiB;
constexpr size_t W_GU1 = 0, W_D1 = 96 * MiB, W_IN = 144 * MiB, W_QU = 204 * MiB, W_KVU = 210 * MiB, W_O = 214 * MiB, W_GU2 = 246 * MiB, W_D2 = 342 * MiB, W_LAYER = 390 * MiB;
constexpr size_t WS_END = WS_W + DEPTH * W_LAYER;
static_assert(WS_BIG + (size_t)M * INCP * 2 <= WS_SSP && WS_SSP + (size_t)M * 64 * 4 <= WS_KPE && WS_XBC + (size_t)M * 4096 * 2 <= WS_Q && WS_Q + (size_t)M * QW * 2 <= WS_KV, "d_ws map");
constexpr int CW_TMO = 0, CW_CODE = 1, CW_BAR = 4096;

constexpr int RING_OFF = 0, RING_BYTES = 131072;
constexpr int LDSCTL_OFF = RING_BYTES, MISC_OFF = LDSCTL_OFF + 320;
constexpr int LDS_BYTES = 147456;

#define GAS __attribute__((address_space(1)))
#define LAS __attribute__((address_space(3)))
typedef unsigned short bf16;
typedef unsigned v4u __attribute__((ext_vector_type(4)));
typedef unsigned v2u __attribute__((ext_vector_type(2)));
typedef float f32x4 __attribute__((ext_vector_type(4)));
typedef float f32x2 __attribute__((ext_vector_type(2)));
typedef float f32x16 __attribute__((ext_vector_type(16)));
typedef short bf16x8 __attribute__((ext_vector_type(8)));
typedef short s16x4 __attribute__((ext_vector_type(4)));
typedef GAS unsigned gu32;
#define RLX_AGENT __ATOMIC_RELAXED, __HIP_MEMORY_SCOPE_AGENT
#define LDS_WAIT() asm volatile("s_waitcnt lgkmcnt(0)" ::: "memory")
#define VM_WAIT() asm volatile("s_waitcnt vmcnt(0)" ::: "memory")
__device__ __forceinline__ unsigned f2bf(float f) { unsigned u = __builtin_bit_cast(unsigned, f); return (u + 0x7fffu + ((u >> 16) & 1u)) >> 16; }
__device__ __forceinline__ unsigned pk2(float lo, float hi) { return f2bf(lo) | (f2bf(hi) << 16); }
__device__ __forceinline__ float bflo(unsigned w) { return __builtin_bit_cast(float, w << 16); }
__device__ __forceinline__ float bfhi(unsigned w) { return __builtin_bit_cast(float, w & 0xffff0000u); }
__device__ __forceinline__ float bf1(bf16 b) { return __builtin_bit_cast(float, (unsigned)b << 16); }
typedef _Float16 h16x2 __attribute__((ext_vector_type(2)));
__device__ __forceinline__ unsigned pkh2(float lo, float hi) { f32x2 v = {lo, hi}; h16x2 h = __builtin_convertvector(v, h16x2); return __builtin_bit_cast(unsigned, h); }
__device__ __forceinline__ float hlo(unsigned w) { return (float)__builtin_bit_cast(h16x2, w)[0]; }
__device__ __forceinline__ float hhi(unsigned w) { return (float)__builtin_bit_cast(h16x2, w)[1]; }
__device__ __forceinline__ float wave_sum(float v) {
#pragma unroll
    for (int o = 1; o < 64; o <<= 1) v += __shfl_xor(v, o);
    return v;
}
__device__ __forceinline__ float fast_exp(float x) { return __builtin_amdgcn_exp2f(x * 1.4426950408889634f); }
__device__ __forceinline__ float silu_f(float x) { return x * __builtin_amdgcn_rcpf(1.0f + fast_exp(-x)); }
#define XB_TMO      128
#define XB_XCNT(j)  (256  + 64 * (j))
#define XB_XSUB(j)  (1280 + 64 * (j))
#define XB_XGEN(j)  (2304 + 64 * (j))
#define XB_TOP      3328
#define XB_TOPGEN   3392
#define XCD_BAR_WORDS 3456
#define XB_SPIN_CAP (1u << 18)

__device__ __forceinline__ unsigned xb_ld(unsigned* p)              { return __hip_atomic_load(p, __ATOMIC_RELAXED, __HIP_MEMORY_SCOPE_AGENT); }
__device__ __forceinline__ unsigned xb_add(unsigned* p, unsigned v) { return __hip_atomic_fetch_add(p, v, __ATOMIC_RELAXED, __HIP_MEMORY_SCOPE_AGENT); }
__device__ __forceinline__ unsigned xb_xcc_id() { return (unsigned)__builtin_amdgcn_s_getreg((3 << 11) | 20) & 0xFu; }
#define XB_SPIN(cond, bar) do { unsigned _sp = 0; while (cond) { __builtin_amdgcn_s_sleep(1); \
    if ((++_sp & 255u) == 0u) { if (xb_ld(&(bar)[XB_TMO])) break; if (_sp > XB_SPIN_CAP) { atomicAdd(&(bar)[XB_TMO], 1u); break; } } } } while (0)

struct XcdBarrier {
    unsigned* bar; unsigned x;
    volatile LAS unsigned* st;
};

__device__ __forceinline__ XcdBarrier xcd_barrier_post(unsigned* bar, volatile LAS unsigned* st) {
    XcdBarrier b; b.bar = bar; b.x = xb_xcc_id(); b.st = st;
    if (threadIdx.x == 0) (void)xb_add(&bar[XB_XCNT(b.x)], 1u);
    return b;
}
__device__ __forceinline__ void xcd_barrier_complete(unsigned* bar, unsigned x, unsigned& nloc, unsigned& nx) {
    const unsigned G = gridDim.x * gridDim.y * gridDim.z;
    unsigned sum, cnt, mine, sp = 0u;
    for (;;) {
        sum = 0u; cnt = 0u; mine = 0u;
#pragma unroll
        for (unsigned j = 0; j < 16; ++j) { const unsigned c = xb_ld(&bar[XB_XCNT(j)]); sum += c; cnt += (c > 0u) ? 1u : 0u; mine = (j == x) ? c : mine; }
        if (sum == G) break;
        __builtin_amdgcn_s_sleep(1);
        if ((++sp & 255u) == 0u) { if (xb_ld(&bar[XB_TMO])) break; if (sp > XB_SPIN_CAP) { atomicAdd(&bar[XB_TMO], 1u); break; } }
    }
    nloc = mine > 0u ? mine : 1u; nx = cnt > 0u ? cnt : 1u;
}

__device__ __forceinline__ void xcd_barrier(const XcdBarrier& b) {
    asm volatile("s_waitcnt vmcnt(0)" ::: "memory");
    __syncthreads();
    if (threadIdx.x == 0) {
        unsigned* bar = b.bar;
        __builtin_amdgcn_s_waitcnt(0);
        unsigned nloc = b.st[0], nx = b.st[1];
        if (nloc == 0u) { xcd_barrier_complete(bar, b.x, nloc, nx); b.st[0] = nloc; b.st[1] = nx; }
        const unsigned old = xb_add(&bar[XB_XSUB(b.x)], 1u);
        const unsigned gen = old / nloc;
        if (old + 1u == (gen + 1u) * nloc) {
            __builtin_amdgcn_fence(__ATOMIC_RELEASE, "agent");
            asm volatile("s_waitcnt vmcnt(0)" ::: "memory");
            const unsigned og = xb_add(&bar[XB_TOP], 1u);
            const unsigned tg = og / nx;
            if (og + 1u == (tg + 1u) * nx) xb_add(&bar[XB_TOPGEN], 1u);
            else XB_SPIN(xb_ld(&bar[XB_TOPGEN]) == tg, bar);
            __builtin_amdgcn_fence(__ATOMIC_ACQUIRE, "agent");
            xb_add(&bar[XB_XGEN(b.x)], 1u);
            asm volatile("s_waitcnt vmcnt(0)" ::: "memory");
        } else {
            XB_SPIN(xb_ld(&bar[XB_XGEN(b.x)]) == gen, bar);
            __builtin_amdgcn_fence(__ATOMIC_ACQUIRE, "agent");
            asm volatile("s_waitcnt vmcnt(0)" ::: "memory");
        }
    }
    __syncthreads();
}
namespace pg8 {
#define PG8_LAS __attribute__((address_space(3)))
typedef unsigned short bf16_t;
typedef short bf16x8 __attribute__((ext_vector_type(8)));
typedef float f32x4 __attribute__((ext_vector_type(4)));
typedef unsigned u32x4 __attribute__((ext_vector_type(4)));
typedef _Float16 h16x8 __attribute__((ext_vector_type(8)));
constexpr int BM = 256, BK = 64, HALF = 128, HTB = HALF * BK * 2  , STAGE_BYTES = 8 * HTB, NXCD = 8, WGM = 8;

__host__ __device__ __forceinline__ int lds_byte(int r, int c) { const int st = (r >> 4) * 2 + (c >> 5), rr = r & 15, cc = c & 31, ob = rr * 64 + cc * 2; return st * 1024 + (ob ^ (((ob >> 9) & 1) << 5)); }
__host__ __device__ __forceinline__ void stage_rc(int b, int& R, int& C) { const int st = b / 1024, sb = b % 1024, swz = sb ^ (((sb >> 9) & 1) << 5); R = (st >> 1) * 16 + swz / 64; C = (st & 1) * 32 + (swz % 64) / 2; }
__host__ __device__ __forceinline__ int perm32(int rho) { const int n = rho >> 4, i = rho & 15; return 8 * (i >> 2) + 4 * n + (i & 3); }

struct Unit { int pm, pn; };
struct Gemm { const bf16_t* A; const bf16_t* Bt; int M, N, K, lda, ldb; };

struct StaticOrder {
    int nM, nN, nwg, G, c;
    __host__ __device__ void init(int M, int N, int G_, int c_) { nM = M / BM; nN = N / BM; nwg = nM * nN; G = G_; c = c_; }
    __host__ __device__ bool next(int i, Unit& u) const {
        const long L = (long)i * G + c; if (L >= nwg) return false;
        int wgid = (int)L; { const int q = nwg / NXCD, r = nwg % NXCD, xcd = wgid % NXCD, off = wgid / NXCD; wgid = (xcd < r ? xcd * (q + 1) : r * (q + 1) + (xcd - r) * q) + off; }
        const int nig = WGM * nN, gid = wgid / nig, fm = gid * WGM, gsz = (nM - fm) < WGM ? (nM - fm) : WGM;
        u.pm = fm + ((wgid % nig) % gsz); u.pn = (wgid % nig) / gsz; return true;
    }
    __device__ __forceinline__ void a_ready(const Unit&) const {}
    __device__ __forceinline__ void done(const Unit&) const {}
};

__device__ __forceinline__ unsigned cvt_pk_bf16(float lo, float hi) { unsigned r; asm volatile("v_cvt_pk_bf16_f32 %0, %1, %2" : "=v"(r) : "v"(lo), "v"(hi)); return r; }

__device__ __forceinline__ float row_rstd(const unsigned long long* ss, int row, float inv_n) { return 1.0f / sqrtf((float)ss[row] * (inv_n * 9.5367431640625e-07f) + 1e-6f); }
struct EpiStore {
    static constexpr bool PERM = true, AFTER_DRAIN = false;
    bf16_t* O; int ldc; const unsigned long long* ss; float inv_n;
    __device__ __forceinline__ void operator()(const f32x4 (&acc)[2][2][4][2], const Unit& u, int wr, int wc, int fr, int fq) const {
        const int row0 = u.pm * BM + wr * 64 + fr, col0 = u.pn * BM + wc * 32 + 8 * fq;
#pragma unroll
        for (int ai = 0; ai < 2; ++ai)
#pragma unroll
            for (int m = 0; m < 4; ++m) { const int row = row0 + ai * HALF + m * 16; bf16_t* rowp = O + (size_t)row * ldc + col0;
                const float rs = ss ? row_rstd(ss, row, inv_n) : 1.0f;
#pragma unroll
                for (int bj = 0; bj < 2; ++bj) { const f32x4 v0 = acc[ai][bj][m][0] * rs, v1 = acc[ai][bj][m][1] * rs;
                    u32x4 w; w.x = cvt_pk_bf16(v0[0], v0[1]); w.y = cvt_pk_bf16(v0[2], v0[3]); w.z = cvt_pk_bf16(v1[0], v1[1]); w.w = cvt_pk_bf16(v1[2], v1[3]);
                    *(u32x4*)(rowp + bj * HALF) = w; } }
    }
};
struct EpiSwiGLU {
    static constexpr bool PERM = true, AFTER_DRAIN = false;
    bf16_t* O; int ldc; const unsigned long long* ss; float inv_n;
    __device__ __forceinline__ void operator()(const f32x4 (&acc)[2][2][4][2], const Unit& u, int wr, int wc, int fr, int fq) const {
        const int row0 = u.pm * BM + wr * 64 + fr, col0 = u.pn * HALF + wc * 32 + 8 * fq;
#pragma unroll
        for (int ai = 0; ai < 2; ++ai)
#pragma unroll
            for (int m = 0; m < 4; ++m) { const int row = row0 + ai * HALF + m * 16; bf16_t* rowp = O + (size_t)row * ldc + col0;
                const float rs = row_rstd(ss, row, inv_n);
                float h[8];
#pragma unroll
                for (int n = 0; n < 2; ++n)
#pragma unroll
                    for (int i = 0; i < 4; ++i) { const float g = acc[ai][0][m][n][i] * rs, up = acc[ai][1][m][n][i] * rs;
                        h[n * 4 + i] = g * up * __builtin_amdgcn_rcpf(1.0f + __builtin_amdgcn_exp2f(g * -1.4426950408889634f)); }
                u32x4 w; w.x = cvt_pk_bf16(h[0], h[1]); w.y = cvt_pk_bf16(h[2], h[3]); w.z = cvt_pk_bf16(h[4], h[5]); w.w = cvt_pk_bf16(h[6], h[7]);
                *(u32x4*)rowp = w; }
    }
};
struct EpiResid {
    static constexpr bool PERM = true, AFTER_DRAIN = false;
    bf16_t* xb; unsigned long long* ssn; int ldc; float alpha;
    __device__ __forceinline__ void operator()(const f32x4 (&acc)[2][2][4][2], const Unit& u, int wr, int wc, int fr, int fq) const {
        const int row0 = u.pm * BM + wr * 64 + fr, col0 = u.pn * BM + wc * 32 + 8 * fq;
#pragma unroll
        for (int ai = 0; ai < 2; ++ai)
#pragma unroll
            for (int m = 0; m < 4; ++m) { const int row = row0 + ai * HALF + m * 16; bf16_t* rowp = xb + (size_t)row * ldc + col0; float sq = 0.f;
#pragma unroll
                for (int bj = 0; bj < 2; ++bj) { const u32x4 b = *(const u32x4*)(rowp + bj * HALF);
                    float v[8];
#pragma unroll
                    for (int e = 0; e < 4; ++e) { v[2 * e] = __builtin_bit_cast(float, b[e] << 16) + acc[ai][bj][m][e >> 1][2 * (e & 1)] * alpha;
                                                  v[2 * e + 1] = __builtin_bit_cast(float, b[e] & 0xffff0000u) + acc[ai][bj][m][e >> 1][2 * (e & 1) + 1] * alpha; }
#pragma unroll
                    for (int e = 0; e < 8; ++e) sq += v[e] * v[e];
                    u32x4 w; w.x = cvt_pk_bf16(v[0], v[1]); w.y = cvt_pk_bf16(v[2], v[3]); w.z = cvt_pk_bf16(v[4], v[5]); w.w = cvt_pk_bf16(v[6], v[7]);
                    *(u32x4*)(rowp + bj * HALF) = w; }
                sq += __shfl_xor(sq, 16); sq += __shfl_xor(sq, 32);
                if (fq == 0) __hip_atomic_fetch_add(ssn + row, (unsigned long long)(sq * 1048576.0f + 0.5f), __ATOMIC_RELAXED, __HIP_MEMORY_SCOPE_AGENT); }
    }
};

template <class Epi, class Sched, bool ALIGN_EPI = false, bool SP2 = false, bool F16 = false>
__device__ __forceinline__ void gemm_phase(PG8_LAS unsigned char* lds, const Gemm g, const Sched& S, const Epi& E) {
    __builtin_amdgcn_s_waitcnt(0);
    int tid_l = threadIdx.x; asm volatile("" : "+v"(tid_l));
    const int tid = tid_l, wid = __builtin_amdgcn_readfirstlane(tid >> 6), lane = tid & 63, wr = wid >> 2, wc = wid & 3, fr = lane & 15, fq = lane >> 4;
    const int K = g.K, nt = K / BK, lda = g.lda, ldb = g.ldb;
    unsigned voffA[2], voffB[2];
#pragma unroll
    for (int i = 0; i < 2; ++i) { int R, C; stage_rc(tid * 16 + i * 8192, R, C); const int Rb = Epi::PERM ? ((R & ~31) + perm32(R & 31)) : R;
        voffA[i] = (unsigned)(R * lda + C) * 2u; voffB[i] = (unsigned)(Rb * ldb + C) * 2u; }
    const size_t kstep = (size_t)(BK * 2);
    const size_t hstepA = (size_t)HALF * lda * 2, hstepB = (size_t)HALF * ldb * 2;
    const size_t tstepA = 2 * hstepA, tstepB = 2 * hstepB;
    const unsigned ldsw = (unsigned)wid * 1024u;
    const int aoff = lds_byte(wr * 64 + fr, fq * 8), boff = lds_byte(wc * 32 + fr, fq * 8);
#define PG8_SA(b, h) (((b) * 2 + (h)) * HTB)
#define PG8_SB(b, h) ((4 + (b) * 2 + (h)) * HTB)
#define PG8_STAGE(bufoff, gbase, voff) do { _Pragma("unroll") for (int _i = 0; _i < 2; ++_i) \
        __builtin_amdgcn_global_load_lds((const unsigned*)((const char*)(gbase) + (voff)[_i]), (PG8_LAS unsigned*)(lds + (bufoff) + ldsw + _i * 8192), 16, 0, 0); } while (0)
#define PG8_LDA(dst, b, h) do { _Pragma("unroll") for (int m = 0; m < 4; ++m) _Pragma("unroll") for (int k = 0; k < 2; ++k) dst[m][k] = *(const PG8_LAS bf16x8*)(lds + PG8_SA(b, h) + aoff + m * 2048 + k * 1024); } while (0)
#define PG8_LDB(dst, b, h) do { _Pragma("unroll") for (int n = 0; n < 2; ++n) _Pragma("unroll") for (int k = 0; k < 2; ++k) dst[n][k] = *(const PG8_LAS bf16x8*)(lds + PG8_SB(b, h) + boff + n * 2048 + k * 1024); } while (0)
#define PG8_MMA(ai, bj, At, Bt) do { __builtin_amdgcn_s_setprio(1); _Pragma("unroll") for (int m = 0; m < 4; ++m) _Pragma("unroll") for (int n = 0; n < 2; ++n) _Pragma("unroll") for (int k = 0; k < 2; ++k) \
        acc[ai][bj][m][n] = F16 ? __builtin_amdgcn_mfma_f32_16x16x32_f16(__builtin_bit_cast(h16x8, Bt[n][k]), __builtin_bit_cast(h16x8, At[m][k]), acc[ai][bj][m][n], 0, 0, 0) \
                                : __builtin_amdgcn_mfma_f32_16x16x32_bf16(Bt[n][k], At[m][k], acc[ai][bj][m][n], 0, 0, 0); __builtin_amdgcn_s_setprio(0); } while (0)
#define PG8_WAIT_V(n) asm volatile("s_waitcnt vmcnt(" #n ")" ::: "memory")
#define PG8_WAIT_L(n) asm volatile("s_waitcnt lgkmcnt(" #n ")" ::: "memory")
#define PG8_BAR __builtin_amdgcn_s_barrier()
#define PG8_SCHED __builtin_amdgcn_sched_barrier(0)
    Unit cur, nxt; int ui = 0;
    if (!S.next(0, cur)) return;
    f32x4 acc[2][2][4][2];
#pragma unroll
    for (int a = 0; a < 2; ++a)
#pragma unroll
        for (int b = 0; b < 2; ++b)
#pragma unroll
            for (int m = 0; m < 4; ++m)
#pragma unroll
                for (int n = 0; n < 2; ++n) acc[a][b][m][n] = (f32x4){0.f, 0.f, 0.f, 0.f};
    bf16x8 At[4][2], B0[2][2], B1[2][2];
    const char* cA = (const char*)g.A + (size_t)cur.pm * tstepA; const char* cB = (const char*)g.Bt + (size_t)cur.pn * tstepB;
    S.a_ready(cur);
    if constexpr (SP2) {
        PG8_STAGE(PG8_SB(0, 0), cB, voffB); PG8_STAGE(PG8_SB(0, 1), cB + hstepB, voffB); PG8_STAGE(PG8_SA(0, 0), cA, voffA); PG8_STAGE(PG8_SA(0, 1), cA + hstepA, voffA);
        if (wr == 1) PG8_BAR;
        PG8_WAIT_V(2); PG8_BAR;
        PG8_STAGE(PG8_SB(1, 0), cB + kstep, voffB); PG8_STAGE(PG8_SA(1, 0), cA + kstep, voffA); PG8_STAGE(PG8_SB(1, 1), cB + hstepB + kstep, voffB);
        PG8_WAIT_V(6); PG8_BAR;
    } else {
        PG8_STAGE(PG8_SB(0, 0), cB, voffB); PG8_STAGE(PG8_SA(0, 0), cA, voffA); PG8_STAGE(PG8_SB(0, 1), cB + hstepB, voffB); PG8_STAGE(PG8_SA(0, 1), cA + hstepA, voffA);
        if (wr == 1) PG8_BAR;
        PG8_WAIT_V(4); PG8_BAR;
        PG8_STAGE(PG8_SB(1, 0), cB + kstep, voffB); PG8_STAGE(PG8_SA(1, 0), cA + kstep, voffA); PG8_STAGE(PG8_SB(1, 1), cB + hstepB + kstep, voffB);
        PG8_WAIT_V(6); PG8_BAR;
    }
    for (;;) {
        const bool has_next = S.next(ui + 1, nxt);
        const char* nA = has_next ? (const char*)g.A + (size_t)nxt.pm * tstepA : cA; const char* nB = has_next ? (const char*)g.Bt + (size_t)nxt.pn * tstepB : cB;
        for (int t = 0; t < nt; t += 2) {
            const bool last = (t == nt - 2);
            const char* a1 = cA + (size_t)(t + 1) * kstep;
            const char* a2 = last ? nA : cA + (size_t)(t + 2) * kstep; const char* b2 = last ? nB : cB + (size_t)(t + 2) * kstep;
            const char* a3 = a2 + kstep; const char* b3 = b2 + kstep;
            if (last && has_next) S.a_ready(nxt);
            if constexpr (SP2) {
            PG8_LDB(B0, 0, 0); PG8_LDB(B1, 0, 1); PG8_SCHED; PG8_LDA(At, 0, 0); PG8_STAGE(PG8_SA(1, 1), a1 + hstepA, voffA);
            PG8_WAIT_V(8); PG8_WAIT_L(0); PG8_BAR; PG8_MMA(0, 0, At, B0); PG8_MMA(0, 1, At, B1); PG8_BAR; PG8_SCHED;
            PG8_LDA(At, 0, 1); PG8_STAGE(PG8_SB(0, 0), b2, voffB); PG8_STAGE(PG8_SB(0, 1), b2 + hstepB, voffB); PG8_STAGE(PG8_SA(0, 0), a2, voffA);
            PG8_WAIT_V(8); PG8_WAIT_L(0); PG8_BAR; PG8_MMA(1, 0, At, B0); PG8_MMA(1, 1, At, B1); PG8_BAR; PG8_SCHED;
            PG8_LDB(B0, 1, 0); PG8_LDB(B1, 1, 1); PG8_SCHED; PG8_LDA(At, 1, 0); PG8_STAGE(PG8_SA(0, 1), a2 + hstepA, voffA);
            PG8_WAIT_V(8); PG8_WAIT_L(0); PG8_BAR; PG8_MMA(0, 0, At, B0); PG8_MMA(0, 1, At, B1); PG8_BAR; PG8_SCHED;
            PG8_LDA(At, 1, 1); PG8_STAGE(PG8_SB(1, 0), b3, voffB); PG8_STAGE(PG8_SB(1, 1), b3 + hstepB, voffB); PG8_STAGE(PG8_SA(1, 0), a3, voffA);
            PG8_WAIT_V(8); PG8_WAIT_L(0); PG8_BAR; PG8_MMA(1, 0, At, B0); PG8_MMA(1, 1, At, B1); PG8_BAR; PG8_SCHED;
            } else {
            PG8_LDB(B0, 0, 0); PG8_SCHED; PG8_LDA(At, 0, 0); PG8_STAGE(PG8_SA(1, 1), a1 + hstepA, voffA);
            PG8_WAIT_L(8); PG8_BAR; PG8_WAIT_L(0); PG8_MMA(0, 0, At, B0); PG8_BAR; PG8_SCHED;
            PG8_LDB(B1, 0, 1); PG8_STAGE(PG8_SB(0, 0), b2, voffB);
            PG8_BAR; PG8_WAIT_L(0); PG8_MMA(0, 1, At, B1); PG8_BAR;
            PG8_LDA(At, 0, 1); PG8_STAGE(PG8_SA(0, 0), a2, voffA);
            PG8_BAR; PG8_WAIT_L(0); PG8_MMA(1, 0, At, B0); PG8_BAR; PG8_SCHED;
            PG8_STAGE(PG8_SB(0, 1), b2 + hstepB, voffB);
            PG8_WAIT_V(6); PG8_BAR; PG8_MMA(1, 1, At, B1); PG8_BAR;
            PG8_LDB(B0, 1, 0); PG8_SCHED; PG8_LDA(At, 1, 0); PG8_STAGE(PG8_SA(0, 1), a2 + hstepA, voffA);
            PG8_WAIT_L(8); PG8_BAR; PG8_WAIT_L(0); PG8_MMA(0, 0, At, B0); PG8_BAR; PG8_SCHED;
            PG8_LDB(B1, 1, 1); PG8_STAGE(PG8_SB(1, 0), b3, voffB);
            PG8_BAR; PG8_WAIT_L(0); PG8_MMA(0, 1, At, B1); PG8_BAR;
            PG8_LDA(At, 1, 1); PG8_STAGE(PG8_SA(1, 0), a3, voffA);
            PG8_BAR; PG8_WAIT_L(0); PG8_MMA(1, 0, At, B0); PG8_BAR; PG8_SCHED;
            PG8_STAGE(PG8_SB(1, 1), b3 + hstepB, voffB);
            PG8_WAIT_V(6); PG8_BAR; PG8_MMA(1, 1, At, B1); PG8_BAR;
            }
        }
        if constexpr (ALIGN_EPI) { if (wr == 0) PG8_BAR; }
        if constexpr (!Epi::AFTER_DRAIN) { E(acc, cur, wr, wc, fr, fq); S.done(cur); }
        if (!has_next) break;
#pragma unroll
        for (int a = 0; a < 2; ++a)
#pragma unroll
            for (int b = 0; b < 2; ++b)
#pragma unroll
                for (int m = 0; m < 4; ++m)
#pragma unroll
                    for (int n = 0; n < 2; ++n) acc[a][b][m][n] = (f32x4){0.f, 0.f, 0.f, 0.f};
        cur = nxt; cA = nA; cB = nB; ++ui;
        if constexpr (ALIGN_EPI) { if (wr == 1) PG8_BAR; }
    }
    PG8_WAIT_V(0);
    if constexpr (!ALIGN_EPI) { if (wr == 0) PG8_BAR; }
    PG8_BAR;
    if constexpr (Epi::AFTER_DRAIN) { E.fused(acc, cur, wr, wc, fr, fq, lds, wid, lane); S.done(cur); }
#undef PG8_SA
#undef PG8_SB
#undef PG8_STAGE
#undef PG8_LDA
#undef PG8_LDB
#undef PG8_MMA
#undef PG8_WAIT_V
#undef PG8_WAIT_L
#undef PG8_BAR
#undef PG8_SCHED
}
}
#ifndef PG8_SP2
#define PG8_SP2 true
#endif
#ifndef PG8_ALIGN
#define PG8_ALIGN true
#endif
namespace att {
constexpr int KSTR = 400, VSTR = 320;
constexpr int KBUF = 64 * KSTR, VBUF = 64 * VSTR;
constexpr int OFF_K = 0, OFF_V = 2 * KBUF, OFF_WS = OFF_V + 2 * VBUF, LDS_NEED = OFF_WS + NWAVES * 256;
constexpr float C2 = 0.07216878364870322f * 1.4426950408889634f;
static_assert(LDS_NEED <= RING_BYTES, "attention LDS");
typedef float f32x2_t __attribute__((ext_vector_type(2))); typedef __bf16 bf16x2_t __attribute__((ext_vector_type(2)));
typedef short v4i16_t __attribute__((ext_vector_type(4)));
__device__ __forceinline__ unsigned cvtpk(float lo, float hi) { f32x2_t v = {lo, hi}; bf16x2_t b = __builtin_convertvector(v, bf16x2_t); return __builtin_bit_cast(unsigned, b); }
__device__ __forceinline__ s16x4 trd(const LAS unsigned char* p) { return __builtin_bit_cast(s16x4, __builtin_amdgcn_ds_read_tr16_b64_v4i16((LAS v4i16_t*)p)); }
__device__ __forceinline__ int crow(int r, int hi) { return (r & 3) + 8 * (r >> 2) + 4 * hi; }
#define ATT_MFMA(a, b, c) __builtin_amdgcn_mfma_f32_32x32x16_bf16((a), (b), (c), 0, 0, 0)

__device__ __forceinline__ void attn_block(int b, int h, int qb, const bf16* __restrict__ Q, const bf16* __restrict__ KV, const bf16* __restrict__ KPE, const float* __restrict__ cosT, const float* __restrict__ sinT, bf16* __restrict__ MIXo, LAS unsigned char* lds) {
    int tid_l = threadIdx.x; asm volatile("" : "+v"(tid_l));
    const int tid = tid_l, lane = tid & 63, c = lane & 31, hi = lane >> 5;
    const int wid = __builtin_amdgcn_readfirstlane(tid >> 6);
    const size_t rowbase = (size_t)b * SEQ; const int q0 = qb * 256, qlo = q0 + wid * 32;
    const int NT = 4 * qb + 4;
    const bf16* qrow = Q + (rowbase + qlo + c) * QW + h * QKD + 8 * hi;
    bf16x8 qr[12];
#pragma unroll
    for (int d = 0; d < 12; ++d) qr[d] = *(const bf16x8*)(qrow + 16 * d);
    {
        const float* ct = cosT + (rowbase + qlo + c) * 32 + 4 * hi; const float* st = sinT + (rowbase + qlo + c) * 32 + 4 * hi;
#pragma unroll
        for (int dd = 0; dd < 4; ++dd) { const f32x4 cs = *(const f32x4*)(ct + 8 * dd), sn = *(const f32x4*)(st + 8 * dd);
            v4u w = __builtin_bit_cast(v4u, qr[8 + dd]);
#pragma unroll
            for (int e = 0; e < 4; ++e) { const float x1 = bflo(w[e]), x2 = bfhi(w[e]); w[e] = cvtpk(x1 * cs[e] - x2 * sn[e], x2 * cs[e] + x1 * sn[e]); }
            qr[8 + dd] = __builtin_bit_cast(bf16x8, w); }
    }
    const int kkey = tid >> 4, kch = tid & 15, pkey = tid >> 3, pch = tid & 7;
    const bf16* gk = KV + (rowbase + kkey) * KVW + h * 256 + kch * 8;
    const bf16* gv = gk + 128;
    const bf16* gp = KPE + (rowbase + pkey) * 64 + pch * 8;
    const int lk0 = kkey * KSTR + kch * 16, lk1 = lk0 + 32 * KSTR, lp = pkey * KSTR + 256 + pch * 16;
    const int lv0 = kkey * VSTR + kch * 16, lv1 = lv0 + 32 * VSTR;
    v4u sk0, sk1, sp, sv0, sv1;
#define ATT_LOAD(t) do { const size_t o_ = (size_t)(t) * 64 * KVW; sk0 = *(const v4u*)(gk + o_); sk1 = *(const v4u*)(gk + o_ + 32 * KVW); \
        sv0 = *(const v4u*)(gv + o_); sv1 = *(const v4u*)(gv + o_ + 32 * KVW); sp = *(const v4u*)(gp + (size_t)(t) * 64 * 64); } while (0)
#define ATT_WRITE(bi) do { LAS unsigned char* kb_ = lds + OFF_K + (bi) * KBUF; LAS unsigned char* vb_ = lds + OFF_V + (bi) * VBUF; \
        *(LAS v4u*)(kb_ + lk0) = sk0; *(LAS v4u*)(kb_ + lk1) = sk1; *(LAS v4u*)(kb_ + lp) = sp; *(LAS v4u*)(vb_ + lv0) = sv0; *(LAS v4u*)(vb_ + lv1) = sv1; } while (0)
    LAS float* wsf = (LAS float*)(lds + OFF_WS) + wid * 64;
    float m_run = -1e30f, l_run = 0.f;
    f32x16 o[4];
#pragma unroll
    for (int d0 = 0; d0 < 4; ++d0)
#pragma unroll
        for (int r = 0; r < 16; ++r) o[d0][r] = 0.f;
    const int i16 = lane & 15, qq = i16 >> 2, pp = i16 & 3, blk = (lane >> 4) & 1;
    const int voff = (4 * hi + qq) * VSTR + 32 * blk + 8 * pp;
    const int koff = c * KSTR + hi * 16;
    ATT_LOAD(0); ATT_WRITE(0); __syncthreads();
    for (int t = 0; t < NT; ++t) {
        const int cur = t & 1, kb0 = 64 * t;
        if (t + 1 < NT) ATT_LOAD(t + 1);
        if (kb0 <= qlo + 31) {
            f32x16 p0, p1;
#pragma unroll
            for (int r = 0; r < 16; ++r) { p0[r] = 0.f; p1[r] = 0.f; }
            const LAS unsigned char* kp = lds + OFF_K + cur * KBUF + koff;
#pragma unroll
            for (int dg = 0; dg < 3; ++dg) {
                bf16x8 k0[4], k1[4];
#pragma unroll
                for (int j = 0; j < 4; ++j) { k0[j] = *(const LAS bf16x8*)(kp + (4 * dg + j) * 32); k1[j] = *(const LAS bf16x8*)(kp + 32 * KSTR + (4 * dg + j) * 32); }
                __builtin_amdgcn_sched_barrier(0);
#pragma unroll
                for (int j = 0; j < 4; ++j) { p0 = ATT_MFMA(k0[j], qr[4 * dg + j], p0); p1 = ATT_MFMA(k1[j], qr[4 * dg + j], p1); }
            }
            if (kb0 + 63 > qlo) {
                const int dq = qlo + c - kb0 - 4 * hi; const float NEG = -__builtin_inff();
#pragma unroll
                for (int r = 0; r < 16; ++r) { const int cr = (r & 3) + 8 * (r >> 2); if (cr > dq) p0[r] = NEG; if (cr + 32 > dq) p1[r] = NEG; }
            }
            float mx = p0[0];
#pragma unroll
            for (int r = 1; r < 16; ++r) mx = fmaxf(mx, p0[r]);
#pragma unroll
            for (int r = 0; r < 16; ++r) mx = fmaxf(mx, p1[r]);
            mx = fmaxf(mx, __shfl_xor(mx, 32));
            float mn = m_run, alpha = 1.0f;
            if (!__all((mx - m_run) * C2 <= 6.0f)) { mn = fmaxf(m_run, mx); alpha = __builtin_amdgcn_exp2f((m_run - mn) * C2); m_run = mn; }
            const float mnc = mn * C2;
            float rs = 0.f;
#pragma unroll
            for (int r = 0; r < 16; ++r) { p0[r] = __builtin_amdgcn_exp2f(p0[r] * C2 - mnc); rs += p0[r]; }
            if (__any(alpha < 1.0f)) {
                if (hi == 0) wsf[c] = alpha;
                LDS_WAIT();
#pragma unroll
                for (int r = 0; r < 16; ++r) { const float a = wsf[crow(r, hi)];
#pragma unroll
                    for (int d0 = 0; d0 < 4; ++d0) o[d0][r] *= a; }
            }
            const LAS unsigned char* vp = lds + OFF_V + cur * VBUF + voff;
#pragma unroll
            for (int s = 0; s < 2; ++s) {
                v4u pw; pw.x = cvtpk(p0[8 * s + 0], p0[8 * s + 1]); pw.y = cvtpk(p0[8 * s + 2], p0[8 * s + 3]); pw.z = cvtpk(p0[8 * s + 4], p0[8 * s + 5]); pw.w = cvtpk(p0[8 * s + 6], p0[8 * s + 7]);
                const bf16x8 pa = __builtin_bit_cast(bf16x8, pw);
                s16x4 lo[4], hh[4];
#pragma unroll
                for (int d0 = 0; d0 < 4; ++d0) { lo[d0] = trd(vp + (16 * s) * VSTR + 64 * d0); hh[d0] = trd(vp + (16 * s + 8) * VSTR + 64 * d0); }
                __builtin_amdgcn_sched_barrier(0);
#pragma unroll
                for (int d0 = 0; d0 < 4; ++d0) o[d0] = ATT_MFMA(pa, __builtin_shufflevector(lo[d0], hh[d0], 0, 1, 2, 3, 4, 5, 6, 7), o[d0]);
#pragma unroll
                for (int r = 8 * s; r < 8 * s + 8; ++r) { p1[r] = __builtin_amdgcn_exp2f(p1[r] * C2 - mnc); rs += p1[r]; }
#pragma unroll
                for (int i = 0; i < 4; ++i) { __builtin_amdgcn_sched_group_barrier(0x008, 1, 0); __builtin_amdgcn_sched_group_barrier(0x002, 6, 0); }
                __builtin_amdgcn_sched_barrier(0);
            }
            rs += __shfl_xor(rs, 32);
            l_run = l_run * alpha + rs;
#pragma unroll
            for (int s = 0; s < 2; ++s) {
                v4u pw; pw.x = cvtpk(p1[8 * s + 0], p1[8 * s + 1]); pw.y = cvtpk(p1[8 * s + 2], p1[8 * s + 3]); pw.z = cvtpk(p1[8 * s + 4], p1[8 * s + 5]); pw.w = cvtpk(p1[8 * s + 6], p1[8 * s + 7]);
                const bf16x8 pa = __builtin_bit_cast(bf16x8, pw);
                s16x4 lo[4], hh[4];
#pragma unroll
                for (int d0 = 0; d0 < 4; ++d0) { lo[d0] = trd(vp + (32 + 16 * s) * VSTR + 64 * d0); hh[d0] = trd(vp + (32 + 16 * s + 8) * VSTR + 64 * d0); }
                __builtin_amdgcn_sched_barrier(0);
#pragma unroll
                for (int d0 = 0; d0 < 4; ++d0) o[d0] = ATT_MFMA(pa, __builtin_shufflevector(lo[d0], hh[d0], 0, 1, 2, 3, 4, 5, 6, 7), o[d0]);
            }
        }
        if (t + 1 < NT) ATT_WRITE(cur ^ 1);
        __syncthreads();
    }
    if (hi == 0) wsf[32 + c] = l_run;
    LDS_WAIT();
    bf16* ob = MIXo + (rowbase + qlo) * 4096 + h * 128 + c;
#pragma unroll
    for (int r = 0; r < 16; ++r) { const int orow = crow(r, hi); const float rl = 1.0f / wsf[32 + orow];
#pragma unroll
        for (int d0 = 0; d0 < 4; ++d0) { const float v = o[d0][r] * rl, vn = __shfl_xor(v, 1);
            if ((c & 1) == 0) *(unsigned*)(ob + (size_t)orow * 4096 + d0 * 32) = pk2(v, vn); } }
    LDS_WAIT();
#undef ATT_LOAD
#undef ATT_WRITE
}
}
namespace ssd {
constexpr int RS = 272;
constexpr int BUF = 128 * RS + 128 * 64 + 2560;
constexpr int OFF_X = 128 * RS, OFF_SC = OFF_X + 128 * 64, OFF_S = 2 * BUF;
constexpr int SC_ACS = 0, SC_DT = 512, SC_ECS = 1024, SC_WEND = 1536, SC_ETOT = 2048, LDS_NEED = OFF_S + 2 * 32 * RS;
static_assert(LDS_NEED <= RING_BYTES && BUF % 16 == 0, "ssd LDS");
constexpr float LOG2E = 1.4426950408889634f;
#define SSD_MFMA(a, b, c) __builtin_amdgcn_mfma_f32_32x32x16_bf16((a), (b), (c), 0, 0, 0)
#define SSD_BAR() do { asm volatile("s_waitcnt lgkmcnt(0)" ::: "memory"); __builtin_amdgcn_s_barrier(); asm volatile("" ::: "memory"); } while (0)

__device__ __forceinline__ void ssd_unit(int unit, const bf16* __restrict__ XBC, const float* __restrict__ DT, const bf16* __restrict__ PROJ, const float* a_log, const float* d_skip,
                                         bf16* __restrict__ MIXo, LAS unsigned char* lds) {
    int tid_l = threadIdx.x; asm volatile("" : "+v"(tid_l));
    const int tid = tid_l, lane = tid & 63, c = lane & 31, hi = lane >> 5;
    const int wid = __builtin_amdgcn_readfirstlane(tid >> 6);
    const int b = unit >> 6, h = (unit >> 1) & 31, ph = unit & 1, g = h >> 2, pcol0 = h * 64 + 32 * ph;
    const float A2 = -expf(a_log[h]) * LOG2E, Dk = d_skip[h];
    const size_t mb = (size_t)b * SEQ;
    LAS unsigned char* Ss = lds + OFF_S;
    const int srow = tid >> 4, sch = tid & 15, xrow = tid >> 2, xch = tid & 3;
    const bf16* gB = XBC + (mb + srow) * 4096 + 2048 + g * 128 + sch * 8;
    const bf16* gX = XBC + (mb + xrow) * 4096 + pcol0 + xch * 8;
    const float* gD = DT + (mb + 2 * lane) * 32 + h;
    const bf16* gCf = XBC + (mb + 32 * (wid & 3) + c) * 4096 + 3072 + g * 128 + 8 * hi;
    const int lcb = srow * RS + sch * 16, lx = OFF_X + xrow * 64 + xch * 16;
    v4u sb0, sb1, sb2, sb3, sx; float sd0 = 0.f, sd1 = 0.f;
#define SSD_LOAD(ch) do { const size_t o_ = (size_t)(ch) * 128 * 4096; \
        sb0 = *(const v4u*)(gB + o_); sb1 = *(const v4u*)(gB + o_ + 32 * 4096); sb2 = *(const v4u*)(gB + o_ + 64 * 4096); sb3 = *(const v4u*)(gB + o_ + 96 * 4096); \
        sx = *(const v4u*)(gX + o_); if (wid == 0) { sd0 = gD[(size_t)(ch) * 128 * 32]; sd1 = gD[(size_t)(ch) * 128 * 32 + 32]; } } while (0)
#define SSD_WRITE(bufp) do { LAS unsigned char* wb_ = (bufp); \
        *(LAS v4u*)(wb_ + lcb) = sb0; *(LAS v4u*)(wb_ + lcb + 32 * RS) = sb1; *(LAS v4u*)(wb_ + lcb + 64 * RS) = sb2; *(LAS v4u*)(wb_ + lcb + 96 * RS) = sb3; \
        *(LAS v4u*)(wb_ + lx) = sx; \
        if (wid == 0) {     \
            LAS float* sc_ = (LAS float*)(wb_ + OFF_SC); \
            const float a0_ = sd0 * A2, a1_ = sd1 * A2, pr_ = a0_ + a1_; float inc_ = pr_; \
            _Pragma("unroll") for (int o_ = 1; o_ < 64; o_ <<= 1) { const float v_ = __shfl_up(inc_, o_); if (lane >= o_) inc_ += v_; } \
            const float cs0_ = inc_ - pr_ + a0_, cs1_ = inc_, tot_ = __shfl(inc_, 63); \
            *(LAS f32x2*)(sc_ + SC_ACS / 4 + 2 * lane) = (f32x2){cs0_, cs1_}; *(LAS f32x2*)(sc_ + SC_DT / 4 + 2 * lane) = (f32x2){sd0, sd1}; \
            *(LAS f32x2*)(sc_ + SC_ECS / 4 + 2 * lane) = (f32x2){__builtin_amdgcn_exp2f(cs0_), __builtin_amdgcn_exp2f(cs1_)}; \
            *(LAS f32x2*)(sc_ + SC_WEND / 4 + 2 * lane) = (f32x2){sd0 * __builtin_amdgcn_exp2f(tot_ - cs0_), sd1 * __builtin_amdgcn_exp2f(tot_ - cs1_)}; \
            if (lane == 63) sc_[SC_ETOT / 4] = __builtin_amdgcn_exp2f(tot_); } } while (0)
    const int i16 = lane & 15, qq = i16 >> 2, pp = i16 & 3, blk = (lane >> 4) & 1;
    f32x16 ST;
#pragma unroll
    for (int r = 0; r < 16; ++r) ST[r] = 0.f;
    bf16x8 cfn[8];
#pragma unroll
    for (int ks = 0; ks < 8; ++ks) cfn[ks] = *(const bf16x8*)(gCf + 16 * ks);
    SSD_LOAD(0); SSD_WRITE(lds);
    for (int i = tid; i < (32 * RS) / 16; i += NTHREADS) *(LAS v4u*)(Ss + i * 16) = (v4u){0u, 0u, 0u, 0u};
    SSD_BAR();
    for (int ch = 0; ch < SEQ / 128; ++ch) {
        const int chn = ch + 1 < SEQ / 128 ? ch + 1 : ch;
        SSD_LOAD(chn);
        const size_t m0 = mb + (size_t)ch * 128;
        LAS unsigned char* cb = lds + (ch & 1) * BUF;
        LAS unsigned char* Bs = cb; LAS unsigned char* Xs = cb + OFF_X;
        LAS float* acs = (LAS float*)(cb + OFF_SC + SC_ACS); LAS float* dtv = (LAS float*)(cb + OFF_SC + SC_DT); LAS float* ecs = (LAS float*)(cb + OFF_SC + SC_ECS);
        LAS float* wend = (LAS float*)(cb + OFF_SC + SC_WEND); LAS float* etot = (LAS float*)(cb + OFF_SC + SC_ETOT);
        if (wid < 4) {
            const int lb = wid;
            unsigned short zr[16];
            { const bf16* zp = PROJ + (m0 + 32 * lb + 4 * hi) * INCP + O_Z + pcol0 + c;
#pragma unroll
              for (int r = 0; r < 16; ++r) zr[r] = zp[(size_t)((r & 3) + 8 * (r >> 2)) * INCP]; }
            bf16x8 cf[8];
#pragma unroll
            for (int ks = 0; ks < 8; ++ks) cf[ks] = cfn[ks];
#pragma unroll
            for (int ks = 0; ks < 8; ++ks) cfn[ks] = *(const bf16x8*)(gCf + (size_t)chn * 128 * 4096 + 16 * ks);
            f32x16 y;
#pragma unroll
            for (int r = 0; r < 16; ++r) y[r] = 0.f;
            { const LAS unsigned char* sp = Ss + (ch & 1) * 32 * RS + c * RS + hi * 16; bf16x8 sf[8];
#pragma unroll
              for (int ks = 0; ks < 8; ++ks) sf[ks] = *(const LAS bf16x8*)(sp + ks * 32);
              __builtin_amdgcn_sched_barrier(0);
#pragma unroll
              for (int ks = 0; ks < 8; ++ks) y = SSD_MFMA(cf[ks], sf[ks], y); }
#pragma unroll
            for (int g4 = 0; g4 < 4; ++g4) { const f32x4 e = *(const LAS f32x4*)(ecs + 32 * lb + 8 * g4 + 4 * hi);
#pragma unroll
                for (int i = 0; i < 4; ++i) y[4 * g4 + i] *= e[i]; }
            const float acl = acs[32 * lb + c];
            for (int sb = 0; sb <= lb; ++sb) {
                f32x16 gt;
#pragma unroll
                for (int r = 0; r < 16; ++r) gt[r] = 0.f;
                const LAS unsigned char* bp = Bs + (32 * sb + c) * RS + hi * 16;
                const LAS unsigned char* xp0 = Xs + (32 * sb + 4 * hi + qq) * 64 + (16 * blk + 4 * pp) * 2;
                const s16x4 xl0 = att::trd(xp0), xh0 = att::trd(xp0 + 8 * 64), xl1 = att::trd(xp0 + 16 * 64), xh1 = att::trd(xp0 + 24 * 64);
#pragma unroll
                for (int kg = 0; kg < 2; ++kg) { bf16x8 bfr[4];
#pragma unroll
                    for (int k4 = 0; k4 < 4; ++k4) bfr[k4] = *(const LAS bf16x8*)(bp + (4 * kg + k4) * 32);
                    __builtin_amdgcn_sched_barrier(0);
#pragma unroll
                    for (int k4 = 0; k4 < 4; ++k4) gt = SSD_MFMA(bfr[k4], cf[4 * kg + k4], gt); }
                const int dl = 32 * (lb - sb) + c - 4 * hi;
#pragma unroll
                for (int gh = 0; gh < 2; ++gh) { f32x4 as4[2], ds4[2];
#pragma unroll
                    for (int g2 = 0; g2 < 2; ++g2) { as4[g2] = *(const LAS f32x4*)(acs + 32 * sb + 8 * (2 * gh + g2) + 4 * hi); ds4[g2] = *(const LAS f32x4*)(dtv + 32 * sb + 8 * (2 * gh + g2) + 4 * hi); }
#pragma unroll
                    for (int g2 = 0; g2 < 2; ++g2) { const int g4 = 2 * gh + g2;
#pragma unroll
                        for (int i = 0; i < 4; ++i) { const float w = __builtin_amdgcn_exp2f(fminf(acl - as4[g2][i], 0.f)) * ds4[g2][i]; gt[4 * g4 + i] = (8 * g4 + i <= dl) ? gt[4 * g4 + i] * w : 0.f; } } }
#pragma unroll
                for (int s2 = 0; s2 < 2; ++s2) {
                    v4u pw; pw.x = att::cvtpk(gt[8 * s2 + 0], gt[8 * s2 + 1]); pw.y = att::cvtpk(gt[8 * s2 + 2], gt[8 * s2 + 3]); pw.z = att::cvtpk(gt[8 * s2 + 4], gt[8 * s2 + 5]); pw.w = att::cvtpk(gt[8 * s2 + 6], gt[8 * s2 + 7]);
                    const s16x4 lo = s2 ? xl1 : xl0, hh = s2 ? xh1 : xh0;
                    y = SSD_MFMA(__builtin_bit_cast(bf16x8, pw), __builtin_shufflevector(lo, hh, 0, 1, 2, 3, 4, 5, 6, 7), y);
                }
            }
            bf16* op = MIXo + (m0 + 32 * lb + 4 * hi) * 4096 + 2048 + pcol0 + c;
            const LAS unsigned short* xl = (const LAS unsigned short*)(Xs + (32 * lb + 4 * hi) * 64 + 2 * c);
            unsigned short xr[16];
#pragma unroll
            for (int r = 0; r < 16; ++r) xr[r] = xl[((r & 3) + 8 * (r >> 2)) * 32];
            __builtin_amdgcn_sched_barrier(0);
#pragma unroll
            for (int r = 0; r < 16; ++r) { const int lr = (r & 3) + 8 * (r >> 2);
                const float v = (y[r] + Dk * bf1(xr[r])) * silu_f(bf1(zr[r]));
                op[(size_t)lr * 4096] = (bf16)f2bf(v); }
        } else {
            const int nb = wid - 4;
            const float et = etot[0];
#pragma unroll
            for (int r = 0; r < 16; ++r) ST[r] *= et;
            const LAS unsigned char* ap = Bs + (8 * hi + qq) * RS + (32 * nb + 16 * blk + 4 * pp) * 2;
            const LAS unsigned char* xp = Xs + (8 * hi + qq) * 64 + (16 * blk + 4 * pp) * 2;
#pragma unroll
            for (int kg = 0; kg < 2; ++kg) {
                s16x4 alo[4], ahh[4], xlo[4], xhh[4]; f32x4 w0[4], w1[4];
#pragma unroll
                for (int k4 = 0; k4 < 4; ++k4) { const int ks = 4 * kg + k4;
                    alo[k4] = att::trd(ap + 16 * ks * RS); ahh[k4] = att::trd(ap + (16 * ks + 4) * RS);
                    xlo[k4] = att::trd(xp + 16 * ks * 64); xhh[k4] = att::trd(xp + (16 * ks + 4) * 64);
                    w0[k4] = *(const LAS f32x4*)(wend + 16 * ks + 8 * hi); w1[k4] = *(const LAS f32x4*)(wend + 16 * ks + 8 * hi + 4); }
                __builtin_amdgcn_sched_barrier(0);
#pragma unroll
                for (int k4 = 0; k4 < 4; ++k4) {
                    v4u xw;
                    xw.x = att::cvtpk(bf1((bf16)xlo[k4][0]) * w0[k4][0], bf1((bf16)xlo[k4][1]) * w0[k4][1]); xw.y = att::cvtpk(bf1((bf16)xlo[k4][2]) * w0[k4][2], bf1((bf16)xlo[k4][3]) * w0[k4][3]);
                    xw.z = att::cvtpk(bf1((bf16)xhh[k4][0]) * w1[k4][0], bf1((bf16)xhh[k4][1]) * w1[k4][1]); xw.w = att::cvtpk(bf1((bf16)xhh[k4][2]) * w1[k4][2], bf1((bf16)xhh[k4][3]) * w1[k4][3]);
                    ST = SSD_MFMA(__builtin_shufflevector(alo[k4], ahh[k4], 0, 1, 2, 3, 4, 5, 6, 7), __builtin_bit_cast(bf16x8, xw), ST);
                }
            }
            LAS unsigned char* so = Ss + ((ch + 1) & 1) * 32 * RS + c * RS + (32 * nb + 4 * hi) * 2;
#pragma unroll
            for (int g4 = 0; g4 < 4; ++g4) { v2u w; w.x = att::cvtpk(ST[4 * g4], ST[4 * g4 + 1]); w.y = att::cvtpk(ST[4 * g4 + 2], ST[4 * g4 + 3]); *(LAS v2u*)(so + g4 * 16) = w; }
        }
        SSD_WRITE(lds + ((ch + 1) & 1) * BUF);
        SSD_BAR();
    }
    VM_WAIT();
#undef SSD_LOAD
#undef SSD_WRITE
}
}
struct Frame {
    LAS unsigned char* lds;
    volatile LAS unsigned* MISC;
    gu32* ctl;
    int wave;
    int vcu, G;
};

__device__ __forceinline__ void row_copy_ss(const float* xrow, bf16* orow, unsigned long long* ss, int lane) {
    const f32x4* xr = (const f32x4*)xrow + lane;
    f32x4 v[16]; float s = 0.f;
#pragma unroll
    for (int j = 0; j < 16; ++j) { v[j] = xr[64 * j]; s += (v[j].x * v[j].x + v[j].y * v[j].y) + (v[j].z * v[j].z + v[j].w * v[j].w); }
    s = wave_sum(s);
    v2u* o8 = (v2u*)orow + lane;
#pragma unroll
    for (int j = 0; j < 16; ++j) { v2u wb; wb.x = pk2(v[j].x, v[j].y); wb.y = pk2(v[j].z, v[j].w); o8[64 * j] = wb; }
    if (lane == 0) *ss = (unsigned long long)(s * 1048576.0f + 0.5f);
}
__device__ __forceinline__ void rms_row_out(const bf16* xrow, const float* gain, float* orow, int lane) {
    const v4u* xr = (const v4u*)xrow + lane; float v[64]; float s = 0.f;
#pragma unroll
    for (int j = 0; j < 8; ++j) { const v4u w = xr[64 * j];
#pragma unroll
        for (int e = 0; e < 4; ++e) { v[8 * j + 2 * e] = bflo(w[e]); v[8 * j + 2 * e + 1] = bfhi(w[e]); s += v[8 * j + 2 * e] * v[8 * j + 2 * e] + v[8 * j + 2 * e + 1] * v[8 * j + 2 * e + 1]; } }
    const float rstd = 1.0f / sqrtf(wave_sum(s) * (1.0f / DM) + EPS);
#pragma unroll
    for (int j = 0; j < 8; ++j) { const f32x4 g0 = *(const f32x4*)(gain + 512 * j + 8 * lane), g1 = *(const f32x4*)(gain + 512 * j + 8 * lane + 4);
        f32x4 o0, o1;
#pragma unroll
        for (int e = 0; e < 4; ++e) { o0[e] = v[8 * j + e] * rstd * g0[e]; o1[e] = v[8 * j + 4 + e] * rstd * g1[e]; }
        *(f32x4*)(orow + 512 * j + 8 * lane) = o0; *(f32x4*)(orow + 512 * j + 8 * lane + 4) = o1; }
}
__device__ __forceinline__ void prep_rows4(int m0, const bf16* PROJ, const float* cosT, const float* sinT, const float* dt_bias, unsigned long long* SSQ, bf16* KPE, float* DT, int lane) {
    v4u w[4][3]; unsigned short dtr[4];
#pragma unroll
    for (int r = 0; r < 4; ++r) { const bf16* pr = PROJ + (size_t)(m0 + r) * INCP;
        w[r][0] = *(const v4u*)(pr + 8 * lane); w[r][1] = *(const v4u*)(pr + 8 * (64 + lane));
        w[r][2] = lane < 56 ? *(const v4u*)(pr + 8 * (128 + lane)) : (v4u){0u, 0u, 0u, 0u};
        dtr[r] = lane < 32 ? pr[O_DT + lane] : (unsigned short)0; }
#pragma unroll
    for (int r = 0; r < 4; ++r) { const int m = m0 + r;
        float s0 = 0.f, s1 = 0.f, s2 = 0.f;
#pragma unroll
        for (int e = 0; e < 4; ++e) { float a = bflo(w[r][0][e]), b = bfhi(w[r][0][e]); s0 += a * a + b * b; a = bflo(w[r][1][e]); b = bfhi(w[r][1][e]); s1 += a * a + b * b; a = bflo(w[r][2][e]); b = bfhi(w[r][2][e]); s2 += a * a + b * b; }
        const float sq = wave_sum(s0 + (lane < 48 ? s1 : 0.f)), sk = wave_sum((lane < 48 ? 0.f : s1) + (lane < 48 ? s2 : 0.f));
        if (lane == 0) { SSQ[m] = (unsigned long long)(sq * 1048576.0f + 0.5f); SSQ[M + m] = (unsigned long long)(sk * 1048576.0f + 0.5f); }
        if (lane >= 48 && lane < 56) {
            const int ip = 4 * (lane - 48); const f32x4 cs = *(const f32x4*)(cosT + (size_t)m * 32 + ip), sn = *(const f32x4*)(sinT + (size_t)m * 32 + ip);
            v4u o;
#pragma unroll
            for (int e = 0; e < 4; ++e) { const float x1 = bflo(w[r][2][e]), x2 = bfhi(w[r][2][e]); o[e] = pk2(x1 * cs[e] - x2 * sn[e], x2 * cs[e] + x1 * sn[e]); }
            *(v4u*)(KPE + (size_t)m * 64 + 2 * ip) = o; }
        if (lane < 32) { const float v = bf1(dtr[r]) + dt_bias[lane]; DT[(size_t)m * 32 + lane] = fmaxf(v, 0.f) + log1pf(expf(-fabsf(v))); }
    }
}
__device__ __forceinline__ void conv_item(int item, const bf16* PROJ, const float* conv_w, const float* conv_b, bf16* XBC, int lane) {
    const int rr = item >> 3, sl = item & 7, ch0 = sl * 512 + lane * 8, m0 = rr * 32, t0 = m0 & (SEQ - 1);
    const bf16* src = PROJ + (size_t)m0 * INCP + O_XBC + ch0;
    bf16* dst = XBC + (size_t)m0 * 4096 + ch0;
    v4u x[35];
#pragma unroll
    for (int i = 0; i < 3; ++i) x[i] = t0 > 0 ? *(const v4u*)(src + (ptrdiff_t)(i - 3) * INCP) : (v4u){0u, 0u, 0u, 0u};
#pragma unroll
    for (int i = 0; i < 32; ++i) x[3 + i] = *(const v4u*)(src + (size_t)i * INCP);
    float w[4][8], bb[8];
#pragma unroll
    for (int k = 0; k < 4; ++k) { const f32x4 a = *(const f32x4*)(conv_w + k * CONVD + ch0), b2 = *(const f32x4*)(conv_w + k * CONVD + ch0 + 4);
#pragma unroll
        for (int e = 0; e < 4; ++e) { w[k][e] = a[e]; w[k][4 + e] = b2[e]; } }
    { const f32x4 a = *(const f32x4*)(conv_b + ch0), b2 = *(const f32x4*)(conv_b + ch0 + 4);
#pragma unroll
      for (int e = 0; e < 4; ++e) { bb[e] = a[e]; bb[4 + e] = b2[e]; } }
#pragma unroll
    for (int i = 0; i < 32; ++i) { v4u o;
#pragma unroll
        for (int e = 0; e < 4; ++e) {
            const float ya = bb[2 * e] + w[0][2 * e] * bflo(x[i][e]) + w[1][2 * e] * bflo(x[i + 1][e]) + w[2][2 * e] * bflo(x[i + 2][e]) + w[3][2 * e] * bflo(x[i + 3][e]);
            const float yc = bb[2 * e + 1] + w[0][2 * e + 1] * bfhi(x[i][e]) + w[1][2 * e + 1] * bfhi(x[i + 1][e]) + w[2][2 * e + 1] * bfhi(x[i + 2][e]) + w[3][2 * e + 1] * bfhi(x[i + 3][e]);
            o[e] = pk2(silu_f(ya), silu_f(yc)); }
        *(v4u*)(dst + (size_t)i * 4096) = o; }
}
template <int NR> __device__ __forceinline__ void gnorm_rows(bf16* row0, size_t rstride, const float* gw, int lane) {
    v4u w[NR][4];
#pragma unroll
    for (int r = 0; r < NR; ++r) { const v4u* p = (const v4u*)(row0 + r * rstride + 32 * lane);
#pragma unroll
        for (int j = 0; j < 4; ++j) w[r][j] = p[j]; }
    const float* g = gw + 32 * lane;
#pragma unroll
    for (int r = 0; r < NR; ++r) { float s = 0.f;
#pragma unroll
        for (int j = 0; j < 4; ++j)
#pragma unroll
            for (int e = 0; e < 4; ++e) { const float a = bflo(w[r][j][e]), b = bfhi(w[r][j][e]); s += a * a + b * b; }
        s += __shfl_xor(s, 1); s += __shfl_xor(s, 2); s += __shfl_xor(s, 4);
        const float rstd = 1.0f / sqrtf(s * (1.0f / 256.0f) + EPS);
        v4u* p = (v4u*)(row0 + r * rstride + 32 * lane);
#pragma unroll
        for (int j = 0; j < 4; ++j) { v4u o;
#pragma unroll
            for (int e = 0; e < 4; ++e) o[e] = pk2(bflo(w[r][j][e]) * rstd * g[8 * j + 2 * e], bfhi(w[r][j][e]) * rstd * g[8 * j + 2 * e + 1]);
            p[j] = o; } }
}
__device__ __forceinline__ void ssd_item(int item, const bf16* XBC, const float* DT, const bf16* PROJ, const float* a_log, const float* d_skip, bf16* MIXo, int lane) {
    const int pi = lane >> 4, ns = lane & 15;
    const int b = item >> 9, h = (item >> 4) & 31, pq = item & 15, g = h >> 2;
    const float A2 = -expf(a_log[h]) * 1.4426950408889634f, Dk = d_skip[h];
    const int pcol = h * 64 + pq * 4 + pi;
    float st[8];
#pragma unroll
    for (int k = 0; k < 8; ++k) st[k] = 0.f;
    const bf16* xb = XBC + (size_t)b * SEQ * 4096; const float* dtp = DT + (size_t)b * SEQ * 32 + h;
    const bf16* zp = PROJ + (size_t)b * SEQ * INCP + O_Z + pcol; bf16* op = MIXo + (size_t)b * SEQ * 4096 + 2048 + pcol;
#pragma unroll 4
    for (int t = 0; t < SEQ; ++t) {
        const bf16* xr = xb + (size_t)t * 4096;
        const float dtv = dtp[(size_t)t * 32];
        const float xv = bf1(xr[pcol]);
        const v4u Bw = *(const v4u*)(xr + 2048 + g * 128 + ns * 8);
        const v4u Cw = *(const v4u*)(xr + 3072 + g * 128 + ns * 8);
        const float zv = bf1(zp[(size_t)t * INCP]);
        const float dA = __builtin_amdgcn_exp2f(dtv * A2), xdt = dtv * xv;
        float part = 0.f;
#pragma unroll
        for (int e = 0; e < 4; ++e) {
            st[2 * e] = dA * st[2 * e] + xdt * bflo(Bw[e]); part += bflo(Cw[e]) * st[2 * e];
            st[2 * e + 1] = dA * st[2 * e + 1] + xdt * bfhi(Bw[e]); part += bfhi(Cw[e]) * st[2 * e + 1]; }
        part += __shfl_xor(part, 1); part += __shfl_xor(part, 2); part += __shfl_xor(part, 4); part += __shfl_xor(part, 8);
        if (ns == 0) op[(size_t)t * 4096] = (bf16)f2bf((part + Dk * xv) * silu_f(zv));
    }
}
__device__ __forceinline__ int dst_row(int kind, int n) {
    if (kind == 1) return ((n >> 7) << 8) + (n & 127);
    if (kind == 2) return ((n >> 7) << 8) + 128 + (n & 127);
    if (kind == 3) { const int hh = n / QKD, j = n - hh * QKD; if (j < NOPE) return n; const int i = j - NOPE; return hh * QKD + NOPE + (i < 32 ? 2 * i : 2 * (i - 32) + 1); }
    if (kind == 4) { if (n < O_KPE || n >= O_KPE + ROPE) return n; const int i = n - O_KPE; return O_KPE + (i < 32 ? 2 * i : 2 * (i - 32) + 1); }
    return n;
}
__device__ __forceinline__ void p0_transpose_item(const float* W, int K, int N, bf16* WT, int kind, const float* gain, LAS float* scr, int item, int lane) {
    const bool f16w = false;
    const int nblk = N / 32, kb = item / nblk, nb = item - kb * nblk, k0 = 64 * kb, n0 = 32 * nb;
    float v[32];
    const float* wp = W + (size_t)(k0 + (lane >> 5)) * N + n0 + (lane & 31);
#pragma unroll
    for (int i = 0; i < 32; ++i) v[i] = wp[(size_t)(2 * i) * N];
    const int c = lane & 7;
    f32x4 g0 = (f32x4){1.f, 1.f, 1.f, 1.f}, g1 = g0;
    if (gain) { g0 = *(const f32x4*)(gain + k0 + 8 * c); g1 = *(const f32x4*)(gain + k0 + 8 * c + 4); }
#pragma unroll
    for (int i = 0; i < 32; ++i) scr[(2 * i + (lane >> 5)) * 33 + (lane & 31)] = v[i];
    LDS_WAIT(); asm volatile("" ::: "memory");
#pragma unroll
    for (int j = 0; j < 4; ++j) { const int n = (lane >> 3) + 8 * j; const LAS float* s = scr + (8 * c) * 33 + n;
        const float e0 = s[0 * 33] * g0[0], e1 = s[1 * 33] * g0[1], e2 = s[2 * 33] * g0[2], e3 = s[3 * 33] * g0[3], e4 = s[4 * 33] * g1[0], e5 = s[5 * 33] * g1[1], e6 = s[6 * 33] * g1[2], e7 = s[7 * 33] * g1[3];
        v4u o; if (f16w) { o.x = pkh2(e0, e1); o.y = pkh2(e2, e3); o.z = pkh2(e4, e5); o.w = pkh2(e6, e7); } else { o.x = pk2(e0, e1); o.y = pk2(e2, e3); o.z = pk2(e4, e5); o.w = pk2(e6, e7); }
        *(v4u*)(WT + (size_t)dst_row(kind, n0 + n) * K + k0 + 8 * c) = o; }
    LDS_WAIT(); asm volatile("" ::: "memory");
}
struct InPtrs { const float* p[24]; };
#ifndef DEFER_D2
#define DEFER_D2 1
#endif
constexpr int IT_FFN = (DM / 64) * (FF / 32);
constexpr int IT_IN = (DM / 64) * (INC / 32);
constexpr int IT_QU = (QL / 64) * (QW / 32);
constexpr int IT_KVU = (KVL / 64) * (KVW / 32);
constexpr int IT_O = (DM / 64) * (DM / 32);
constexpr int IT_LAYER = 6 * IT_FFN + IT_IN + IT_QU + IT_KVU + IT_O;
__device__ __forceinline__ void p0_prologue(Frame& F, const InPtrs& in, unsigned char* ws, int lane) {
    LAS float* scr = (LAS float*)(F.lds + RING_OFF + F.wave * 16384);
    const int gw = F.vcu * NWAVES + F.wave, NGW = F.G * NWAVES;
    for (int it = gw; it < DEPTH * IT_LAYER; it += NGW) {
        const int l = it / IT_LAYER; int r = it - l * IT_LAYER;
        unsigned char* wl = ws + WS_W + (size_t)l * W_LAYER;
        const size_t lFF = (size_t)l * DM * FF;
        if (r < IT_FFN) { p0_transpose_item(in.p[3] + lFF, DM, FF, (bf16*)(wl + W_GU1), 1, in.p[2] + (size_t)l * DM, scr, r, lane); continue; } r -= IT_FFN;
        if (r < IT_FFN) { p0_transpose_item(in.p[4] + lFF, DM, FF, (bf16*)(wl + W_GU1), 2, in.p[2] + (size_t)l * DM, scr, r, lane); continue; } r -= IT_FFN;
        if (r < IT_FFN) { p0_transpose_item(in.p[5] + lFF, FF, DM, (bf16*)(wl + W_D1), 0, nullptr, scr, r, lane); continue; } r -= IT_FFN;
        if (r < IT_IN) { p0_transpose_item(in.p[7] + (size_t)l * DM * INC, DM, INC, (bf16*)(wl + W_IN), 4, in.p[6] + (size_t)l * DM, scr, r, lane); continue; } r -= IT_IN;
        if (r < IT_QU) { p0_transpose_item(in.p[9] + (size_t)l * QL * QW, QL, QW, (bf16*)(wl + W_QU), 3, in.p[8] + (size_t)l * QL, scr, r, lane); continue; } r -= IT_QU;
        if (r < IT_KVU) { p0_transpose_item(in.p[11] + (size_t)l * KVL * KVW, KVL, KVW, (bf16*)(wl + W_KVU), 0, in.p[10] + (size_t)l * KVL, scr, r, lane); continue; } r -= IT_KVU;
        if (r < IT_O) { p0_transpose_item(in.p[18] + (size_t)l * DM * DM, DM, DM, (bf16*)(wl + W_O), 0, nullptr, scr, r, lane); continue; } r -= IT_O;
        if (r < IT_FFN) { if (!(l >= 1 && DEFER_D2 >= 2)) p0_transpose_item(in.p[20] + lFF, DM, FF, (bf16*)(wl + W_GU2), 1, in.p[19] + (size_t)l * DM, scr, r, lane); continue; } r -= IT_FFN;
        if (r < IT_FFN) { p0_transpose_item(in.p[21] + lFF, DM, FF, (bf16*)(wl + W_GU2), 2, in.p[19] + (size_t)l * DM, scr, r, lane); continue; } r -= IT_FFN;
        if (l >= 1 && DEFER_D2) continue;
        p0_transpose_item(in.p[22] + lFF, FF, DM, (bf16*)(wl + W_D2), 0, nullptr, scr, r, lane);
    }
    const int gt = gw * 64 + lane, NGT = NGW * 64;
    for (int i = gt; i < DEPTH * 16384; i += NGT) { const int l = i >> 14, j = i & 16383;
        *(v4u*)(ws + WS_W + (size_t)l * W_LAYER + W_IN + (size_t)INC * DM * 2 + (size_t)j * 16) = (v4u){0u, 0u, 0u, 0u}; }
    const int* pos = (const int*)in.p[1]; float* cosT = (float*)(ws + WS_COS); float* sinT = (float*)(ws + WS_SIN);
    float invf;
    {   const double y = -(double)(lane & 31) * 0.28782313662425575;
        const double kd = __builtin_rint(y * 1.4426950408889634);
        double r = __builtin_fma(-kd, 0.6931471803691238, y); r = __builtin_fma(-kd, 1.9082149292705877e-10, r);
        double e = 1.0;
#pragma unroll
        for (int k = 18; k >= 1; --k) e = 1.0 + e * r * (1.0 / (double)k);
        invf = (float)__builtin_ldexp(e, (int)kd); }
    for (int i = gt; i < M * 32; i += NGT) { const int m = i >> 5;
        const float ang = (float)pos[m] * invf;
        const double x = (double)ang, n = __builtin_rint(x * 0.15915494309189535);
        double r = __builtin_fma(-n, 6.283185307179586, x); r = __builtin_fma(-n, 2.4492935982947064e-16, r);
        const double r2 = r * r; double sn = 1.0, cs = 1.0;
#pragma unroll
        for (int k = 14; k >= 1; --k) { sn = 1.0 - sn * r2 * (1.0 / (double)((2 * k) * (2 * k + 1))); cs = 1.0 - cs * r2 * (1.0 / (double)((2 * k - 1) * (2 * k))); }
        cosT[i] = (float)cs; sinT[i] = (float)(sn * r); }
    for (int m = gw; m < M; m += NGW) row_copy_ss(in.p[0] + (size_t)m * DM, (bf16*)(ws + WS_XN) + (size_t)m * DM, (unsigned long long*)(ws + WS_SS) + m, lane);
}
#ifndef REP_GEMM
#define REP_GEMM 1
#endif
#ifndef REP_RES
#define REP_RES 1
#endif
#ifndef REP_BAR
#define REP_BAR 0
#endif
#ifndef REP_ATT
#define REP_ATT 1
#endif
#ifndef REP_SSD
#define REP_SSD 1
#endif
#ifndef REP_THIN
#define REP_THIN 1
#endif
#ifndef DBG_EN
#define DBG_EN 0xffff
#endif
constexpr int PH_PER_LAYER = 9, N_PHASES = 1 + PH_PER_LAYER * DEPTH + 1;
struct Args { const float* in[24]; float* out; unsigned char* ws; int ph_lo, ph_hi; };
static_assert(sizeof(Args) == 24 * 8 + 16 + 8, "Args has no holes");

__global__ void __launch_bounds__(NTHREADS, 2) trunk_fwd(Args args) {
    extern __shared__ __attribute__((aligned(16))) unsigned char lds[];
    Frame F;
    F.lds = (LAS unsigned char*)lds;
    F.MISC = (volatile LAS unsigned*)(F.lds + MISC_OFF);
    F.wave = __builtin_amdgcn_readfirstlane(threadIdx.x >> 6);
    F.G = gridDim.x; { const int bx = blockIdx.x; F.vcu = (F.G % 8 == 0) ? (bx % 8) * (F.G / 8) + bx / 8 : bx; }
    unsigned char* ws = args.ws;
    F.ctl = (gu32*)(ws + WS_CTL);
    for (int u = threadIdx.x; u < (LDS_BYTES - LDSCTL_OFF) / 4; u += NTHREADS) ((LAS unsigned*)(F.lds + LDSCTL_OFF))[u] = 0u;
    __syncthreads();
    XcdBarrier bar; bar.bar = (unsigned*)(F.ctl + CW_BAR); bar.x = 0; bar.st = nullptr;
    if (MK_ONE_LAUNCH) bar = xcd_barrier_post((unsigned*)(F.ctl + CW_BAR), F.MISC + 8);
#define GRID_BAR() do { if (MK_ONE_LAUNCH) xcd_barrier(bar); } while (0)
    const int lo = args.ph_lo, hi = args.ph_hi;
#define IN(k) (lo <= (k) && (k) < hi)
#ifndef XBAR
#define XBAR 0
#endif
#define SEAM(k) do { if (IN((k) + 1)) { GRID_BAR(); for (int xb_ = 0; xb_ < XBAR; ++xb_) GRID_BAR(); } } while (0)
#define LANE_L() ({ int l_ = threadIdx.x; asm volatile("" : "+v"(l_)); l_ & 63; })
#define PH_VARS() const int ln = LANE_L(); int gw_ = F.vcu * NWAVES + F.wave; asm volatile("" : "+s"(gw_)); const int gw = gw_, NGW = F.G * NWAVES; (void)ln; (void)gw; (void)NGW

    bf16* XB = (bf16*)(ws + WS_XN); bf16* HB = (bf16*)(ws + WS_BIG); bf16* PROJ = (bf16*)(ws + WS_BIG);
    bf16* KPE = (bf16*)(ws + WS_KPE); float* DT = (float*)(ws + WS_DT); unsigned long long* SSQ = (unsigned long long*)(ws + WS_SSQ); unsigned long long* SS = (unsigned long long*)(ws + WS_SS);
    bf16* XBC = (bf16*)(ws + WS_XBC); bf16* QB = (bf16*)(ws + WS_Q); bf16* KVB = (bf16*)(ws + WS_KV); bf16* MIX = (bf16*)(ws + WS_MIX);
    const float* cosT = (const float*)(ws + WS_COS); const float* sinT = (const float*)(ws + WS_SIN);

    if ((DBG_EN & 1) && IN(0)) { PH_VARS(); InPtrs ip;
#pragma unroll
        for (int i = 0; i < 24; ++i) ip.p[i] = args.in[i];
        for (int rep = 0; rep < REP_THIN; ++rep) p0_prologue(F, ip, ws, ln); SEAM(0); }

    for (int l = 0; l < DEPTH; ++l) {
        const int pb = 1 + PH_PER_LAYER * l;
        unsigned char* wl = ws + WS_W + (size_t)l * W_LAYER;
        for (int f = 0; f < 2; ++f) {
            if (f == 1) {
                if ((DBG_EN & 4) && IN(pb + 2)) { PH_VARS(); pg8::Gemm g{XB, (const bf16*)(wl + W_IN), M, INCP, DM, DM, DM}; pg8::StaticOrder S; S.init(M, INCP, F.G, (int)blockIdx.x);
                    pg8::EpiStore E{PROJ, INCP, SS + (size_t)(3 * l + 1) * M, 1.0f / DM};
                    for (int rep = 0; rep < REP_GEMM; ++rep) { if (REP_BAR && rep) GRID_BAR(); pg8::gemm_phase<pg8::EpiStore, pg8::StaticOrder, PG8_ALIGN, PG8_SP2>(F.lds + RING_OFF, g, S, E); }
                    if (DEFER_D2 && l + 1 < DEPTH && F.G == 256 && blockIdx.x >= 128) {
                        LAS float* scr = (LAS float*)(F.lds + RING_OFF + F.wave * 16384);
                        bf16* wt = (bf16*)(ws + WS_W + (size_t)(l + 1) * W_LAYER + W_D2); const float* wsrc = args.in[22] + (size_t)(l + 1) * DM * FF;
                        for (int it = ((int)blockIdx.x - 128) * NWAVES + F.wave; it < IT_FFN; it += 128 * NWAVES) p0_transpose_item(wsrc, FF, DM, wt, 0, nullptr, scr, it, ln);
                        if (DEFER_D2 >= 2) { bf16* wg = (bf16*)(ws + WS_W + (size_t)(l + 1) * W_LAYER + W_GU2); const float* gsrc = args.in[20] + (size_t)(l + 1) * DM * FF; const float* gg = args.in[19] + (size_t)(l + 1) * DM;
                            for (int it = ((int)blockIdx.x - 128) * NWAVES + F.wave; it < IT_FFN; it += 128 * NWAVES) p0_transpose_item(gsrc, DM, FF, wg, 1, gg, scr, it, ln); }
                    } else if (DEFER_D2 && l + 1 < DEPTH && F.G != 256) {
                        LAS float* scr = (LAS float*)(F.lds + RING_OFF + F.wave * 16384);
                        bf16* wt = (bf16*)(ws + WS_W + (size_t)(l + 1) * W_LAYER + W_D2); const float* wsrc = args.in[22] + (size_t)(l + 1) * DM * FF;
                        for (int it = gw; it < IT_FFN; it += NGW) p0_transpose_item(wsrc, FF, DM, wt, 0, nullptr, scr, it, ln);
                        if (DEFER_D2 >= 2) { bf16* wg = (bf16*)(ws + WS_W + (size_t)(l + 1) * W_LAYER + W_GU2); const float* gsrc = args.in[20] + (size_t)(l + 1) * DM * FF; const float* gg = args.in[19] + (size_t)(l + 1) * DM;
                            for (int it = gw; it < IT_FFN; it += NGW) p0_transpose_item(gsrc, DM, FF, wg, 1, gg, scr, it, ln); }
                    }
                    SEAM(pb + 2); }
                if ((DBG_EN & 8) && IN(pb + 3)) { PH_VARS();
                    for (int rep = 0; rep < REP_THIN; ++rep) for (int m = 4 * gw; m < M; m += 4 * NGW) prep_rows4(m, PROJ, cosT, sinT, args.in[14] + (size_t)l * SSD_H, SSQ, KPE, DT, ln);
                    for (int rep = 0; rep < REP_THIN; ++rep) for (int it = gw; it < (M / 32) * 8; it += NGW) conv_item(it, PROJ, args.in[12] + (size_t)l * 4 * CONVD, args.in[13] + (size_t)l * CONVD, XBC, ln);
                    SEAM(pb + 3); }
                if ((DBG_EN & 16) && IN(pb + 4)) { PH_VARS();
                    for (int rep = 0; rep < REP_SSD; ++rep) for (int u = F.vcu; u < BATCH * SSD_H * 2; u += F.G) ssd::ssd_unit(u, XBC, DT, PROJ, args.in[15] + (size_t)l * SSD_H, args.in[16] + (size_t)l * SSD_H, MIX, F.lds + RING_OFF);
                    for (int s2 = 0; s2 < 2; ++s2) {
                        const int kk = s2 ? KVL : QL, nn = s2 ? KVW : QW;
                        pg8::Gemm g{PROJ + (s2 ? O_CKV : O_CQ), (const bf16*)(wl + (s2 ? W_KVU : W_QU)), M, nn, kk, INCP, kk}; pg8::StaticOrder S; S.init(M, nn, F.G, (int)blockIdx.x);
                        pg8::EpiStore E{s2 ? KVB : QB, nn, SSQ + (size_t)s2 * M, 1.0f / (float)kk};
                        for (int rep = 0; rep < REP_GEMM; ++rep) { if (REP_BAR && rep) GRID_BAR(); pg8::gemm_phase<pg8::EpiStore, pg8::StaticOrder, PG8_ALIGN, PG8_SP2>(F.lds + RING_OFF, g, S, E); } }
                    SEAM(pb + 4); }
                if ((DBG_EN & 32) && IN(pb + 5)) { PH_VARS();
                    for (int rep = 0; rep < REP_ATT; ++rep) for (int u = F.vcu; u < BATCH * NH * 8; u += F.G) { const int bh = u >> 3, xq = u & 7;
                        att::attn_block(bh >> 4, bh & 15, xq, QB, KVB, KPE, cosT, sinT, MIX, F.lds + RING_OFF);
                        att::attn_block(bh >> 4, bh & 15, 15 - xq, QB, KVB, KPE, cosT, sinT, MIX, F.lds + RING_OFF); }
                    { const float* g = args.in[17] + (size_t)l * SSD_W;
                      for (int m = 4 * gw; m < M; m += 4 * NGW) gnorm_rows<4>(MIX + (size_t)m * 4096 + 2048, 4096, g, ln); }
                    SEAM(pb + 5); }
                if ((DBG_EN & 128) && IN(pb + 6)) { PH_VARS(); pg8::Gemm g{MIX, (const bf16*)(wl + W_O), M, DM, DM, DM, DM}; pg8::StaticOrder S; S.init(M, DM, F.G, (int)blockIdx.x);
                    for (int rep = 0; rep < REP_RES; ++rep) { pg8::EpiResid E{XB, rep ? (unsigned long long*)(ws + WS_SSP) : SS + (size_t)(3 * l + 2) * M, DM, rep == 0 ? 1.0f : 0.0f};
                    pg8::gemm_phase<pg8::EpiResid, pg8::StaticOrder, PG8_ALIGN, PG8_SP2>(F.lds + RING_OFF, g, S, E); }
                    SEAM(pb + 6); }
            }
            const int fb = pb + 7 * f;
            if ((DBG_EN & 512) && IN(fb)) { PH_VARS(); pg8::Gemm g{XB, (const bf16*)(wl + (f ? W_GU2 : W_GU1)), M, 2 * FF, DM, DM, DM}; pg8::StaticOrder S; S.init(M, 2 * FF, F.G, (int)blockIdx.x);
                pg8::EpiSwiGLU E{HB, FF, SS + (size_t)(3 * l + 2 * f) * M, 1.0f / DM};
                for (int rep = 0; rep < REP_GEMM; ++rep) { if (REP_BAR && rep) GRID_BAR(); pg8::gemm_phase<pg8::EpiSwiGLU, pg8::StaticOrder, PG8_ALIGN, PG8_SP2>(F.lds + RING_OFF, g, S, E); }
                SEAM(fb); }
            if ((DBG_EN & 1024) && IN(fb + 1)) { PH_VARS(); pg8::Gemm g{HB, (const bf16*)(wl + (f ? W_D2 : W_D1)), M, DM, FF, FF, FF}; pg8::StaticOrder S; S.init(M, DM, F.G, (int)blockIdx.x);
                for (int rep = 0; rep < REP_RES; ++rep) { pg8::EpiResid E{XB, rep ? (unsigned long long*)(ws + WS_SSP) : SS + (size_t)(3 * l + 2 * f + 1) * M, DM, rep == 0 ? 0.5f : 0.0f};
                pg8::gemm_phase<pg8::EpiResid, pg8::StaticOrder, PG8_ALIGN, PG8_SP2>(F.lds + RING_OFF, g, S, E); }
                SEAM(fb + 1); }
        }
    }
    if ((DBG_EN & 2048) && IN(N_PHASES - 1)) { PH_VARS(); for (int m = gw; m < M; m += NGW) rms_row_out(XB + (size_t)m * DM, args.in[23], args.out + (size_t)m * DM, ln); }
#undef IN
#undef SEAM
#undef GRID_BAR
}

extern "C" void kernel_launch(void* const* d_in, const int* in_sizes, int n_in, void* d_out, int out_size, void* d_ws, size_t ws_size, hipStream_t stream) {
    static int grid = 0;
    if (grid == 0) {
        if (n_in != 24 || in_sizes[0] != M * DM || out_size != M * DM || ws_size < WS_END) {
            fprintf(stderr, "kernel_launch: built for 24 inputs, x/out of %d floats, >= %zu bytes of workspace; got n_in %d, in0 %d, out %d, ws %zu; nothing launched\n", M * DM, (size_t)WS_END, n_in, n_in > 0 ? in_sizes[0] : -1, out_size, ws_size);
            grid = -1; return; }
        int dev = 0, cus = 0, per_cu = 0;
        if (hipGetDevice(&dev) != hipSuccess || hipDeviceGetAttribute(&cus, hipDeviceAttributeMultiprocessorCount, dev) != hipSuccess) { fprintf(stderr, "kernel_launch: device query failed\n"); grid = -1; return; }
        if (hipFuncSetAttribute((const void*)trunk_fwd, hipFuncAttributeMaxDynamicSharedMemorySize, LDS_BYTES) != hipSuccess) { fprintf(stderr, "kernel_launch: hipFuncSetAttribute failed\n"); grid = -1; return; }
        if (hipOccupancyMaxActiveBlocksPerMultiprocessor(&per_cu, (const void*)trunk_fwd, NTHREADS, LDS_BYTES) != hipSuccess || per_cu < 1)
            fprintf(stderr, "kernel_launch: note: occupancy query reports %d workgroups per CU\n", per_cu);
        (void)hipGetLastError();
        grid = cus;
    }
    if (grid < 0) return;
    if (hipMemsetAsync((char*)d_ws + WS_CTL, 0, CTL_ZERO_BYTES, stream) != hipSuccess) { fprintf(stderr, "kernel_launch: memset failed\n"); return; }
    Args a{};
    for (int i = 0; i < 24; ++i) a.in[i] = (const float*)d_in[i];
    a.out = (float*)d_out; a.ws = (unsigned char*)d_ws;
#if MK_ONE_LAUNCH
    a.ph_lo = 0; a.ph_hi = N_PHASES;
    hipLaunchKernelGGL(trunk_fwd, dim3(grid), dim3(NTHREADS), LDS_BYTES, stream, a);
#else
    for (int p = 0; p < N_PHASES; ++p) { a.ph_lo = p; a.ph_hi = p + 1; hipLaunchKernelGGL(trunk_fwd, dim3(grid), dim3(NTHREADS), LDS_BYTES, stream, a); }
#endif
    const hipError_t le = hipPeekAtLastError();
    if (le != hipSuccess) fprintf(stderr, "kernel_launch: launch failed: %s\n", hipGetErrorName(le));
}
```

```cpp
#include <hip/hip_runtime.h>
#include <cstdio>
#include <cstdint>

#ifndef MK_ONE_LAUNCH
#define MK_ONE_LAUNCH 1
#endif

constexpr int BATCH = 4, SEQ = 4096, DM = 4096, DEPTH = 4, FF = 6144;
constexpr int M = BATCH * SEQ;
constexpr int NH = 16, QL = 896, KVL = 512, NOPE = 128, ROPE = 64, VH = 128, QKD = NOPE + ROPE;
constexpr int QW = NH * QKD;
constexpr int KVW = NH * (NOPE + VH);
constexpr int SSD_P = 64, SSD_H = 32, SSD_G = 8, SSD_N = 128, SSD_W = 2048, CONVD = 4096;
constexpr int INC = 7648, INCP = 7680;
constexpr int O_CQ = 0, O_CKV = 896, O_KPE = 1408, O_Z = 1472, O_XBC = 3520, O_DT = 7616;
constexpr float EPS = 1e-6f;
constexpr int NWAVES = 8, NTHREADS = NWAVES * 64;

constexpr size_t MiB = 1u << 20;
constexpr size_t WS_CTL = 0, CTL_ZERO_BYTES = 3 * MiB;
constexpr size_t WS_SS = 1 * MiB;
constexpr int N_SS = 3 * DEPTH + 1;
static_assert(WS_SS + (size_t)N_SS * M * 8 <= CTL_ZERO_BYTES, "ss arrays inside the memset region");
constexpr size_t WS_COS = 3 * MiB, WS_SIN = 5 * MiB;
constexpr size_t WS_SSQ = 7 * MiB;
constexpr size_t WS_X = 8 * MiB;
constexpr size_t WS_XN = 264 * MiB;
constexpr size_t WS_BIG = 392 * MiB;
constexpr size_t WS_SSP = 632 * MiB;
constexpr size_t WS_KPE = 676 * MiB;
constexpr size_t WS_DT = 678 * MiB;
constexpr size_t WS_XBC = 680 * MiB;
constexpr size_t WS_Q = 808 * MiB;
constexpr size_t WS_KV = 904 * MiB;
constexpr size_t WS_MIX = 1032 * MiB;
constexpr size_t WS_W = 1160 * MiB;
constexpr size_t W_GU1 = 0, W_D1 = 96 * MiB, W_IN = 144 * MiB, W_QU = 204 * MiB, W_KVU = 210 * MiB, W_O = 214 * MiB, W_GU2 = 246 * MiB, W_D2 = 342 * MiB, W_LAYER = 390 * MiB;
constexpr size_t WS_END = WS_W + DEPTH * W_LAYER;
static_assert(WS_BIG + (size_t)M * INCP * 2 <= WS_SSP && WS_SSP + (size_t)M * 64 * 4 <= WS_KPE && WS_XBC + (size_t)M * 4096 * 2 <= WS_Q && WS_Q + (size_t)M * QW * 2 <= WS_KV, "d_ws map");
constexpr int CW_TMO = 0, CW_CODE = 1, CW_BAR = 4096;

constexpr int RING_OFF = 0, RING_BYTES = 131072;
constexpr int LDSCTL_OFF = RING_BYTES, MISC_OFF = LDSCTL_OFF + 320, RSTAB_OFF = LDSCTL_OFF + 1024;
static_assert(RSTAB_OFF + 2048 * 4 <= 147456, "LDS map");
constexpr int LDS_BYTES = 147456;

#define GAS __attribute__((address_space(1)))
#define LAS __attribute__((address_space(3)))
typedef unsigned short bf16;
typedef unsigned v4u __attribute__((ext_vector_type(4)));
typedef unsigned v2u __attribute__((ext_vector_type(2)));
typedef float f32x4 __attribute__((ext_vector_type(4)));
typedef float f32x2 __attribute__((ext_vector_type(2)));
typedef float f32x16 __attribute__((ext_vector_type(16)));
typedef short bf16x8 __attribute__((ext_vector_type(8)));
typedef short s16x4 __attribute__((ext_vector_type(4)));
typedef GAS unsigned gu32;
#define RLX_AGENT __ATOMIC_RELAXED, __HIP_MEMORY_SCOPE_AGENT
#define LDS_WAIT() asm volatile("s_waitcnt lgkmcnt(0)" ::: "memory")
#define VM_WAIT() asm volatile("s_waitcnt vmcnt(0)" ::: "memory")
__device__ __forceinline__ unsigned f2bf(float f) { unsigned u = __builtin_bit_cast(unsigned, f); return (u + 0x7fffu + ((u >> 16) & 1u)) >> 16; }
__device__ __forceinline__ unsigned pk2(float lo, float hi) { return f2bf(lo) | (f2bf(hi) << 16); }
__device__ __forceinline__ float bflo(unsigned w) { return __builtin_bit_cast(float, w << 16); }
__device__ __forceinline__ float bfhi(unsigned w) { return __builtin_bit_cast(float, w & 0xffff0000u); }
__device__ __forceinline__ float bf1(bf16 b) { return __builtin_bit_cast(float, (unsigned)b << 16); }
typedef _Float16 h16x2 __attribute__((ext_vector_type(2)));
__device__ __forceinline__ unsigned pkh2(float lo, float hi) { f32x2 v = {lo, hi}; h16x2 h = __builtin_convertvector(v, h16x2); return __builtin_bit_cast(unsigned, h); }
__device__ __forceinline__ float hlo(unsigned w) { return (float)__builtin_bit_cast(h16x2, w)[0]; }
__device__ __forceinline__ float hhi(unsigned w) { return (float)__builtin_bit_cast(h16x2, w)[1]; }
__device__ __forceinline__ float wave_sum(float v) {
#pragma unroll
    for (int o = 1; o < 64; o <<= 1) v += __shfl_xor(v, o);
    return v;
}
__device__ __forceinline__ float fast_exp(float x) { return __builtin_amdgcn_exp2f(x * 1.4426950408889634f); }
__device__ __forceinline__ float silu_f(float x) { return x * __builtin_amdgcn_rcpf(1.0f + fast_exp(-x)); }
#define XB_TMO      128
#define XB_XCNT(j)  (256  + 64 * (j))
#define XB_XSUB(j)  (1280 + 64 * (j))
#define XB_XGEN(j)  (2304 + 64 * (j))
#define XB_TOP      3328
#define XB_TOPGEN   3392
#define XCD_BAR_WORDS 3456
#define XB_SPIN_CAP (1u << 18)

__device__ __forceinline__ unsigned xb_ld(unsigned* p)              { return __hip_atomic_load(p, __ATOMIC_RELAXED, __HIP_MEMORY_SCOPE_AGENT); }
__device__ __forceinline__ unsigned xb_add(unsigned* p, unsigned v) { return __hip_atomic_fetch_add(p, v, __ATOMIC_RELAXED, __HIP_MEMORY_SCOPE_AGENT); }
__device__ __forceinline__ unsigned xb_xcc_id() { return (unsigned)__builtin_amdgcn_s_getreg((3 << 11) | 20) & 0xFu; }
#define XB_SPIN(cond, bar) do { unsigned _sp = 0; while (cond) { __builtin_amdgcn_s_sleep(1); \
    if ((++_sp & 255u) == 0u) { if (xb_ld(&(bar)[XB_TMO])) break; if (_sp > XB_SPIN_CAP) { atomicAdd(&(bar)[XB_TMO], 1u); break; } } } } while (0)

struct XcdBarrier {
    unsigned* bar; unsigned x;
    volatile LAS unsigned* st;
};

__device__ __forceinline__ XcdBarrier xcd_barrier_post(unsigned* bar, volatile LAS unsigned* st) {
    XcdBarrier b; b.bar = bar; b.x = xb_xcc_id(); b.st = st;
    if (threadIdx.x == 0) (void)xb_add(&bar[XB_XCNT(b.x)], 1u);
    return b;
}
__device__ __forceinline__ void xcd_barrier_complete(unsigned* bar, unsigned x, unsigned& nloc, unsigned& nx) {
    const unsigned G = gridDim.x * gridDim.y * gridDim.z;
    unsigned sum, cnt, mine, sp = 0u;
    for (;;) {
        sum = 0u; cnt = 0u; mine = 0u;
#pragma unroll
        for (unsigned j = 0; j < 16; ++j) { const unsigned c = xb_ld(&bar[XB_XCNT(j)]); sum += c; cnt += (c > 0u) ? 1u : 0u; mine = (j == x) ? c : mine; }
        if (sum == G) break;
        __builtin_amdgcn_s_sleep(1);
        if ((++sp & 255u) == 0u) { if (xb_ld(&bar[XB_TMO])) break; if (sp > XB_SPIN_CAP) { atomicAdd(&bar[XB_TMO], 1u); break; } }
    }
    nloc = mine > 0u ? mine : 1u; nx = cnt > 0u ? cnt : 1u;
}

__device__ __forceinline__ void xcd_barrier(const XcdBarrier& b) {
    asm volatile("s_waitcnt vmcnt(0)" ::: "memory");
    __syncthreads();
    if (threadIdx.x == 0) {
        unsigned* bar = b.bar;
        __builtin_amdgcn_s_waitcnt(0);
        unsigned nloc = b.st[0], nx = b.st[1];
        if (nloc == 0u) { xcd_barrier_complete(bar, b.x, nloc, nx); b.st[0] = nloc; b.st[1] = nx; }
        const unsigned old = xb_add(&bar[XB_XSUB(b.x)], 1u);
        const unsigned gen = old / nloc;
        if (old + 1u == (gen + 1u) * nloc) {
            __builtin_amdgcn_fence(__ATOMIC_RELEASE, "agent");
            asm volatile("s_waitcnt vmcnt(0)" ::: "memory");
            const unsigned og = xb_add(&bar[XB_TOP], 1u);
            const unsigned tg = og / nx;
            if (og + 1u == (tg + 1u) * nx) xb_add(&bar[XB_TOPGEN], 1u);
            else XB_SPIN(xb_ld(&bar[XB_TOPGEN]) == tg, bar);
            __builtin_amdgcn_fence(__ATOMIC_ACQUIRE, "agent");
            xb_add(&bar[XB_XGEN(b.x)], 1u);
            asm volatile("s_waitcnt vmcnt(0)" ::: "memory");
        } else {
            XB_SPIN(xb_ld(&bar[XB_XGEN(b.x)]) == gen, bar);
            __builtin_amdgcn_fence(__ATOMIC_ACQUIRE, "agent");
            asm volatile("s_waitcnt vmcnt(0)" ::: "memory");
        }
    }
    __syncthreads();
}
namespace pg8 {
#define PG8_LAS __attribute__((address_space(3)))
typedef unsigned short bf16_t;
typedef short bf16x8 __attribute__((ext_vector_type(8)));
typedef float f32x4 __attribute__((ext_vector_type(4)));
typedef unsigned u32x4 __attribute__((ext_vector_type(4)));
typedef _Float16 h16x8 __attribute__((ext_vector_type(8)));
constexpr int BM = 256, BK = 64, HALF = 128, HTB = HALF * BK * 2  , STAGE_BYTES = 8 * HTB, NXCD = 8, WGM = 8;

__host__ __device__ __forceinline__ int lds_byte(int r, int c) { const int st = (r >> 4) * 2 + (c >> 5), rr = r & 15, cc = c & 31, ob = rr * 64 + cc * 2; return st * 1024 + (ob ^ (((ob >> 9) & 1) << 5)); }
__host__ __device__ __forceinline__ void stage_rc(int b, int& R, int& C) { const int st = b / 1024, sb = b % 1024, swz = sb ^ (((sb >> 9) & 1) << 5); R = (st >> 1) * 16 + swz / 64; C = (st & 1) * 32 + (swz % 64) / 2; }
__host__ __device__ __forceinline__ int perm32(int rho) { const int n = rho >> 4, i = rho & 15; return 8 * (i >> 2) + 4 * n + (i & 3); }

struct Unit { int pm, pn; };
struct Gemm { const bf16_t* A; const bf16_t* Bt; int M, N, K, lda, ldb; };

struct StaticOrder {
    int nM, nN, nwg, G, c;
    __host__ __device__ void init(int M, int N, int G_, int c_) { nM = M / BM; nN = N / BM; nwg = nM * nN; G = G_; c = c_; }
    __host__ __device__ bool next(int i, Unit& u) const {
        const long L = (long)i * G + c; if (L >= nwg) return false;
        int wgid = (int)L; { const int q = nwg / NXCD, r = nwg % NXCD, xcd = wgid % NXCD, off = wgid / NXCD; wgid = (xcd < r ? xcd * (q + 1) : r * (q + 1) + (xcd - r) * q) + off; }
        const int nig = WGM * nN, gid = wgid / nig, fm = gid * WGM, gsz = (nM - fm) < WGM ? (nM - fm) : WGM;
        u.pm = fm + ((wgid % nig) % gsz); u.pn = (wgid % nig) / gsz; return true;
    }
    __device__ __forceinline__ void a_ready(const Unit&) const {}
    __device__ __forceinline__ void done(const Unit&) const {}
};

__device__ __forceinline__ unsigned cvt_pk_bf16(float lo, float hi) { unsigned r; asm volatile("v_cvt_pk_bf16_f32 %0, %1, %2" : "=v"(r) : "v"(lo), "v"(hi)); return r; }

__device__ __forceinline__ float row_rstd(const unsigned long long* ss, int row, float inv_n) { return 1.0f / sqrtf((float)ss[row] * (inv_n * 9.5367431640625e-07f) + 1e-6f); }
struct RowFac { const PG8_LAS float* tab;
    __device__ __forceinline__ float get(int row) const { return tab[row]; } };
struct EpiStore {
    static constexpr bool PERM = true, AFTER_DRAIN = false;
    bf16_t* O; int ldc; RowFac rf;
    __device__ __forceinline__ void operator()(const f32x4 (&acc)[2][2][4][2], const Unit& u, int wr, int wc, int fr, int fq) const {
        const int row0 = u.pm * BM + wr * 64 + fr, col0 = u.pn * BM + wc * 32 + 8 * fq;
#pragma unroll
        for (int ai = 0; ai < 2; ++ai)
#pragma unroll
            for (int m = 0; m < 4; ++m) { const int row = row0 + ai * HALF + m * 16; bf16_t* rowp = O + (size_t)row * ldc + col0;
                const float rs = rf.get(row);
#pragma unroll
                for (int bj = 0; bj < 2; ++bj) { const f32x4 v0 = acc[ai][bj][m][0] * rs, v1 = acc[ai][bj][m][1] * rs;
                    u32x4 w; w.x = cvt_pk_bf16(v0[0], v0[1]); w.y = cvt_pk_bf16(v0[2], v0[3]); w.z = cvt_pk_bf16(v1[0], v1[1]); w.w = cvt_pk_bf16(v1[2], v1[3]);
                    *(u32x4*)(rowp + bj * HALF) = w; } }
    }
};
struct EpiSwiGLU {
    static constexpr bool PERM = true, AFTER_DRAIN = false;
    bf16_t* O; int ldc; RowFac rf;
    __device__ __forceinline__ void operator()(const f32x4 (&acc)[2][2][4][2], const Unit& u, int wr, int wc, int fr, int fq) const {
        const int row0 = u.pm * BM + wr * 64 + fr, col0 = u.pn * HALF + wc * 32 + 8 * fq;
#pragma unroll
        for (int ai = 0; ai < 2; ++ai)
#pragma unroll
            for (int m = 0; m < 4; ++m) { const int row = row0 + ai * HALF + m * 16; bf16_t* rowp = O + (size_t)row * ldc + col0;
                const float rs = rf.get(row);
                float h[8];
#pragma unroll
                for (int n = 0; n < 2; ++n)
#pragma unroll
                    for (int i = 0; i < 4; ++i) { const float g = acc[ai][0][m][n][i] * rs, up = acc[ai][1][m][n][i] * rs;
                        h[n * 4 + i] = g * up * __builtin_amdgcn_rcpf(1.0f + __builtin_amdgcn_exp2f(g * -1.4426950408889634f)); }
                u32x4 w; w.x = cvt_pk_bf16(h[0], h[1]); w.y = cvt_pk_bf16(h[2], h[3]); w.z = cvt_pk_bf16(h[4], h[5]); w.w = cvt_pk_bf16(h[6], h[7]);
                *(u32x4*)rowp = w; }
    }
};
struct EpiResid {
    static constexpr bool PERM = true, AFTER_DRAIN = false;
    bf16_t* xb; unsigned long long* ssn; int ldc; float alpha;
    __device__ __forceinline__ void operator()(const f32x4 (&acc)[2][2][4][2], const Unit& u, int wr, int wc, int fr, int fq) const {
        const int row0 = u.pm * BM + wr * 64 + fr, col0 = u.pn * BM + wc * 32 + 8 * fq;
#pragma unroll
        for (int ai = 0; ai < 2; ++ai)
#pragma unroll
            for (int m = 0; m < 4; ++m) { const int row = row0 + ai * HALF + m * 16; bf16_t* rowp = xb + (size_t)row * ldc + col0; float sq = 0.f;
#pragma unroll
                for (int bj = 0; bj < 2; ++bj) { const u32x4 b = *(const u32x4*)(rowp + bj * HALF);
                    float v[8];
#pragma unroll
                    for (int e = 0; e < 4; ++e) { v[2 * e] = __builtin_bit_cast(float, b[e] << 16) + acc[ai][bj][m][e >> 1][2 * (e & 1)] * alpha;
                                                  v[2 * e + 1] = __builtin_bit_cast(float, b[e] & 0xffff0000u) + acc[ai][bj][m][e >> 1][2 * (e & 1) + 1] * alpha; }
#pragma unroll
                    for (int e = 0; e < 8; ++e) sq += v[e] * v[e];
                    u32x4 w; w.x = cvt_pk_bf16(v[0], v[1]); w.y = cvt_pk_bf16(v[2], v[3]); w.z = cvt_pk_bf16(v[4], v[5]); w.w = cvt_pk_bf16(v[6], v[7]);
                    *(u32x4*)(rowp + bj * HALF) = w; }
                sq += __shfl_xor(sq, 16); sq += __shfl_xor(sq, 32);
                if (fq == 0) __hip_atomic_fetch_add(ssn + row, (unsigned long long)(sq * 1048576.0f + 0.5f), __ATOMIC_RELAXED, __HIP_MEMORY_SCOPE_AGENT); }
    }
};

template <class Epi, class Sched, bool ALIGN_EPI = false, bool SP2 = false, bool F16 = false>
__device__ __forceinline__ void gemm_phase(PG8_LAS unsigned char* lds, const Gemm g, const Sched& S, const Epi& E) {
    __builtin_amdgcn_s_waitcnt(0);
    int tid_l = threadIdx.x; asm volatile("" : "+v"(tid_l));
    const int tid = tid_l, wid = __builtin_amdgcn_readfirstlane(tid >> 6), lane = tid & 63, wr = wid >> 2, wc = wid & 3, fr = lane & 15, fq = lane >> 4;
    const int K = g.K, nt = K / BK, lda = g.lda, ldb = g.ldb;
    unsigned voffA[2], voffB[2];
#pragma unroll
    for (int i = 0; i < 2; ++i) { int R, C; stage_rc(tid * 16 + i * 8192, R, C); const int Rb = Epi::PERM ? ((R & ~31) + perm32(R & 31)) : R;
        voffA[i] = (unsigned)(R * lda + C) * 2u; voffB[i] = (unsigned)(Rb * ldb + C) * 2u; }
    const size_t kstep = (size_t)(BK * 2);
    const size_t hstepA = (size_t)HALF * lda * 2, hstepB = (size_t)HALF * ldb * 2;
    const size_t tstepA = 2 * hstepA, tstepB = 2 * hstepB;
    const unsigned ldsw = (unsigned)wid * 1024u;
    const int aoff = lds_byte(wr * 64 + fr, fq * 8), boff = lds_byte(wc * 32 + fr, fq * 8);
#define PG8_SA(b, h) (((b) * 2 + (h)) * HTB)
#define PG8_SB(b, h) ((4 + (b) * 2 + (h)) * HTB)
#define PG8_STAGE(bufoff, gbase, voff) do { _Pragma("unroll") for (int _i = 0; _i < 2; ++_i) \
        __builtin_amdgcn_global_load_lds((const unsigned*)((const char*)(gbase) + (voff)[_i]), (PG8_LAS unsigned*)(lds + (bufoff) + ldsw + _i * 8192), 16, 0, 0); } while (0)
#define PG8_LDA(dst, b, h) do { _Pragma("unroll") for (int m = 0; m < 4; ++m) _Pragma("unroll") for (int k = 0; k < 2; ++k) dst[m][k] = *(const PG8_LAS bf16x8*)(lds + PG8_SA(b, h) + aoff + m * 2048 + k * 1024); } while (0)
#define PG8_LDB(dst, b, h) do { _Pragma("unroll") for (int n = 0; n < 2; ++n) _Pragma("unroll") for (int k = 0; k < 2; ++k) dst[n][k] = *(const PG8_LAS bf16x8*)(lds + PG8_SB(b, h) + boff + n * 2048 + k * 1024); } while (0)
#define PG8_MMA(ai, bj, At, Bt) do { __builtin_amdgcn_s_setprio(1); _Pragma("unroll") for (int m = 0; m < 4; ++m) _Pragma("unroll") for (int n = 0; n < 2; ++n) _Pragma("unroll") for (int k = 0; k < 2; ++k) \
        acc[ai][bj][m][n] = F16 ? __builtin_amdgcn_mfma_f32_16x16x32_f16(__builtin_bit_cast(h16x8, Bt[n][k]), __builtin_bit_cast(h16x8, At[m][k]), acc[ai][bj][m][n], 0, 0, 0) \
                                : __builtin_amdgcn_mfma_f32_16x16x32_bf16(Bt[n][k], At[m][k], acc[ai][bj][m][n], 0, 0, 0); __builtin_amdgcn_s_setprio(0); } while (0)
#define PG8_WAIT_V(n) asm volatile("s_waitcnt vmcnt(" #n ")" ::: "memory")
#define PG8_WAIT_L(n) asm volatile("s_waitcnt lgkmcnt(" #n ")" ::: "memory")
#define PG8_BAR __builtin_amdgcn_s_barrier()
#define PG8_SCHED __builtin_amdgcn_sched_barrier(0)
    Unit cur, nxt; int ui = 0;
    if (!S.next(0, cur)) return;
    f32x4 acc[2][2][4][2];
#pragma unroll
    for (int a = 0; a < 2; ++a)
#pragma unroll
        for (int b = 0; b < 2; ++b)
#pragma unroll
            for (int m = 0; m < 4; ++m)
#pragma unroll
                for (int n = 0; n < 2; ++n) acc[a][b][m][n] = (f32x4){0.f, 0.f, 0.f, 0.f};
    bf16x8 At[4][2], B0[2][2], B1[2][2];
    const char* cA = (const char*)g.A + (size_t)cur.pm * tstepA; const char* cB = (const char*)g.Bt + (size_t)cur.pn * tstepB;
    S.a_ready(cur);
    if constexpr (SP2) {
        PG8_STAGE(PG8_SB(0, 0), cB, voffB); PG8_STAGE(PG8_SB(0, 1), cB + hstepB, voffB); PG8_STAGE(PG8_SA(0, 0), cA, voffA); PG8_STAGE(PG8_SA(0, 1), cA + hstepA, voffA);
        if (wr == 1) PG8_BAR;
        PG8_WAIT_V(2); PG8_BAR;
        PG8_STAGE(PG8_SB(1, 0), cB + kstep, voffB); PG8_STAGE(PG8_SA(1, 0), cA + kstep, voffA); PG8_STAGE(PG8_SB(1, 1), cB + hstepB + kstep, voffB);
        PG8_WAIT_V(6); PG8_BAR;
    } else {
        PG8_STAGE(PG8_SB(0, 0), cB, voffB); PG8_STAGE(PG8_SA(0, 0), cA, voffA); PG8_STAGE(PG8_SB(0, 1), cB + hstepB, voffB); PG8_STAGE(PG8_SA(0, 1), cA + hstepA, voffA);
        if (wr == 1) PG8_BAR;
        PG8_WAIT_V(4); PG8_BAR;
        PG8_STAGE(PG8_SB(1, 0), cB + kstep, voffB); PG8_STAGE(PG8_SA(1, 0), cA + kstep, voffA); PG8_STAGE(PG8_SB(1, 1), cB + hstepB + kstep, voffB);
        PG8_WAIT_V(6); PG8_BAR;
    }
    for (;;) {
        const bool has_next = S.next(ui + 1, nxt);
        const char* nA = has_next ? (const char*)g.A + (size_t)nxt.pm * tstepA : cA; const char* nB = has_next ? (const char*)g.Bt + (size_t)nxt.pn * tstepB : cB;
        for (int t = 0; t < nt; t += 2) {
            const bool last = (t == nt - 2);
            const char* a1 = cA + (size_t)(t + 1) * kstep;
            const char* a2 = last ? nA : cA + (size_t)(t + 2) * kstep; const char* b2 = last ? nB : cB + (size_t)(t + 2) * kstep;
            const char* a3 = a2 + kstep; const char* b3 = b2 + kstep;
            if (last && has_next) S.a_ready(nxt);
            if constexpr (SP2) {
            PG8_LDB(B0, 0, 0); PG8_LDB(B1, 0, 1); PG8_SCHED; PG8_LDA(At, 0, 0); PG8_STAGE(PG8_SA(1, 1), a1 + hstepA, voffA);
            PG8_WAIT_V(8); PG8_WAIT_L(0); PG8_BAR; PG8_MMA(0, 0, At, B0); PG8_MMA(0, 1, At, B1); PG8_BAR; PG8_SCHED;
            PG8_LDA(At, 0, 1); PG8_STAGE(PG8_SB(0, 0), b2, voffB); PG8_STAGE(PG8_SB(0, 1), b2 + hstepB, voffB); PG8_STAGE(PG8_SA(0, 0), a2, voffA);
            PG8_WAIT_V(8); PG8_WAIT_L(0); PG8_BAR; PG8_MMA(1, 0, At, B0); PG8_MMA(1, 1, At, B1); PG8_BAR; PG8_SCHED;
            PG8_LDB(B0, 1, 0); PG8_LDB(B1, 1, 1); PG8_SCHED; PG8_LDA(At, 1, 0); PG8_STAGE(PG8_SA(0, 1), a2 + hstepA, voffA);
            PG8_WAIT_V(8); PG8_WAIT_L(0); PG8_BAR; PG8_MMA(0, 0, At, B0); PG8_MMA(0, 1, At, B1); PG8_BAR; PG8_SCHED;
            PG8_LDA(At, 1, 1); PG8_STAGE(PG8_SB(1, 0), b3, voffB); PG8_STAGE(PG8_SB(1, 1), b3 + hstepB, voffB); PG8_STAGE(PG8_SA(1, 0), a3, voffA);
            PG8_WAIT_V(8); PG8_WAIT_L(0); PG8_BAR; PG8_MMA(1, 0, At, B0); PG8_MMA(1, 1, At, B1); PG8_BAR; PG8_SCHED;
            } else {
            PG8_LDB(B0, 0, 0); PG8_SCHED; PG8_LDA(At, 0, 0); PG8_STAGE(PG8_SA(1, 1), a1 + hstepA, voffA);
            PG8_WAIT_L(8); PG8_BAR; PG8_WAIT_L(0); PG8_MMA(0, 0, At, B0); PG8_BAR; PG8_SCHED;
            PG8_LDB(B1, 0, 1); PG8_STAGE(PG8_SB(0, 0), b2, voffB);
            PG8_BAR; PG8_WAIT_L(0); PG8_MMA(0, 1, At, B1); PG8_BAR;
            PG8_LDA(At, 0, 1); PG8_STAGE(PG8_SA(0, 0), a2, voffA);
            PG8_BAR; PG8_WAIT_L(0); PG8_MMA(1, 0, At, B0); PG8_BAR; PG8_SCHED;
            PG8_STAGE(PG8_SB(0, 1), b2 + hstepB, voffB);
            PG8_WAIT_V(6); PG8_BAR; PG8_MMA(1, 1, At, B1); PG8_BAR;
            PG8_LDB(B0, 1, 0); PG8_SCHED; PG8_LDA(At, 1, 0); PG8_STAGE(PG8_SA(0, 1), a2 + hstepA, voffA);
            PG8_WAIT_L(8); PG8_BAR; PG8_WAIT_L(0); PG8_MMA(0, 0, At, B0); PG8_BAR; PG8_SCHED;
            PG8_LDB(B1, 1, 1); PG8_STAGE(PG8_SB(1, 0), b3, voffB);
            PG8_BAR; PG8_WAIT_L(0); PG8_MMA(0, 1, At, B1); PG8_BAR;
            PG8_LDA(At, 1, 1); PG8_STAGE(PG8_SA(1, 0), a3, voffA);
            PG8_BAR; PG8_WAIT_L(0); PG8_MMA(1, 0, At, B0); PG8_BAR; PG8_SCHED;
            PG8_STAGE(PG8_SB(1, 1), b3 + hstepB, voffB);
            PG8_WAIT_V(6); PG8_BAR; PG8_MMA(1, 1, At, B1); PG8_BAR;
            }
        }
        if constexpr (ALIGN_EPI) { if (wr == 0) PG8_BAR; }
        if constexpr (!Epi::AFTER_DRAIN) { E(acc, cur, wr, wc, fr, fq); S.done(cur); }
        if (!has_next) break;
#pragma unroll
        for (int a = 0; a < 2; ++a)
#pragma unroll
            for (int b = 0; b < 2; ++b)
#pragma unroll
                for (int m = 0; m < 4; ++m)
#pragma unroll
                    for (int n = 0; n < 2; ++n) acc[a][b][m][n] = (f32x4){0.f, 0.f, 0.f, 0.f};
        cur = nxt; cA = nA; cB = nB; ++ui;
        if constexpr (ALIGN_EPI) { if (wr == 1) PG8_BAR; }
    }
    PG8_WAIT_V(0);
    if constexpr (!ALIGN_EPI) { if (wr == 0) PG8_BAR; }
    PG8_BAR;
    if constexpr (Epi::AFTER_DRAIN) { E.fused(acc, cur, wr, wc, fr, fq, lds, wid, lane); S.done(cur); }
#undef PG8_SA
#undef PG8_SB
#undef PG8_STAGE
#undef PG8_LDA
#undef PG8_LDB
#undef PG8_MMA
#undef PG8_WAIT_V
#undef PG8_WAIT_L
#undef PG8_BAR
#undef PG8_SCHED
}
}
#ifndef PG8_SP2
#define PG8_SP2 true
#endif
#ifndef PG8_ALIGN
#define PG8_ALIGN true
#endif
namespace att {
constexpr int KSTR = 400, VSTR = 320;
constexpr int KBUF = 64 * KSTR, VBUF = 64 * VSTR;
constexpr int OFF_K = 0, OFF_V = 2 * KBUF, OFF_WS = OFF_V + 2 * VBUF, LDS_NEED = OFF_WS + NWAVES * 256;
constexpr float C2 = 0.07216878364870322f * 1.4426950408889634f;
static_assert(LDS_NEED <= RING_BYTES, "attention LDS");
typedef float f32x2_t __attribute__((ext_vector_type(2))); typedef __bf16 bf16x2_t __attribute__((ext_vector_type(2)));
typedef short v4i16_t __attribute__((ext_vector_type(4)));
__device__ __forceinline__ unsigned cvtpk(float lo, float hi) { f32x2_t v = {lo, hi}; bf16x2_t b = __builtin_convertvector(v, bf16x2_t); return __builtin_bit_cast(unsigned, b); }
__device__ __forceinline__ s16x4 trd(const LAS unsigned char* p) { return __builtin_bit_cast(s16x4, __builtin_amdgcn_ds_read_tr16_b64_v4i16((LAS v4i16_t*)p)); }
__device__ __forceinline__ int crow(int r, int hi) { return (r & 3) + 8 * (r >> 2) + 4 * hi; }
#define ATT_MFMA(a, b, c) __builtin_amdgcn_mfma_f32_32x32x16_bf16((a), (b), (c), 0, 0, 0)

__device__ __forceinline__ void attn_block(int b, int h, int qb, const bf16* __restrict__ Q, const bf16* __restrict__ KV, const bf16* __restrict__ KPE, const float* __restrict__ cosT, const float* __restrict__ sinT, bf16* __restrict__ MIXo, LAS unsigned char* lds) {
    int tid_l = threadIdx.x; asm volatile("" : "+v"(tid_l));
    const int tid = tid_l, lane = tid & 63, c = lane & 31, hi = lane >> 5;
    const int wid = __builtin_amdgcn_readfirstlane(tid >> 6);
    const size_t rowbase = (size_t)b * SEQ; const int q0 = qb * 256, qlo = q0 + wid * 32;
    const int NT = 4 * qb + 4;
    const bf16* qrow = Q + (rowbase + qlo + c) * QW + h * QKD + 8 * hi;
    bf16x8 qr[12];
#pragma unroll
    for (int d = 0; d < 12; ++d) qr[d] = *(const bf16x8*)(qrow + 16 * d);
    {
        const float* ct = cosT + (rowbase + qlo + c) * 32 + 4 * hi; const float* st = sinT + (rowbase + qlo + c) * 32 + 4 * hi;
#pragma unroll
        for (int dd = 0; dd < 4; ++dd) { const f32x4 cs = *(const f32x4*)(ct + 8 * dd), sn = *(const f32x4*)(st + 8 * dd);
            v4u w = __builtin_bit_cast(v4u, qr[8 + dd]);
#pragma unroll
            for (int e = 0; e < 4; ++e) { const float x1 = bflo(w[e]), x2 = bfhi(w[e]); w[e] = cvtpk(x1 * cs[e] - x2 * sn[e], x2 * cs[e] + x1 * sn[e]); }
            qr[8 + dd] = __builtin_bit_cast(bf16x8, w); }
    }
    const int kkey = tid >> 4, kch = tid & 15, pkey = tid >> 3, pch = tid & 7;
    const bf16* gk = KV + (rowbase + kkey) * KVW + h * 256 + kch * 8;
    const bf16* gv = gk + 128;
    const bf16* gp = KPE + (rowbase + pkey) * 64 + pch * 8;
    const int lk0 = kkey * KSTR + kch * 16, lk1 = lk0 + 32 * KSTR, lp = pkey * KSTR + 256 + pch * 16;
    const int lv0 = kkey * VSTR + kch * 16, lv1 = lv0 + 32 * VSTR;
    v4u sk0, sk1, sp, sv0, sv1;
#define ATT_LOAD(t) do { const size_t o_ = (size_t)(t) * 64 * KVW; sk0 = *(const v4u*)(gk + o_); sk1 = *(const v4u*)(gk + o_ + 32 * KVW); \
        sv0 = *(const v4u*)(gv + o_); sv1 = *(const v4u*)(gv + o_ + 32 * KVW); sp = *(const v4u*)(gp + (size_t)(t) * 64 * 64); } while (0)
#define ATT_WRITE(bi) do { LAS unsigned char* kb_ = lds + OFF_K + (bi) * KBUF; LAS unsigned char* vb_ = lds + OFF_V + (bi) * VBUF; \
        *(LAS v4u*)(kb_ + lk0) = sk0; *(LAS v4u*)(kb_ + lk1) = sk1; *(LAS v4u*)(kb_ + lp) = sp; *(LAS v4u*)(vb_ + lv0) = sv0; *(LAS v4u*)(vb_ + lv1) = sv1; } while (0)
    LAS float* wsf = (LAS float*)(lds + OFF_WS) + wid * 64;
    float m_run = -1e30f, l_run = 0.f;
    f32x16 o[4];
#pragma unroll
    for (int d0 = 0; d0 < 4; ++d0)
#pragma unroll
        for (int r = 0; r < 16; ++r) o[d0][r] = 0.f;
    const int i16 = lane & 15, qq = i16 >> 2, pp = i16 & 3, blk = (lane >> 4) & 1;
    const int voff = (4 * hi + qq) * VSTR + 32 * blk + 8 * pp;
    const int koff = c * KSTR + hi * 16;
    ATT_LOAD(0); ATT_WRITE(0); __syncthreads();
    for (int t = 0; t < NT; ++t) {
        const int cur = t & 1, kb0 = 64 * t;
        if (t + 1 < NT) ATT_LOAD(t + 1);
        if (kb0 <= qlo + 31) {
            f32x16 p0, p1;
#pragma unroll
            for (int r = 0; r < 16; ++r) { p0[r] = 0.f; p1[r] = 0.f; }
            const LAS unsigned char* kp = lds + OFF_K + cur * KBUF + koff;
#pragma unroll
            for (int dg = 0; dg < 3; ++dg) {
                bf16x8 k0[4], k1[4];
#pragma unroll
                for (int j = 0; j < 4; ++j) { k0[j] = *(const LAS bf16x8*)(kp + (4 * dg + j) * 32); k1[j] = *(const LAS bf16x8*)(kp + 32 * KSTR + (4 * dg + j) * 32); }
                __builtin_amdgcn_sched_barrier(0);
#pragma unroll
                for (int j = 0; j < 4; ++j) { p0 = ATT_MFMA(k0[j], qr[4 * dg + j], p0); p1 = ATT_MFMA(k1[j], qr[4 * dg + j], p1); }
            }
            if (kb0 + 63 > qlo) {
                const int dq = qlo + c - kb0 - 4 * hi; const float NEG = -__builtin_inff();
#pragma unroll
                for (int r = 0; r < 16; ++r) { const int cr = (r & 3) + 8 * (r >> 2); if (cr > dq) p0[r] = NEG; if (cr + 32 > dq) p1[r] = NEG; }
            }
            float mx = p0[0];
#pragma unroll
            for (int r = 1; r < 16; ++r) mx = fmaxf(mx, p0[r]);
#pragma unroll
            for (int r = 0; r < 16; ++r) mx = fmaxf(mx, p1[r]);
            mx = fmaxf(mx, __shfl_xor(mx, 32));
            float mn = m_run, alpha = 1.0f;
            if (!__all((mx - m_run) * C2 <= 6.0f)) { mn = fmaxf(m_run, mx); alpha = __builtin_amdgcn_exp2f((m_run - mn) * C2); m_run = mn; }
            const float mnc = mn * C2;
            float rs = 0.f;
#pragma unroll
            for (int r = 0; r < 16; ++r) { p0[r] = __builtin_amdgcn_exp2f(p0[r] * C2 - mnc); p1[r] = __builtin_amdgcn_exp2f(p1[r] * C2 - mnc); rs += p0[r] + p1[r]; }
            rs += __shfl_xor(rs, 32);
            l_run = l_run * alpha + rs;
            if (__any(alpha < 1.0f)) {
                if (hi == 0) wsf[c] = alpha;
                LDS_WAIT();
#pragma unroll
                for (int r = 0; r < 16; ++r) { const float a = wsf[crow(r, hi)];
#pragma unroll
                    for (int d0 = 0; d0 < 4; ++d0) o[d0][r] *= a; }
            }
            const LAS unsigned char* vp = lds + OFF_V + cur * VBUF + voff;
#pragma unroll
            for (int kb = 0; kb < 2; ++kb)
#pragma unroll
                for (int s = 0; s < 2; ++s) {
                    v4u pw;
                    if (kb == 0) { pw.x = cvtpk(p0[8 * s + 0], p0[8 * s + 1]); pw.y = cvtpk(p0[8 * s + 2], p0[8 * s + 3]); pw.z = cvtpk(p0[8 * s + 4], p0[8 * s + 5]); pw.w = cvtpk(p0[8 * s + 6], p0[8 * s + 7]); }
                    else         { pw.x = cvtpk(p1[8 * s + 0], p1[8 * s + 1]); pw.y = cvtpk(p1[8 * s + 2], p1[8 * s + 3]); pw.z = cvtpk(p1[8 * s + 4], p1[8 * s + 5]); pw.w = cvtpk(p1[8 * s + 6], p1[8 * s + 7]); }
                    const bf16x8 pa = __builtin_bit_cast(bf16x8, pw);
                    s16x4 lo[4], hh[4];
#pragma unroll
                    for (int d0 = 0; d0 < 4; ++d0) { lo[d0] = trd(vp + (32 * kb + 16 * s) * VSTR + 64 * d0); hh[d0] = trd(vp + (32 * kb + 16 * s + 8) * VSTR + 64 * d0); }
                    __builtin_amdgcn_sched_barrier(0);
#pragma unroll
                    for (int d0 = 0; d0 < 4; ++d0) o[d0] = ATT_MFMA(pa, __builtin_shufflevector(lo[d0], hh[d0], 0, 1, 2, 3, 4, 5, 6, 7), o[d0]);
                }
        }
        if (t + 1 < NT) ATT_WRITE(cur ^ 1);
        __syncthreads();
    }
    if (hi == 0) wsf[32 + c] = l_run;
    LDS_WAIT();
    bf16* ob = MIXo + (rowbase + qlo) * 4096 + h * 128 + c;
#pragma unroll
    for (int r = 0; r < 16; ++r) { const int orow = crow(r, hi); const float rl = 1.0f / wsf[32 + orow];
#pragma unroll
        for (int d0 = 0; d0 < 4; ++d0) { const float v = o[d0][r] * rl, vn = __shfl_xor(v, 1);
            if ((c & 1) == 0) *(unsigned*)(ob + (size_t)orow * 4096 + d0 * 32) = pk2(v, vn); } }
    LDS_WAIT();
#undef ATT_LOAD
#undef ATT_WRITE
}
}
namespace ssd {
constexpr int RS = 272;
constexpr int BUF = 128 * RS + 128 * 64 + 2560;
constexpr int OFF_X = 128 * RS, OFF_SC = OFF_X + 128 * 64, OFF_S = 2 * BUF;
constexpr int SC_ACS = 0, SC_DT = 512, SC_ECS = 1024, SC_WEND = 1536, SC_ETOT = 2048, LDS_NEED = OFF_S + 2 * 32 * RS;
static_assert(LDS_NEED <= RING_BYTES && BUF % 16 == 0, "ssd LDS");
constexpr float LOG2E = 1.4426950408889634f;
#define SSD_MFMA(a, b, c) __builtin_amdgcn_mfma_f32_32x32x16_bf16((a), (b), (c), 0, 0, 0)
#define SSD_BAR() do { asm volatile("s_waitcnt lgkmcnt(0)" ::: "memory"); __builtin_amdgcn_s_barrier(); asm volatile("" ::: "memory"); } while (0)

__device__ __forceinline__ void ssd_unit(int unit, const bf16* __restrict__ XBC, const float* __restrict__ DT, const bf16* __restrict__ PROJ, const float* a_log, const float* d_skip,
                                         bf16* __restrict__ MIXo, LAS unsigned char* lds) {
    int tid_l = threadIdx.x; asm volatile("" : "+v"(tid_l));
    const int tid = tid_l, lane = tid & 63, c = lane & 31, hi = lane >> 5;
    const int wid = __builtin_amdgcn_readfirstlane(tid >> 6);
    const int b = unit >> 6, h = (unit >> 1) & 31, ph = unit & 1, g = h >> 2, pcol0 = h * 64 + 32 * ph;
    const float A2 = -expf(a_log[h]) * LOG2E, Dk = d_skip[h];
    const size_t mb = (size_t)b * SEQ;
    LAS unsigned char* Ss = lds + OFF_S;
    const int srow = tid >> 4, sch = tid & 15, xrow = tid >> 2, xch = tid & 3;
    const bf16* gB = XBC + (mb + srow) * 4096 + 2048 + g * 128 + sch * 8;
    const bf16* gX = XBC + (mb + xrow) * 4096 + pcol0 + xch * 8;
    const float* gD = DT + (mb + 2 * lane) * 32 + h;
    const bf16* gCf = XBC + (mb + 32 * (wid & 3) + c) * 4096 + 3072 + g * 128 + 8 * hi;
    const int lcb = srow * RS + sch * 16, lx = OFF_X + xrow * 64 + xch * 16;
    v4u sb0, sb1, sb2, sb3, sx; float sd0 = 0.f, sd1 = 0.f;
#define SSD_LOAD(ch) do { const size_t o_ = (size_t)(ch) * 128 * 4096; \
        sb0 = *(const v4u*)(gB + o_); sb1 = *(const v4u*)(gB + o_ + 32 * 4096); sb2 = *(const v4u*)(gB + o_ + 64 * 4096); sb3 = *(const v4u*)(gB + o_ + 96 * 4096); \
        sx = *(const v4u*)(gX + o_); if (wid == 0) { sd0 = gD[(size_t)(ch) * 128 * 32]; sd1 = gD[(size_t)(ch) * 128 * 32 + 32]; } } while (0)
#define SSD_WRITE(bufp) do { LAS unsigned char* wb_ = (bufp); \
        *(LAS v4u*)(wb_ + lcb) = sb0; *(LAS v4u*)(wb_ + lcb + 32 * RS) = sb1; *(LAS v4u*)(wb_ + lcb + 64 * RS) = sb2; *(LAS v4u*)(wb_ + lcb + 96 * RS) = sb3; \
        *(LAS v4u*)(wb_ + lx) = sx; \
        if (wid == 0) {     \
            LAS float* sc_ = (LAS float*)(wb_ + OFF_SC); \
            const float a0_ = sd0 * A2, a1_ = sd1 * A2, pr_ = a0_ + a1_; float inc_ = pr_; \
            _Pragma("unroll") for (int o_ = 1; o_ < 64; o_ <<= 1) { const float v_ = __shfl_up(inc_, o_); if (lane >= o_) inc_ += v_; } \
            const float cs0_ = inc_ - pr_ + a0_, cs1_ = inc_, tot_ = __shfl(inc_, 63); \
            *(LAS f32x2*)(sc_ + SC_ACS / 4 + 2 * lane) = (f32x2){cs0_, cs1_}; *(LAS f32x2*)(sc_ + SC_DT / 4 + 2 * lane) = (f32x2){sd0, sd1}; \
            *(LAS f32x2*)(sc_ + SC_ECS / 4 + 2 * lane) = (f32x2){__builtin_amdgcn_exp2f(cs0_), __builtin_amdgcn_exp2f(cs1_)}; \
            *(LAS f32x2*)(sc_ + SC_WEND / 4 + 2 * lane) = (f32x2){sd0 * __builtin_amdgcn_exp2f(tot_ - cs0_), sd1 * __builtin_amdgcn_exp2f(tot_ - cs1_)}; \
            if (lane == 63) sc_[SC_ETOT / 4] = __builtin_amdgcn_exp2f(tot_); } } while (0)
    const int i16 = lane & 15, qq = i16 >> 2, pp = i16 & 3, blk = (lane >> 4) & 1;
    f32x16 ST;
#pragma unroll
    for (int r = 0; r < 16; ++r) ST[r] = 0.f;
    bf16x8 cfn[8];
#pragma unroll
    for (int ks = 0; ks < 8; ++ks) cfn[ks] = *(const bf16x8*)(gCf + 16 * ks);
    SSD_LOAD(0); SSD_WRITE(lds);
    for (int i = tid; i < (32 * RS) / 16; i += NTHREADS) *(LAS v4u*)(Ss + i * 16) = (v4u){0u, 0u, 0u, 0u};
    SSD_BAR();
    for (int ch = 0; ch < SEQ / 128; ++ch) {
        const int chn = ch + 1 < SEQ / 128 ? ch + 1 : ch;
        SSD_LOAD(chn);
        const size_t m0 = mb + (size_t)ch * 128;
        LAS unsigned char* cb = lds + (ch & 1) * BUF;
        LAS unsigned char* Bs = cb; LAS unsigned char* Xs = cb + OFF_X;
        LAS float* acs = (LAS float*)(cb + OFF_SC + SC_ACS); LAS float* dtv = (LAS float*)(cb + OFF_SC + SC_DT); LAS float* ecs = (LAS float*)(cb + OFF_SC + SC_ECS);
        LAS float* wend = (LAS float*)(cb + OFF_SC + SC_WEND); LAS float* etot = (LAS float*)(cb + OFF_SC + SC_ETOT);
        if (wid < 4) {
            const int lb = wid;
            unsigned short zr[16];
            { const bf16* zp = PROJ + (m0 + 32 * lb + 4 * hi) * INCP + O_Z + pcol0 + c;
#pragma unroll
              for (int r = 0; r < 16; ++r) zr[r] = zp[(size_t)((r & 3) + 8 * (r >> 2)) * INCP]; }
            bf16x8 cf[8];
#pragma unroll
            for (int ks = 0; ks < 8; ++ks) cf[ks] = cfn[ks];
#pragma unroll
            for (int ks = 0; ks < 8; ++ks) cfn[ks] = *(const bf16x8*)(gCf + (size_t)chn * 128 * 4096 + 16 * ks);
            f32x16 y;
#pragma unroll
            for (int r = 0; r < 16; ++r) y[r] = 0.f;
            { const LAS unsigned char* sp = Ss + (ch & 1) * 32 * RS + c * RS + hi * 16; bf16x8 sf[8];
#pragma unroll
              for (int ks = 0; ks < 8; ++ks) sf[ks] = *(const LAS bf16x8*)(sp + ks * 32);
              __builtin_amdgcn_sched_barrier(0);
#pragma unroll
              for (int ks = 0; ks < 8; ++ks) y = SSD_MFMA(cf[ks], sf[ks], y); }
#pragma unroll
            for (int g4 = 0; g4 < 4; ++g4) { const f32x4 e = *(const LAS f32x4*)(ecs + 32 * lb + 8 * g4 + 4 * hi);
#pragma unroll
                for (int i = 0; i < 4; ++i) y[4 * g4 + i] *= e[i]; }
            const float acl = acs[32 * lb + c];
            for (int sb = 0; sb <= lb; ++sb) {
                f32x16 gt;
#pragma unroll
                for (int r = 0; r < 16; ++r) gt[r] = 0.f;
                const LAS unsigned char* bp = Bs + (32 * sb + c) * RS + hi * 16;
                const LAS unsigned char* xp0 = Xs + (32 * sb + 4 * hi + qq) * 64 + (16 * blk + 4 * pp) * 2;
                const s16x4 xl0 = att::trd(xp0), xh0 = att::trd(xp0 + 8 * 64), xl1 = att::trd(xp0 + 16 * 64), xh1 = att::trd(xp0 + 24 * 64);
#pragma unroll
                for (int kg = 0; kg < 2; ++kg) { bf16x8 bfr[4];
#pragma unroll
                    for (int k4 = 0; k4 < 4; ++k4) bfr[k4] = *(const LAS bf16x8*)(bp + (4 * kg + k4) * 32);
                    __builtin_amdgcn_sched_barrier(0);
#pragma unroll
                    for (int k4 = 0; k4 < 4; ++k4) gt = SSD_MFMA(bfr[k4], cf[4 * kg + k4], gt); }
                const int dl = 32 * (lb - sb) + c - 4 * hi;
#pragma unroll
                for (int gh = 0; gh < 2; ++gh) { f32x4 as4[2], ds4[2];
#pragma unroll
                    for (int g2 = 0; g2 < 2; ++g2) { as4[g2] = *(const LAS f32x4*)(acs + 32 * sb + 8 * (2 * gh + g2) + 4 * hi); ds4[g2] = *(const LAS f32x4*)(dtv + 32 * sb + 8 * (2 * gh + g2) + 4 * hi); }
#pragma unroll
                    for (int g2 = 0; g2 < 2; ++g2) { const int g4 = 2 * gh + g2;
#pragma unroll
                        for (int i = 0; i < 4; ++i) { const float w = __builtin_amdgcn_exp2f(fminf(acl - as4[g2][i], 0.f)) * ds4[g2][i]; gt[4 * g4 + i] = (8 * g4 + i <= dl) ? gt[4 * g4 + i] * w : 0.f; } } }
#pragma unroll
                for (int s2 = 0; s2 < 2; ++s2) {
                    v4u pw; pw.x = att::cvtpk(gt[8 * s2 + 0], gt[8 * s2 + 1]); pw.y = att::cvtpk(gt[8 * s2 + 2], gt[8 * s2 + 3]); pw.z = att::cvtpk(gt[8 * s2 + 4], gt[8 * s2 + 5]); pw.w = att::cvtpk(gt[8 * s2 + 6], gt[8 * s2 + 7]);
                    const s16x4 lo = s2 ? xl1 : xl0, hh = s2 ? xh1 : xh0;
                    y = SSD_MFMA(__builtin_bit_cast(bf16x8, pw), __builtin_shufflevector(lo, hh, 0, 1, 2, 3, 4, 5, 6, 7), y);
                }
            }
            bf16* op = MIXo + (m0 + 32 * lb + 4 * hi) * 4096 + 2048 + pcol0 + c;
            const LAS unsigned short* xl = (const LAS unsigned short*)(Xs + (32 * lb + 4 * hi) * 64 + 2 * c);
            unsigned short xr[16];
#pragma unroll
            for (int r = 0; r < 16; ++r) xr[r] = xl[((r & 3) + 8 * (r >> 2)) * 32];
            __builtin_amdgcn_sched_barrier(0);
#pragma unroll
            for (int r = 0; r < 16; ++r) { const int lr = (r & 3) + 8 * (r >> 2);
                const float v = (y[r] + Dk * bf1(xr[r])) * silu_f(bf1(zr[r]));
                op[(size_t)lr * 4096] = (bf16)f2bf(v); }
        } else {
            const int nb = wid - 4;
            const float et = etot[0];
#pragma unroll
            for (int r = 0; r < 16; ++r) ST[r] *= et;
            const LAS unsigned char* ap = Bs + (8 * hi + qq) * RS + (32 * nb + 16 * blk + 4 * pp) * 2;
            const LAS unsigned char* xp = Xs + (8 * hi + qq) * 64 + (16 * blk + 4 * pp) * 2;
#pragma unroll
            for (int kg = 0; kg < 2; ++kg) {
                s16x4 alo[4], ahh[4], xlo[4], xhh[4]; f32x4 w0[4], w1[4];
#pragma unroll
                for (int k4 = 0; k4 < 4; ++k4) { const int ks = 4 * kg + k4;
                    alo[k4] = att::trd(ap + 16 * ks * RS); ahh[k4] = att::trd(ap + (16 * ks + 4) * RS);
                    xlo[k4] = att::trd(xp + 16 * ks * 64); xhh[k4] = att::trd(xp + (16 * ks + 4) * 64);
                    w0[k4] = *(const LAS f32x4*)(wend + 16 * ks + 8 * hi); w1[k4] = *(const LAS f32x4*)(wend + 16 * ks + 8 * hi + 4); }
                __builtin_amdgcn_sched_barrier(0);
#pragma unroll
                for (int k4 = 0; k4 < 4; ++k4) {
                    v4u xw;
                    xw.x = att::cvtpk(bf1((bf16)xlo[k4][0]) * w0[k4][0], bf1((bf16)xlo[k4][1]) * w0[k4][1]); xw.y = att::cvtpk(bf1((bf16)xlo[k4][2]) * w0[k4][2], bf1((bf16)xlo[k4][3]) * w0[k4][3]);
                    xw.z = att::cvtpk(bf1((bf16)xhh[k4][0]) * w1[k4][0], bf1((bf16)xhh[k4][1]) * w1[k4][1]); xw.w = att::cvtpk(bf1((bf16)xhh[k4][2]) * w1[k4][2], bf1((bf16)xhh[k4][3]) * w1[k4][3]);
                    ST = SSD_MFMA(__builtin_shufflevector(alo[k4], ahh[k4], 0, 1, 2, 3, 4, 5, 6, 7), __builtin_bit_cast(bf16x8, xw), ST);
                }
            }
            LAS unsigned char* so = Ss + ((ch + 1) & 1) * 32 * RS + c * RS + (32 * nb + 4 * hi) * 2;
#pragma unroll
            for (int g4 = 0; g4 < 4; ++g4) { v2u w; w.x = att::cvtpk(ST[4 * g4], ST[4 * g4 + 1]); w.y = att::cvtpk(ST[4 * g4 + 2], ST[4 * g4 + 3]); *(LAS v2u*)(so + g4 * 16) = w; }
        }
        SSD_WRITE(lds + ((ch + 1) & 1) * BUF);
        SSD_BAR();
    }
    VM_WAIT();
#undef SSD_LOAD
#undef SSD_WRITE
}
}
struct Frame {
    LAS unsigned char* lds;
    volatile LAS unsigned* MISC;
    gu32* ctl;
    int wave;
    int vcu, G;
};

__device__ __forceinline__ void row_copy_ss(const float* xrow, bf16* orow, unsigned long long* ss, int lane) {
    const f32x4* xr = (const f32x4*)xrow + lane;
    f32x4 v[16]; float s = 0.f;
#pragma unroll
    for (int j = 0; j < 16; ++j) { v[j] = xr[64 * j]; s += (v[j].x * v[j].x + v[j].y * v[j].y) + (v[j].z * v[j].z + v[j].w * v[j].w); }
    s = wave_sum(s);
    v2u* o8 = (v2u*)orow + lane;
#pragma unroll
    for (int j = 0; j < 16; ++j) { v2u wb; wb.x = pk2(v[j].x, v[j].y); wb.y = pk2(v[j].z, v[j].w); o8[64 * j] = wb; }
    if (lane == 0) *ss = (unsigned long long)(s * 1048576.0f + 0.5f);
}
__device__ __forceinline__ void rms_row_out(const bf16* xrow, const float* gain, float* orow, int lane) {
    const v4u* xr = (const v4u*)xrow + lane; float v[64]; float s = 0.f;
#pragma unroll
    for (int j = 0; j < 8; ++j) { const v4u w = xr[64 * j];
#pragma unroll
        for (int e = 0; e < 4; ++e) { v[8 * j + 2 * e] = bflo(w[e]); v[8 * j + 2 * e + 1] = bfhi(w[e]); s += v[8 * j + 2 * e] * v[8 * j + 2 * e] + v[8 * j + 2 * e + 1] * v[8 * j + 2 * e + 1]; } }
    const float rstd = 1.0f / sqrtf(wave_sum(s) * (1.0f / DM) + EPS);
#pragma unroll
    for (int j = 0; j < 8; ++j) { const f32x4 g0 = *(const f32x4*)(gain + 512 * j + 8 * lane), g1 = *(const f32x4*)(gain + 512 * j + 8 * lane + 4);
        f32x4 o0, o1;
#pragma unroll
        for (int e = 0; e < 4; ++e) { o0[e] = v[8 * j + e] * rstd * g0[e]; o1[e] = v[8 * j + 4 + e] * rstd * g1[e]; }
        *(f32x4*)(orow + 512 * j + 8 * lane) = o0; *(f32x4*)(orow + 512 * j + 8 * lane + 4) = o1; }
}
__device__ __forceinline__ void prep_rows4(int m0, const bf16* PROJ, const float* cosT, const float* sinT, const float* dt_bias, unsigned long long* SSQ, bf16* KPE, float* DT, int lane) {
    v4u w[4][3]; unsigned short dtr[4];
#pragma unroll
    for (int r = 0; r < 4; ++r) { const bf16* pr = PROJ + (size_t)(m0 + r) * INCP;
        w[r][0] = *(const v4u*)(pr + 8 * lane); w[r][1] = *(const v4u*)(pr + 8 * (64 + lane));
        w[r][2] = lane < 56 ? *(const v4u*)(pr + 8 * (128 + lane)) : (v4u){0u, 0u, 0u, 0u};
        dtr[r] = lane < 32 ? pr[O_DT + lane] : (unsigned short)0; }
#pragma unroll
    for (int r = 0; r < 4; ++r) { const int m = m0 + r;
        float s0 = 0.f, s1 = 0.f, s2 = 0.f;
#pragma unroll
        for (int e = 0; e < 4; ++e) { float a = bflo(w[r][0][e]), b = bfhi(w[r][0][e]); s0 += a * a + b * b; a = bflo(w[r][1][e]); b = bfhi(w[r][1][e]); s1 += a * a + b * b; a = bflo(w[r][2][e]); b = bfhi(w[r][2][e]); s2 += a * a + b * b; }
        const float sq = wave_sum(s0 + (lane < 48 ? s1 : 0.f)), sk = wave_sum((lane < 48 ? 0.f : s1) + (lane < 48 ? s2 : 0.f));
        if (lane == 0) { SSQ[m] = (unsigned long long)(sq * 1048576.0f + 0.5f); SSQ[M + m] = (unsigned long long)(sk * 1048576.0f + 0.5f); }
        if (lane >= 48 && lane < 56) {
            const int ip = 4 * (lane - 48); const f32x4 cs = *(const f32x4*)(cosT + (size_t)m * 32 + ip), sn = *(const f32x4*)(sinT + (size_t)m * 32 + ip);
            v4u o;
#pragma unroll
            for (int e = 0; e < 4; ++e) { const float x1 = bflo(w[r][2][e]), x2 = bfhi(w[r][2][e]); o[e] = pk2(x1 * cs[e] - x2 * sn[e], x2 * cs[e] + x1 * sn[e]); }
            *(v4u*)(KPE + (size_t)m * 64 + 2 * ip) = o; }
        if (lane < 32) { const float v = bf1(dtr[r]) + dt_bias[lane]; DT[(size_t)m * 32 + lane] = fmaxf(v, 0.f) + log1pf(expf(-fabsf(v))); }
    }
}
__device__ __forceinline__ void conv_item(int item, const bf16* PROJ, const float* conv_w, const float* conv_b, bf16* XBC, int lane) {
    const int rr = item >> 3, sl = item & 7, ch0 = sl * 512 + lane * 8, m0 = rr * 32, t0 = m0 & (SEQ - 1);
    const bf16* src = PROJ + (size_t)m0 * INCP + O_XBC + ch0;
    bf16* dst = XBC + (size_t)m0 * 4096 + ch0;
    v4u x[35];
#pragma unroll
    for (int i = 0; i < 3; ++i) x[i] = t0 > 0 ? *(const v4u*)(src + (ptrdiff_t)(i - 3) * INCP) : (v4u){0u, 0u, 0u, 0u};
#pragma unroll
    for (int i = 0; i < 32; ++i) x[3 + i] = *(const v4u*)(src + (size_t)i * INCP);
    float w[4][8], bb[8];
#pragma unroll
    for (int k = 0; k < 4; ++k) { const f32x4 a = *(const f32x4*)(conv_w + k * CONVD + ch0), b2 = *(const f32x4*)(conv_w + k * CONVD + ch0 + 4);
#pragma unroll
        for (int e = 0; e < 4; ++e) { w[k][e] = a[e]; w[k][4 + e] = b2[e]; } }
    { const f32x4 a = *(const f32x4*)(conv_b + ch0), b2 = *(const f32x4*)(conv_b + ch0 + 4);
#pragma unroll
      for (int e = 0; e < 4; ++e) { bb[e] = a[e]; bb[4 + e] = b2[e]; } }
#pragma unroll
    for (int i = 0; i < 32; ++i) { v4u o;
#pragma unroll
        for (int e = 0; e < 4; ++e) {
            const float ya = bb[2 * e] + w[0][2 * e] * bflo(x[i][e]) + w[1][2 * e] * bflo(x[i + 1][e]) + w[2][2 * e] * bflo(x[i + 2][e]) + w[3][2 * e] * bflo(x[i + 3][e]);
            const float yc = bb[2 * e + 1] + w[0][2 * e + 1] * bfhi(x[i][e]) + w[1][2 * e + 1] * bfhi(x[i + 1][e]) + w[2][2 * e + 1] * bfhi(x[i + 2][e]) + w[3][2 * e + 1] * bfhi(x[i + 3][e]);
            o[e] = pk2(silu_f(ya), silu_f(yc)); }
        *(v4u*)(dst + (size_t)i * 4096) = o; }
}
template <int NR> __device__ __forceinline__ void gnorm_rows(bf16* row0, size_t rstride, const float* gw, int lane) {
    v4u w[NR][4];
#pragma unroll
    for (int r = 0; r < NR; ++r) { const v4u* p = (const v4u*)(row0 + r * rstride + 32 * lane);
#pragma unroll
        for (int j = 0; j < 4; ++j) w[r][j] = p[j]; }
    const float* g = gw + 32 * lane;
#pragma unroll
    for (int r = 0; r < NR; ++r) { float s = 0.f;
#pragma unroll
        for (int j = 0; j < 4; ++j)
#pragma unroll
            for (int e = 0; e < 4; ++e) { const float a = bflo(w[r][j][e]), b = bfhi(w[r][j][e]); s += a * a + b * b; }
        s += __shfl_xor(s, 1); s += __shfl_xor(s, 2); s += __shfl_xor(s, 4);
        const float rstd = 1.0f / sqrtf(s * (1.0f / 256.0f) + EPS);
        v4u* p = (v4u*)(row0 + r * rstride + 32 * lane);
#pragma unroll
        for (int j = 0; j < 4; ++j) { v4u o;
#pragma unroll
            for (int e = 0; e < 4; ++e) o[e] = pk2(bflo(w[r][j][e]) * rstd * g[8 * j + 2 * e], bfhi(w[r][j][e]) * rstd * g[8 * j + 2 * e + 1]);
            p[j] = o; } }
}
__device__ __forceinline__ void ssd_item(int item, const bf16* XBC, const float* DT, const bf16* PROJ, const float* a_log, const float* d_skip, bf16* MIXo, int lane) {
    const int pi = lane >> 4, ns = lane & 15;
    const int b = item >> 9, h = (item >> 4) & 31, pq = item & 15, g = h >> 2;
    const float A2 = -expf(a_log[h]) * 1.4426950408889634f, Dk = d_skip[h];
    const int pcol = h * 64 + pq * 4 + pi;
    float st[8];
#pragma unroll
    for (int k = 0; k < 8; ++k) st[k] = 0.f;
    const bf16* xb = XBC + (size_t)b * SEQ * 4096; const float* dtp = DT + (size_t)b * SEQ * 32 + h;
    const bf16* zp = PROJ + (size_t)b * SEQ * INCP + O_Z + pcol; bf16* op = MIXo + (size_t)b * SEQ * 4096 + 2048 + pcol;
#pragma unroll 4
    for (int t = 0; t < SEQ; ++t) {
        const bf16* xr = xb + (size_t)t * 4096;
        const float dtv = dtp[(size_t)t * 32];
        const float xv = bf1(xr[pcol]);
        const v4u Bw = *(const v4u*)(xr + 2048 + g * 128 + ns * 8);
        const v4u Cw = *(const v4u*)(xr + 3072 + g * 128 + ns * 8);
        const float zv = bf1(zp[(size_t)t * INCP]);
        const float dA = __builtin_amdgcn_exp2f(dtv * A2), xdt = dtv * xv;
        float part = 0.f;
#pragma unroll
        for (int e = 0; e < 4; ++e) {
            st[2 * e] = dA * st[2 * e] + xdt * bflo(Bw[e]); part += bflo(Cw[e]) * st[2 * e];
            st[2 * e + 1] = dA * st[2 * e + 1] + xdt * bfhi(Bw[e]); part += bfhi(Cw[e]) * st[2 * e + 1]; }
        part += __shfl_xor(part, 1); part += __shfl_xor(part, 2); part += __shfl_xor(part, 4); part += __shfl_xor(part, 8);
        if (ns == 0) op[(size_t)t * 4096] = (bf16)f2bf((part + Dk * xv) * silu_f(zv));
    }
}
__device__ __forceinline__ int dst_row(int kind, int n) {
    if (kind == 1) return ((n >> 7) << 8) + (n & 127);
    if (kind == 2) return ((n >> 7) << 8) + 128 + (n & 127);
    if (kind == 3) { const int hh = n / QKD, j = n - hh * QKD; if (j < NOPE) return n; const int i = j - NOPE; return hh * QKD + NOPE + (i < 32 ? 2 * i : 2 * (i - 32) + 1); }
    if (kind == 4) { if (n < O_KPE || n >= O_KPE + ROPE) return n; const int i = n - O_KPE; return O_KPE + (i < 32 ? 2 * i : 2 * (i - 32) + 1); }
    return n;
}
__device__ __forceinline__ void p0_transpose_item(const float* W, int K, int N, bf16* WT, int kind, const float* gain, LAS float* scr, int item, int lane) {
    const bool f16w = false;
    const int nblk = N / 32, kb = item / nblk, nb = item - kb * nblk, k0 = 64 * kb, n0 = 32 * nb;
    float v[32];
    const float* wp = W + (size_t)(k0 + (lane >> 5)) * N + n0 + (lane & 31);
#pragma unroll
    for (int i = 0; i < 32; ++i) v[i] = wp[(size_t)(2 * i) * N];
    const int c = lane & 7;
    f32x4 g0 = (f32x4){1.f, 1.f, 1.f, 1.f}, g1 = g0;
    if (gain) { g0 = *(const f32x4*)(gain + k0 + 8 * c); g1 = *(const f32x4*)(gain + k0 + 8 * c + 4); }
#pragma unroll
    for (int i = 0; i < 32; ++i) scr[(2 * i + (lane >> 5)) * 33 + (lane & 31)] = v[i];
    LDS_WAIT(); asm volatile("" ::: "memory");
#pragma unroll
    for (int j = 0; j < 4; ++j) { const int n = (lane >> 3) + 8 * j; const LAS float* s = scr + (8 * c) * 33 + n;
        const float e0 = s[0 * 33] * g0[0], e1 = s[1 * 33] * g0[1], e2 = s[2 * 33] * g0[2], e3 = s[3 * 33] * g0[3], e4 = s[4 * 33] * g1[0], e5 = s[5 * 33] * g1[1], e6 = s[6 * 33] * g1[2], e7 = s[7 * 33] * g1[3];
        v4u o; if (f16w) { o.x = pkh2(e0, e1); o.y = pkh2(e2, e3); o.z = pkh2(e4, e5); o.w = pkh2(e6, e7); } else { o.x = pk2(e0, e1); o.y = pk2(e2, e3); o.z = pk2(e4, e5); o.w = pk2(e6, e7); }
        *(v4u*)(WT + (size_t)dst_row(kind, n0 + n) * K + k0 + 8 * c) = o; }
    LDS_WAIT(); asm volatile("" ::: "memory");
}
struct InPtrs { const float* p[24]; };
#ifndef DEFER_D2
#define DEFER_D2 1
#endif
constexpr int IT_FFN = (DM / 64) * (FF / 32);
constexpr int IT_IN = (DM / 64) * (INC / 32);
constexpr int IT_QU = (QL / 64) * (QW / 32);
constexpr int IT_KVU = (KVL / 64) * (KVW / 32);
constexpr int IT_O = (DM / 64) * (DM / 32);
constexpr int IT_LAYER = 6 * IT_FFN + IT_IN + IT_QU + IT_KVU + IT_O;
__device__ __forceinline__ void p0_prologue(Frame& F, const InPtrs& in, unsigned char* ws, int lane) {
    LAS float* scr = (LAS float*)(F.lds + RING_OFF + F.wave * 16384);
    const int gw = F.vcu * NWAVES + F.wave, NGW = F.G * NWAVES;
    for (int it = gw; it < DEPTH * IT_LAYER; it += NGW) {
        const int l = it / IT_LAYER; int r = it - l * IT_LAYER;
        unsigned char* wl = ws + WS_W + (size_t)l * W_LAYER;
        const size_t lFF = (size_t)l * DM * FF;
        if (r < IT_FFN) { p0_transpose_item(in.p[3] + lFF, DM, FF, (bf16*)(wl + W_GU1), 1, in.p[2] + (size_t)l * DM, scr, r, lane); continue; } r -= IT_FFN;
        if (r < IT_FFN) { p0_transpose_item(in.p[4] + lFF, DM, FF, (bf16*)(wl + W_GU1), 2, in.p[2] + (size_t)l * DM, scr, r, lane); continue; } r -= IT_FFN;
        if (r < IT_FFN) { p0_transpose_item(in.p[5] + lFF, FF, DM, (bf16*)(wl + W_D1), 0, nullptr, scr, r, lane); continue; } r -= IT_FFN;
        if (r < IT_IN) { p0_transpose_item(in.p[7] + (size_t)l * DM * INC, DM, INC, (bf16*)(wl + W_IN), 4, in.p[6] + (size_t)l * DM, scr, r, lane); continue; } r -= IT_IN;
        if (r < IT_QU) { p0_transpose_item(in.p[9] + (size_t)l * QL * QW, QL, QW, (bf16*)(wl + W_QU), 3, in.p[8] + (size_t)l * QL, scr, r, lane); continue; } r -= IT_QU;
        if (r < IT_KVU) { p0_transpose_item(in.p[11] + (size_t)l * KVL * KVW, KVL, KVW, (bf16*)(wl + W_KVU), 0, in.p[10] + (size_t)l * KVL, scr, r, lane); continue; } r -= IT_KVU;
        if (r < IT_O) { p0_transpose_item(in.p[18] + (size_t)l * DM * DM, DM, DM, (bf16*)(wl + W_O), 0, nullptr, scr, r, lane); continue; } r -= IT_O;
        if (r < IT_FFN) { if (!(l >= 1 && DEFER_D2 >= 2)) p0_transpose_item(in.p[20] + lFF, DM, FF, (bf16*)(wl + W_GU2), 1, in.p[19] + (size_t)l * DM, scr, r, lane); continue; } r -= IT_FFN;
        if (r < IT_FFN) { p0_transpose_item(in.p[21] + lFF, DM, FF, (bf16*)(wl + W_GU2), 2, in.p[19] + (size_t)l * DM, scr, r, lane); continue; } r -= IT_FFN;
        if (l >= 1 && DEFER_D2) continue;
        p0_transpose_item(in.p[22] + lFF, FF, DM, (bf16*)(wl + W_D2), 0, nullptr, scr, r, lane);
    }
    const int gt = gw * 64 + lane, NGT = NGW * 64;
    for (int i = gt; i < DEPTH * 16384; i += NGT) { const int l = i >> 14, j = i & 16383;
        *(v4u*)(ws + WS_W + (size_t)l * W_LAYER + W_IN + (size_t)INC * DM * 2 + (size_t)j * 16) = (v4u){0u, 0u, 0u, 0u}; }
    const int* pos = (const int*)in.p[1]; float* cosT = (float*)(ws + WS_COS); float* sinT = (float*)(ws + WS_SIN);
    float invf;
    {   const double y = -(double)(lane & 31) * 0.28782313662425575;
        const double kd = __builtin_rint(y * 1.4426950408889634);
        double r = __builtin_fma(-kd, 0.6931471803691238, y); r = __builtin_fma(-kd, 1.9082149292705877e-10, r);
        double e = 1.0;
#pragma unroll
        for (int k = 18; k >= 1; --k) e = 1.0 + e * r * (1.0 / (double)k);
        invf = (float)__builtin_ldexp(e, (int)kd); }
    for (int i = gt; i < M * 32; i += NGT) { const int m = i >> 5;
        const float ang = (float)pos[m] * invf;
        const double x = (double)ang, n = __builtin_rint(x * 0.15915494309189535);
        double r = __builtin_fma(-n, 6.283185307179586, x); r = __builtin_fma(-n, 2.4492935982947064e-16, r);
        const double r2 = r * r; double sn = 1.0, cs = 1.0;
#pragma unroll
        for (int k = 14; k >= 1; --k) { sn = 1.0 - sn * r2 * (1.0 / (double)((2 * k) * (2 * k + 1))); cs = 1.0 - cs * r2 * (1.0 / (double)((2 * k - 1) * (2 * k))); }
        cosT[i] = (float)cs; sinT[i] = (float)(sn * r); }
    for (int m = gw; m < M; m += NGW) row_copy_ss(in.p[0] + (size_t)m * DM, (bf16*)(ws + WS_XN) + (size_t)m * DM, (unsigned long long*)(ws + WS_SS) + m, lane);
}
#ifndef REP_GEMM
#define REP_GEMM 1
#endif
#ifndef REP_RES
#define REP_RES 1
#endif
#ifndef REP_BAR
#define REP_BAR 0
#endif
#ifndef REP_ATT
#define REP_ATT 1
#endif
#ifndef REP_SSD
#define REP_SSD 1
#endif
#ifndef REP_THIN
#define REP_THIN 1
#endif
#ifndef DBG_EN
#define DBG_EN 0xffff
#endif
constexpr int PH_PER_LAYER = 9, N_PHASES = 1 + PH_PER_LAYER * DEPTH + 1;
struct Args { const float* in[24]; float* out; unsigned char* ws; int ph_lo, ph_hi; };
static_assert(sizeof(Args) == 24 * 8 + 16 + 8, "Args has no holes");

__global__ void __launch_bounds__(NTHREADS, 2) trunk_fwd(Args args) {
    extern __shared__ __attribute__((aligned(16))) unsigned char lds[];
    Frame F;
    F.lds = (LAS unsigned char*)lds;
    F.MISC = (volatile LAS unsigned*)(F.lds + MISC_OFF);
    F.wave = __builtin_amdgcn_readfirstlane(threadIdx.x >> 6);
    F.G = gridDim.x; { const int bx = blockIdx.x; F.vcu = (F.G % 8 == 0) ? (bx % 8) * (F.G / 8) + bx / 8 : bx; }
    unsigned char* ws = args.ws;
    F.ctl = (gu32*)(ws + WS_CTL);
    for (int u = threadIdx.x; u < (LDS_BYTES - LDSCTL_OFF) / 4; u += NTHREADS) ((LAS unsigned*)(F.lds + LDSCTL_OFF))[u] = 0u;
    __syncthreads();
    XcdBarrier bar; bar.bar = (unsigned*)(F.ctl + CW_BAR); bar.x = 0; bar.st = nullptr;
    if (MK_ONE_LAUNCH) bar = xcd_barrier_post((unsigned*)(F.ctl + CW_BAR), F.MISC + 8);
#define GRID_BAR() do { if (MK_ONE_LAUNCH) xcd_barrier(bar); } while (0)
    const int lo = args.ph_lo, hi = args.ph_hi;
#define IN(k) (lo <= (k) && (k) < hi)
#ifndef XBAR
#define XBAR 0
#endif
#define SEAM(k) do { if (IN((k) + 1)) { GRID_BAR(); for (int xb_ = 0; xb_ < XBAR; ++xb_) GRID_BAR(); } } while (0)
#define ROWFAC(ssp_, invn_) ({ LAS float* tab_ = (LAS float*)(F.lds + RSTAB_OFF); const int rb_ = 2048 * ((int)blockIdx.x & 7); int t0_ = threadIdx.x; asm volatile("" : "+v"(t0_)); __syncthreads(); \
        for (int r_ = t0_; r_ < 2048; r_ += NTHREADS) tab_[r_] = pg8::row_rstd((ssp_), rb_ + r_, (invn_)); \
        __syncthreads(); pg8::RowFac rf_; rf_.tab = tab_ - rb_; rf_; })
#define LANE_L() ({ int l_ = threadIdx.x; asm volatile("" : "+v"(l_)); l_ & 63; })
#define PH_VARS() const int ln = LANE_L(); int gw_ = F.vcu * NWAVES + F.wave; asm volatile("" : "+s"(gw_)); const int gw = gw_, NGW = F.G * NWAVES; (void)ln; (void)gw; (void)NGW

    bf16* XB = (bf16*)(ws + WS_XN); bf16* HB = (bf16*)(ws + WS_BIG); bf16* PROJ = (bf16*)(ws + WS_BIG);
    bf16* KPE = (bf16*)(ws + WS_KPE); float* DT = (float*)(ws + WS_DT); unsigned long long* SSQ = (unsigned long long*)(ws + WS_SSQ); unsigned long long* SS = (unsigned long long*)(ws + WS_SS);
    bf16* XBC = (bf16*)(ws + WS_XBC); bf16* QB = (bf16*)(ws + WS_Q); bf16* KVB = (bf16*)(ws + WS_KV); bf16* MIX = (bf16*)(ws + WS_MIX);
    const float* cosT = (const float*)(ws + WS_COS); const float* sinT = (const float*)(ws + WS_SIN);

    if ((DBG_EN & 1) && IN(0)) { PH_VARS(); InPtrs ip;
#pragma unroll
        for (int i = 0; i < 24; ++i) ip.p[i] = args.in[i];
        for (int rep = 0; rep < REP_THIN; ++rep) p0_prologue(F, ip, ws, ln); SEAM(0); }

    for (int l = 0; l < DEPTH; ++l) {
        const int pb = 1 + PH_PER_LAYER * l;
        unsigned char* wl = ws + WS_W + (size_t)l * W_LAYER;
        for (int f = 0; f < 2; ++f) {
            if (f == 1) {
                if ((DBG_EN & 4) && IN(pb + 2)) { PH_VARS(); pg8::Gemm g{XB, (const bf16*)(wl + W_IN), M, INCP, DM, DM, DM}; pg8::StaticOrder S; S.init(M, INCP, F.G, (int)blockIdx.x);
                    pg8::EpiStore E{PROJ, INCP, ROWFAC(SS + (size_t)(3 * l + 1) * M, 1.0f / DM)};
                    for (int rep = 0; rep < REP_GEMM; ++rep) { if (REP_BAR && rep) GRID_BAR(); pg8::gemm_phase<pg8::EpiStore, pg8::StaticOrder, PG8_ALIGN, PG8_SP2>(F.lds + RING_OFF, g, S, E); }
                    if (DEFER_D2 && l + 1 < DEPTH && F.G == 256 && blockIdx.x >= 128) {
                        LAS float* scr = (LAS float*)(F.lds + RING_OFF + F.wave * 16384);
                        bf16* wt = (bf16*)(ws + WS_W + (size_t)(l + 1) * W_LAYER + W_D2); const float* wsrc = args.in[22] + (size_t)(l + 1) * DM * FF;
                        for (int it = ((int)blockIdx.x - 128) * NWAVES + F.wave; it < IT_FFN; it += 128 * NWAVES) p0_transpose_item(wsrc, FF, DM, wt, 0, nullptr, scr, it, ln);
                        if (DEFER_D2 >= 2) { bf16* wg = (bf16*)(ws + WS_W + (size_t)(l + 1) * W_LAYER + W_GU2); const float* gsrc = args.in[20] + (size_t)(l + 1) * DM * FF; const float* gg = args.in[19] + (size_t)(l + 1) * DM;
                            for (int it = ((int)blockIdx.x - 128) * NWAVES + F.wave; it < IT_FFN; it += 128 * NWAVES) p0_transpose_item(gsrc, DM, FF, wg, 1, gg, scr, it, ln); }
                    } else if (DEFER_D2 && l + 1 < DEPTH && F.G != 256) {
                        LAS float* scr = (LAS float*)(F.lds + RING_OFF + F.wave * 16384);
                        bf16* wt = (bf16*)(ws + WS_W + (size_t)(l + 1) * W_LAYER + W_D2); const float* wsrc = args.in[22] + (size_t)(l + 1) * DM * FF;
                        for (int it = gw; it < IT_FFN; it += NGW) p0_transpose_item(wsrc, FF, DM, wt, 0, nullptr, scr, it, ln);
                        if (DEFER_D2 >= 2) { bf16* wg = (bf16*)(ws + WS_W + (size_t)(l + 1) * W_LAYER + W_GU2); const float* gsrc = args.in[20] + (size_t)(l + 1) * DM * FF; const float* gg = args.in[19] + (size_t)(l + 1) * DM;
                            for (int it = gw; it < IT_FFN; it += NGW) p0_transpose_item(gsrc, DM, FF, wg, 1, gg, scr, it, ln); }
                    }
                    SEAM(pb + 2); }
                if ((DBG_EN & 8) && IN(pb + 3)) { PH_VARS();
                    for (int rep = 0; rep < REP_THIN; ++rep) for (int m = 4 * gw; m < M; m += 4 * NGW) prep_rows4(m, PROJ, cosT, sinT, args.in[14] + (size_t)l * SSD_H, SSQ, KPE, DT, ln);
                    for (int rep = 0; rep < REP_THIN; ++rep) for (int it = gw; it < (M / 32) * 8; it += NGW) conv_item(it, PROJ, args.in[12] + (size_t)l * 4 * CONVD, args.in[13] + (size_t)l * CONVD, XBC, ln);
                    SEAM(pb + 3); }
                if ((DBG_EN & 16) && IN(pb + 4)) { PH_VARS();
                    for (int rep = 0; rep < REP_SSD; ++rep) for (int u = F.vcu; u < BATCH * SSD_H * 2; u += F.G) ssd::ssd_unit(u, XBC, DT, PROJ, args.in[15] + (size_t)l * SSD_H, args.in[16] + (size_t)l * SSD_H, MIX, F.lds + RING_OFF);
                    for (int s2 = 0; s2 < 2; ++s2) {
                        const int kk = s2 ? KVL : QL, nn = s2 ? KVW : QW;
                        pg8::Gemm g{PROJ + (s2 ? O_CKV : O_CQ), (const bf16*)(wl + (s2 ? W_KVU : W_QU)), M, nn, kk, INCP, kk}; pg8::StaticOrder S; S.init(M, nn, F.G, (int)blockIdx.x);
                        pg8::EpiStore E{s2 ? KVB : QB, nn, ROWFAC(SSQ + (size_t)s2 * M, 1.0f / (float)kk)};
                        for (int rep = 0; rep < REP_GEMM; ++rep) { if (REP_BAR && rep) GRID_BAR(); pg8::gemm_phase<pg8::EpiStore, pg8::StaticOrder, PG8_ALIGN, PG8_SP2>(F.lds + RING_OFF, g, S, E); } }
                    SEAM(pb + 4); }
                if ((DBG_EN & 32) && IN(pb + 5)) { PH_VARS();
                    for (int rep = 0; rep < REP_ATT; ++rep) for (int u = F.vcu; u < BATCH * NH * 8; u += F.G) { const int bh = u >> 3, xq = u & 7;
                        att::attn_block(bh >> 4, bh & 15, xq, QB, KVB, KPE, cosT, sinT, MIX, F.lds + RING_OFF);
                        att::attn_block(bh >> 4, bh & 15, 15 - xq, QB, KVB, KPE, cosT, sinT, MIX, F.lds + RING_OFF); }
                    { const float* g = args.in[17] + (size_t)l * SSD_W;
                      for (int m = 4 * gw; m < M; m += 4 * NGW) gnorm_rows<4>(MIX + (size_t)m * 4096 + 2048, 4096, g, ln); }
                    SEAM(pb + 5); }
                if ((DBG_EN & 128) && IN(pb + 6)) { PH_VARS(); pg8::Gemm g{MIX, (const bf16*)(wl + W_O), M, DM, DM, DM, DM}; pg8::StaticOrder S; S.init(M, DM, F.G, (int)blockIdx.x);
                    for (int rep = 0; rep < REP_RES; ++rep) { pg8::EpiResid E{XB, rep ? (unsigned long long*)(ws + WS_SSP) : SS + (size_t)(3 * l + 2) * M, DM, rep == 0 ? 1.0f : 0.0f};
                    pg8::gemm_phase<pg8::EpiResid, pg8::StaticOrder, PG8_ALIGN, PG8_SP2>(F.lds + RING_OFF, g, S, E); }
                    SEAM(pb + 6); }
            }
            const int fb = pb + 7 * f;
            if ((DBG_EN & 512) && IN(fb)) { PH_VARS(); pg8::Gemm g{XB, (const bf16*)(wl + (f ? W_GU2 : W_GU1)), M, 2 * FF, DM, DM, DM}; pg8::StaticOrder S; S.init(M, 2 * FF, F.G, (int)blockIdx.x);
                pg8::EpiSwiGLU E{HB, FF, ROWFAC(SS + (size_t)(3 * l + 2 * f) * M, 1.0f / DM)};
                for (int rep = 0; rep < REP_GEMM; ++rep) { if (REP_BAR && rep) GRID_BAR(); pg8::gemm_phase<pg8::EpiSwiGLU, pg8::StaticOrder, PG8_ALIGN, PG8_SP2>(F.lds + RING_OFF, g, S, E); }
                SEAM(fb); }
            if ((DBG_EN & 1024) && IN(fb + 1)) { PH_VARS(); pg8::Gemm g{HB, (const bf16*)(wl + (f ? W_D2 : W_D1)), M, DM, FF, FF, FF}; pg8::StaticOrder S; S.init(M, DM, F.G, (int)blockIdx.x);
                for (int rep = 0; rep < REP_RES; ++rep) { pg8::EpiResid E{XB, rep ? (unsigned long long*)(ws + WS_SSP) : SS + (size_t)(3 * l + 2 * f + 1) * M, DM, rep == 0 ? 0.5f : 0.0f};
                pg8::gemm_phase<pg8::EpiResid, pg8::StaticOrder, PG8_ALIGN, PG8_SP2>(F.lds + RING_OFF, g, S, E); }
                SEAM(fb + 1); }
        }
    }
    if ((DBG_EN & 2048) && IN(N_PHASES - 1)) { PH_VARS(); for (int m = gw; m < M; m += NGW) rms_row_out(XB + (size_t)m * DM, args.in[23], args.out + (size_t)m * DM, ln); }
#undef IN
#undef SEAM
#undef GRID_BAR
}

extern "C" void kernel_launch(void* const* d_in, const int* in_sizes, int n_in, void* d_out, int out_size, void* d_ws, size_t ws_size, hipStream_t stream) {
    static int grid = 0;
    if (grid == 0) {
        if (n_in != 24 || in_sizes[0] != M * DM || out_size != M * DM || ws_size < WS_END) {
            fprintf(stderr, "kernel_launch: built for 24 inputs, x/out of %d floats, >= %zu bytes of workspace; got n_in %d, in0 %d, out %d, ws %zu; nothing launched\n", M * DM, (size_t)WS_END, n_in, n_in > 0 ? in_sizes[0] : -1, out_size, ws_size);
            grid = -1; return; }
        int dev = 0, cus = 0, per_cu = 0;
        if (hipGetDevice(&dev) != hipSuccess || hipDeviceGetAttribute(&cus, hipDeviceAttributeMultiprocessorCount, dev) != hipSuccess) { fprintf(stderr, "kernel_launch: device query failed\n"); grid = -1; return; }
        if (hipFuncSetAttribute((const void*)trunk_fwd, hipFuncAttributeMaxDynamicSharedMemorySize, LDS_BYTES) != hipSuccess) { fprintf(stderr, "kernel_launch: hipFuncSetAttribute failed\n"); grid = -1; return; }
        if (hipOccupancyMaxActiveBlocksPerMultiprocessor(&per_cu, (const void*)trunk_fwd, NTHREADS, LDS_BYTES) != hipSuccess || per_cu < 1)
            fprintf(stderr, "kernel_launch: note: occupancy query reports %d workgroups per CU\n", per_cu);
        (void)hipGetLastError();
        if (cus != 256) { fprintf(stderr, "kernel_launch: built for a 256-CU device (the GEMM epilogues' row-factor tables assume the 256-workgroup unit deal); found %d CUs; nothing launched\n", cus); grid = -1; return; }
        grid = cus;
    }
    if (grid < 0) return;
    if (hipMemsetAsync((char*)d_ws + WS_CTL, 0, CTL_ZERO_BYTES, stream) != hipSuccess) { fprintf(stderr, "kernel_launch: memset failed\n"); return; }
    Args a{};
    for (int i = 0; i < 24; ++i) a.in[i] = (const float*)d_in[i];
    a.out = (float*)d_out; a.ws = (unsigned char*)d_ws;
#if MK_ONE_LAUNCH
    a.ph_lo = 0; a.ph_hi = N_PHASES;
    hipLaunchKernelGGL(trunk_fwd, dim3(grid), dim3(NTHREADS), LDS_BYTES, stream, a);
#else
    for (int p = 0; p < N_PHASES; ++p) { a.ph_lo = p; a.ph_hi = p + 1; hipLaunchKernelGGL(trunk_fwd, dim3(grid), dim3(NTHREADS), LDS_BYTES, stream, a); }
#endif
    const hipError_t le = hipPeekAtLastError();
    if (le != hipSuccess) fprintf(stderr, "kernel_launch: launch failed: %s\n", hipGetErrorName(le));
}
```

```cpp
#include <hip/hip_runtime.h>
#include <cstdio>
#include <cstdint>

#ifndef MK_ONE_LAUNCH
#define MK_ONE_LAUNCH 1
#endif

constexpr int BATCH = 4, SEQ = 4096, DM = 4096, DEPTH = 4, FF = 6144;
constexpr int M = BATCH * SEQ;
constexpr int NH = 16, QL = 896, KVL = 512, NOPE = 128, ROPE = 64, VH = 128, QKD = NOPE + ROPE;
constexpr int QW = NH * QKD;
constexpr int KVW = NH * (NOPE + VH);
constexpr int SSD_P = 64, SSD_H = 32, SSD_G = 8, SSD_N = 128, SSD_W = 2048, CONVD = 4096;
constexpr int INC = 7648, INCP = 7680;
constexpr int O_CQ = 0, O_CKV = 896, O_KPE = 1408, O_Z = 1472, O_XBC = 3520, O_DT = 7616;
constexpr float EPS = 1e-6f;
constexpr int NWAVES = 8, NTHREADS = NWAVES * 64;

constexpr size_t MiB = 1u << 20;
constexpr size_t WS_CTL = 0, CTL_ZERO_BYTES = 3 * MiB;
constexpr size_t WS_SS = 1 * MiB;
constexpr int N_SS = 3 * DEPTH + 1;
static_assert(WS_SS + (size_t)N_SS * M * 8 <= CTL_ZERO_BYTES, "ss arrays inside the memset region");
constexpr size_t WS_COS = 3 * MiB, WS_SIN = 5 * MiB;
constexpr size_t WS_SSQ = 7 * MiB;
constexpr size_t WS_X = 8 * MiB;
constexpr size_t WS_XN = 264 * MiB;
constexpr size_t WS_BIG = 392 * MiB;
constexpr size_t WS_SSP = 632 * MiB;
constexpr size_t WS_KPE = 676 * MiB;
constexpr size_t WS_DT = 678 * MiB;
constexpr size_t WS_XBC = 680 * MiB;
constexpr size_t WS_Q = 808 * MiB;
constexpr size_t WS_KV = 904 * MiB;
constexpr size_t WS_MIX = 1032 * MiB;
constexpr size_t WS_W = 1160 * MiB;
constexpr size_t W_GU1 = 0, W_D1 = 96 * MiB, W_IN = 144 * MiB, W_QU = 204 * MiB, W_KVU = 210 * MiB, W_O = 214 * MiB, W_GU2 = 246 * MiB, W_D2 = 342 * MiB, W_LAYER = 390 * MiB;
constexpr size_t WS_END = WS_W + DEPTH * W_LAYER;
static_assert(WS_BIG + (size_t)M * INCP * 2 <= WS_SSP && WS_SSP + (size_t)M * 64 * 4 <= WS_KPE && WS_XBC + (size_t)M * 4096 * 2 <= WS_Q && WS_Q + (size_t)M * QW * 2 <= WS_KV, "d_ws map");
constexpr int CW_TMO = 0, CW_CODE = 1, CW_BAR = 4096;

constexpr int RING_OFF = 0, RING_BYTES = 131072;
constexpr int LDSCTL_OFF = RING_BYTES, MISC_OFF = LDSCTL_OFF + 320, RSTAB_OFF = LDSCTL_OFF + 1024;
static_assert(RSTAB_OFF + 2048 * 4 <= 147456, "LDS map");
constexpr int LDS_BYTES = 147456;

#define GAS __attribute__((address_space(1)))
#define LAS __attribute__((address_space(3)))
typedef unsigned short bf16;
typedef unsigned v4u __attribute__((ext_vector_type(4)));
typedef unsigned v2u __attribute__((ext_vector_type(2)));
typedef float f32x4 __attribute__((ext_vector_type(4)));
typedef float f32x2 __attribute__((ext_vector_type(2)));
typedef float f32x16 __attribute__((ext_vector_type(16)));
typedef short bf16x8 __attribute__((ext_vector_type(8)));
typedef short s16x4 __attribute__((ext_vector_type(4)));
typedef GAS unsigned gu32;
#define RLX_AGENT __ATOMIC_RELAXED, __HIP_MEMORY_SCOPE_AGENT
#define LDS_WAIT() asm volatile("s_waitcnt lgkmcnt(0)" ::: "memory")
#define VM_WAIT() asm volatile("s_waitcnt vmcnt(0)" ::: "memory")
__device__ __forceinline__ unsigned f2bf(float f) { unsigned u = __builtin_bit_cast(unsigned, f); return (u + 0x7fffu + ((u >> 16) & 1u)) >> 16; }
__device__ __forceinline__ unsigned pk2(float lo, float hi) { return f2bf(lo) | (f2bf(hi) << 16); }
__device__ __forceinline__ float bflo(unsigned w) { return __builtin_bit_cast(float, w << 16); }
__device__ __forceinline__ float bfhi(unsigned w) { return __builtin_bit_cast(float, w & 0xffff0000u); }
__device__ __forceinline__ float bf1(bf16 b) { return __builtin_bit_cast(float, (unsigned)b << 16); }
typedef _Float16 h16x2 __attribute__((ext_vector_type(2)));
__device__ __forceinline__ unsigned pkh2(float lo, float hi) { f32x2 v = {lo, hi}; h16x2 h = __builtin_convertvector(v, h16x2); return __builtin_bit_cast(unsigned, h); }
__device__ __forceinline__ float hlo(unsigned w) { return (float)__builtin_bit_cast(h16x2, w)[0]; }
__device__ __forceinline__ float hhi(unsigned w) { return (float)__builtin_bit_cast(h16x2, w)[1]; }
__device__ __forceinline__ float wave_sum(float v) {
#pragma unroll
    for (int o = 1; o < 64; o <<= 1) v += __shfl_xor(v, o);
    return v;
}
__device__ __forceinline__ float fast_exp(float x) { return __builtin_amdgcn_exp2f(x * 1.4426950408889634f); }
__device__ __forceinline__ float silu_f(float x) { return x * __builtin_amdgcn_rcpf(1.0f + fast_exp(-x)); }
#define XB_TMO      128
#define XB_XCNT(j)  (256  + 64 * (j))
#define XB_XSUB(j)  (1280 + 64 * (j))
#define XB_XGEN(j)  (2304 + 64 * (j))
#define XB_TOP      3328
#define XB_TOPGEN   3392
#define XCD_BAR_WORDS 3456
#define XB_SPIN_CAP (1u << 18)

__device__ __forceinline__ unsigned xb_ld(unsigned* p)              { return __hip_atomic_load(p, __ATOMIC_RELAXED, __HIP_MEMORY_SCOPE_AGENT); }
__device__ __forceinline__ unsigned xb_add(unsigned* p, unsigned v) { return __hip_atomic_fetch_add(p, v, __ATOMIC_RELAXED, __HIP_MEMORY_SCOPE_AGENT); }
__device__ __forceinline__ unsigned xb_xcc_id() { return (unsigned)__builtin_amdgcn_s_getreg((3 << 11) | 20) & 0xFu; }
#define XB_SPIN(cond, bar) do { unsigned _sp = 0; while (cond) { __builtin_amdgcn_s_sleep(1); \
    if ((++_sp & 255u) == 0u) { if (xb_ld(&(bar)[XB_TMO])) break; if (_sp > XB_SPIN_CAP) { atomicAdd(&(bar)[XB_TMO], 1u); break; } } } } while (0)

struct XcdBarrier {
    unsigned* bar; unsigned x;
    volatile LAS unsigned* st;
};

__device__ __forceinline__ XcdBarrier xcd_barrier_post(unsigned* bar, volatile LAS unsigned* st) {
    XcdBarrier b; b.bar = bar; b.x = xb_xcc_id(); b.st = st;
    if (threadIdx.x == 0) (void)xb_add(&bar[XB_XCNT(b.x)], 1u);
    return b;
}
__device__ __forceinline__ void xcd_barrier_complete(unsigned* bar, unsigned x, unsigned& nloc, unsigned& nx) {
    const unsigned G = gridDim.x * gridDim.y * gridDim.z;
    unsigned sum, cnt, mine, sp = 0u;
    for (;;) {
        sum = 0u; cnt = 0u; mine = 0u;
#pragma unroll
        for (unsigned j = 0; j < 16; ++j) { const unsigned c = xb_ld(&bar[XB_XCNT(j)]); sum += c; cnt += (c > 0u) ? 1u : 0u; mine = (j == x) ? c : mine; }
        if (sum == G) break;
        __builtin_amdgcn_s_sleep(1);
        if ((++sp & 255u) == 0u) { if (xb_ld(&bar[XB_TMO])) break; if (sp > XB_SPIN_CAP) { atomicAdd(&bar[XB_TMO], 1u); break; } }
    }
    nloc = mine > 0u ? mine : 1u; nx = cnt > 0u ? cnt : 1u;
}

__device__ __forceinline__ void xcd_barrier(const XcdBarrier& b) {
    asm volatile("s_waitcnt vmcnt(0)" ::: "memory");
    __syncthreads();
    if (threadIdx.x == 0) {
        unsigned* bar = b.bar;
        __builtin_amdgcn_s_waitcnt(0);
        unsigned nloc = b.st[0], nx = b.st[1];
        if (nloc == 0u) { xcd_barrier_complete(bar, b.x, nloc, nx); b.st[0] = nloc; b.st[1] = nx; }
        const unsigned old = xb_add(&bar[XB_XSUB(b.x)], 1u);
        const unsigned gen = old / nloc;
        if (old + 1u == (gen + 1u) * nloc) {
            __builtin_amdgcn_fence(__ATOMIC_RELEASE, "agent");
            asm volatile("s_waitcnt vmcnt(0)" ::: "memory");
            const unsigned og = xb_add(&bar[XB_TOP], 1u);
            const unsigned tg = og / nx;
            if (og + 1u == (tg + 1u) * nx) xb_add(&bar[XB_TOPGEN], 1u);
            else XB_SPIN(xb_ld(&bar[XB_TOPGEN]) == tg, bar);
            __builtin_amdgcn_fence(__ATOMIC_ACQUIRE, "agent");
            xb_add(&bar[XB_XGEN(b.x)], 1u);
            asm volatile("s_waitcnt vmcnt(0)" ::: "memory");
        } else {
            XB_SPIN(xb_ld(&bar[XB_XGEN(b.x)]) == gen, bar);
            __builtin_amdgcn_fence(__ATOMIC_ACQUIRE, "agent");
            asm volatile("s_waitcnt vmcnt(0)" ::: "memory");
        }
    }
    __syncthreads();
}
namespace pg8 {
#define PG8_LAS __attribute__((address_space(3)))
typedef unsigned short bf16_t;
typedef short bf16x8 __attribute__((ext_vector_type(8)));
typedef float f32x4 __attribute__((ext_vector_type(4)));
typedef unsigned u32x4 __attribute__((ext_vector_type(4)));
typedef _Float16 h16x8 __attribute__((ext_vector_type(8)));
constexpr int BM = 256, BK = 64, HALF = 128, HTB = HALF * BK * 2  , STAGE_BYTES = 8 * HTB, NXCD = 8, WGM = 8;

__host__ __device__ __forceinline__ int lds_byte(int r, int c) { const int st = (r >> 4) * 2 + (c >> 5), rr = r & 15, cc = c & 31, ob = rr * 64 + cc * 2; return st * 1024 + (ob ^ (((ob >> 9) & 1) << 5)); }
__host__ __device__ __forceinline__ void stage_rc(int b, int& R, int& C) { const int st = b / 1024, sb = b % 1024, swz = sb ^ (((sb >> 9) & 1) << 5); R = (st >> 1) * 16 + swz / 64; C = (st & 1) * 32 + (swz % 64) / 2; }
__host__ __device__ __forceinline__ int perm32(int rho) { const int n = rho >> 4, i = rho & 15; return 8 * (i >> 2) + 4 * n + (i & 3); }

struct Unit { int pm, pn; };
struct Gemm { const bf16_t* A; const bf16_t* Bt; int M, N, K, lda, ldb; };

struct StaticOrder {
    int nM, nN, nwg, G, c;
    __host__ __device__ void init(int M, int N, int G_, int c_) { nM = M / BM; nN = N / BM; nwg = nM * nN; G = G_; c = c_; }
    __host__ __device__ bool next(int i, Unit& u) const {
        const long L = (long)i * G + c; if (L >= nwg) return false;
        int wgid = (int)L; { const int q = nwg / NXCD, r = nwg % NXCD, xcd = wgid % NXCD, off = wgid / NXCD; wgid = (xcd < r ? xcd * (q + 1) : r * (q + 1) + (xcd - r) * q) + off; }
        const int nig = WGM * nN, gid = wgid / nig, fm = gid * WGM, gsz = (nM - fm) < WGM ? (nM - fm) : WGM;
        u.pm = fm + ((wgid % nig) % gsz); u.pn = (wgid % nig) / gsz; return true;
    }
    __device__ __forceinline__ void a_ready(const Unit&) const {}
    __device__ __forceinline__ void done(const Unit&) const {}
};

__device__ __forceinline__ unsigned cvt_pk_bf16(float lo, float hi) { unsigned r; asm volatile("v_cvt_pk_bf16_f32 %0, %1, %2" : "=v"(r) : "v"(lo), "v"(hi)); return r; }

__device__ __forceinline__ float row_rstd(const unsigned long long* ss, int row, float inv_n) { return 1.0f / sqrtf((float)ss[row] * (inv_n * 9.5367431640625e-07f) + 1e-6f); }
struct RowFac { const PG8_LAS float* tab;
    __device__ __forceinline__ float get(int row) const { return tab[row]; } };
struct EpiStore {
    static constexpr bool PERM = true, AFTER_DRAIN = false;
    bf16_t* O; int ldc; RowFac rf;
    __device__ __forceinline__ void operator()(const f32x4 (&acc)[2][2][4][2], const Unit& u, int wr, int wc, int fr, int fq) const {
        const int row0 = u.pm * BM + wr * 64 + fr, col0 = u.pn * BM + wc * 32 + 8 * fq;
#pragma unroll
        for (int ai = 0; ai < 2; ++ai)
#pragma unroll
            for (int m = 0; m < 4; ++m) { const int row = row0 + ai * HALF + m * 16; bf16_t* rowp = O + (size_t)row * ldc + col0;
                const float rs = rf.get(row);
#pragma unroll
                for (int bj = 0; bj < 2; ++bj) { const f32x4 v0 = acc[ai][bj][m][0] * rs, v1 = acc[ai][bj][m][1] * rs;
                    u32x4 w; w.x = cvt_pk_bf16(v0[0], v0[1]); w.y = cvt_pk_bf16(v0[2], v0[3]); w.z = cvt_pk_bf16(v1[0], v1[1]); w.w = cvt_pk_bf16(v1[2], v1[3]);
                    *(u32x4*)(rowp + bj * HALF) = w; } }
    }
};
struct EpiSwiGLU {
    static constexpr bool PERM = true, AFTER_DRAIN = false;
    bf16_t* O; int ldc; RowFac rf;
    __device__ __forceinline__ void operator()(const f32x4 (&acc)[2][2][4][2], const Unit& u, int wr, int wc, int fr, int fq) const {
        const int row0 = u.pm * BM + wr * 64 + fr, col0 = u.pn * HALF + wc * 32 + 8 * fq;
#pragma unroll
        for (int ai = 0; ai < 2; ++ai)
#pragma unroll
            for (int m = 0; m < 4; ++m) { const int row = row0 + ai * HALF + m * 16; bf16_t* rowp = O + (size_t)row * ldc + col0;
                const float rs = rf.get(row);
                float h[8];
#pragma unroll
                for (int n = 0; n < 2; ++n)
#pragma unroll
                    for (int i = 0; i < 4; ++i) { const float g = acc[ai][0][m][n][i] * rs, up = acc[ai][1][m][n][i] * rs;
                        h[n * 4 + i] = g * up * __builtin_amdgcn_rcpf(1.0f + __builtin_amdgcn_exp2f(g * -1.4426950408889634f)); }
                u32x4 w; w.x = cvt_pk_bf16(h[0], h[1]); w.y = cvt_pk_bf16(h[2], h[3]); w.z = cvt_pk_bf16(h[4], h[5]); w.w = cvt_pk_bf16(h[6], h[7]);
                *(u32x4*)rowp = w; }
    }
};
struct EpiResid {
    static constexpr bool PERM = true, AFTER_DRAIN = false;
    bf16_t* xb; unsigned long long* ssn; int ldc; float alpha;
    __device__ __forceinline__ void operator()(const f32x4 (&acc)[2][2][4][2], const Unit& u, int wr, int wc, int fr, int fq) const {
        const int row0 = u.pm * BM + wr * 64 + fr, col0 = u.pn * BM + wc * 32 + 8 * fq;
        u32x4 old[2][4][2];
#pragma unroll
        for (int ai = 0; ai < 2; ++ai)
#pragma unroll
            for (int m = 0; m < 4; ++m)
#pragma unroll
                for (int bj = 0; bj < 2; ++bj) old[ai][m][bj] = *(const u32x4*)(xb + (size_t)(row0 + ai * HALF + m * 16) * ldc + col0 + bj * HALF);
#pragma unroll
        for (int ai = 0; ai < 2; ++ai)
#pragma unroll
            for (int m = 0; m < 4; ++m) { const int row = row0 + ai * HALF + m * 16; bf16_t* rowp = xb + (size_t)row * ldc + col0; float sq = 0.f;
#pragma unroll
                for (int bj = 0; bj < 2; ++bj) { const u32x4 b = old[ai][m][bj];
                    float v[8];
#pragma unroll
                    for (int e = 0; e < 4; ++e) { v[2 * e] = __builtin_bit_cast(float, b[e] << 16) + acc[ai][bj][m][e >> 1][2 * (e & 1)] * alpha;
                                                  v[2 * e + 1] = __builtin_bit_cast(float, b[e] & 0xffff0000u) + acc[ai][bj][m][e >> 1][2 * (e & 1) + 1] * alpha; }
#pragma unroll
                    for (int e = 0; e < 8; ++e) sq += v[e] * v[e];
                    u32x4 w; w.x = cvt_pk_bf16(v[0], v[1]); w.y = cvt_pk_bf16(v[2], v[3]); w.z = cvt_pk_bf16(v[4], v[5]); w.w = cvt_pk_bf16(v[6], v[7]);
                    *(u32x4*)(rowp + bj * HALF) = w; }
                sq += __shfl_xor(sq, 16); sq += __shfl_xor(sq, 32);
                if (fq == 0) __hip_atomic_fetch_add(ssn + row, (unsigned long long)(sq * 1048576.0f + 0.5f), __ATOMIC_RELAXED, __HIP_MEMORY_SCOPE_AGENT); }
    }
};

template <class Epi, class Sched, bool ALIGN_EPI = false, bool SP2 = false, bool F16 = false>
__device__ __forceinline__ void gemm_phase(PG8_LAS unsigned char* lds, const Gemm g, const Sched& S, const Epi& E) {
    __builtin_amdgcn_s_waitcnt(0);
    int tid_l = threadIdx.x; asm volatile("" : "+v"(tid_l));
    const int tid = tid_l, wid = __builtin_amdgcn_readfirstlane(tid >> 6), lane = tid & 63, wr = wid >> 2, wc = wid & 3, fr = lane & 15, fq = lane >> 4;
    const int K = g.K, nt = K / BK, lda = g.lda, ldb = g.ldb;
    unsigned voffA[2], voffB[2];
#pragma unroll
    for (int i = 0; i < 2; ++i) { int R, C; stage_rc(tid * 16 + i * 8192, R, C); const int Rb = Epi::PERM ? ((R & ~31) + perm32(R & 31)) : R;
        voffA[i] = (unsigned)(R * lda + C) * 2u; voffB[i] = (unsigned)(Rb * ldb + C) * 2u; }
    const size_t kstep = (size_t)(BK * 2);
    const size_t hstepA = (size_t)HALF * lda * 2, hstepB = (size_t)HALF * ldb * 2;
    const size_t tstepA = 2 * hstepA, tstepB = 2 * hstepB;
    const unsigned ldsw = (unsigned)wid * 1024u;
    const int aoff = lds_byte(wr * 64 + fr, fq * 8), boff = lds_byte(wc * 32 + fr, fq * 8);
#define PG8_SA(b, h) (((b) * 2 + (h)) * HTB)
#define PG8_SB(b, h) ((4 + (b) * 2 + (h)) * HTB)
#define PG8_STAGE(bufoff, gbase, voff) do { _Pragma("unroll") for (int _i = 0; _i < 2; ++_i) \
        __builtin_amdgcn_global_load_lds((const unsigned*)((const char*)(gbase) + (voff)[_i]), (PG8_LAS unsigned*)(lds + (bufoff) + ldsw + _i * 8192), 16, 0, 0); } while (0)
#define PG8_LDA(dst, b, h) do { _Pragma("unroll") for (int m = 0; m < 4; ++m) _Pragma("unroll") for (int k = 0; k < 2; ++k) dst[m][k] = *(const PG8_LAS bf16x8*)(lds + PG8_SA(b, h) + aoff + m * 2048 + k * 1024); } while (0)
#define PG8_LDB(dst, b, h) do { _Pragma("unroll") for (int n = 0; n < 2; ++n) _Pragma("unroll") for (int k = 0; k < 2; ++k) dst[n][k] = *(const PG8_LAS bf16x8*)(lds + PG8_SB(b, h) + boff + n * 2048 + k * 1024); } while (0)
#define PG8_MMA(ai, bj, At, Bt) do { __builtin_amdgcn_s_setprio(1); _Pragma("unroll") for (int m = 0; m < 4; ++m) _Pragma("unroll") for (int n = 0; n < 2; ++n) _Pragma("unroll") for (int k = 0; k < 2; ++k) \
        acc[ai][bj][m][n] = F16 ? __builtin_amdgcn_mfma_f32_16x16x32_f16(__builtin_bit_cast(h16x8, Bt[n][k]), __builtin_bit_cast(h16x8, At[m][k]), acc[ai][bj][m][n], 0, 0, 0) \
                                : __builtin_amdgcn_mfma_f32_16x16x32_bf16(Bt[n][k], At[m][k], acc[ai][bj][m][n], 0, 0, 0); __builtin_amdgcn_s_setprio(0); } while (0)
#define PG8_WAIT_V(n) asm volatile("s_waitcnt vmcnt(" #n ")" ::: "memory")
#define PG8_WAIT_L(n) asm volatile("s_waitcnt lgkmcnt(" #n ")" ::: "memory")
#define PG8_BAR __builtin_amdgcn_s_barrier()
#define PG8_SCHED __builtin_amdgcn_sched_barrier(0)
    Unit cur, nxt; int ui = 0;
    if (!S.next(0, cur)) return;
    f32x4 acc[2][2][4][2];
#pragma unroll
    for (int a = 0; a < 2; ++a)
#pragma unroll
        for (int b = 0; b < 2; ++b)
#pragma unroll
            for (int m = 0; m < 4; ++m)
#pragma unroll
                for (int n = 0; n < 2; ++n) acc[a][b][m][n] = (f32x4){0.f, 0.f, 0.f, 0.f};
    bf16x8 At[4][2], B0[2][2], B1[2][2];
    const char* cA = (const char*)g.A + (size_t)cur.pm * tstepA; const char* cB = (const char*)g.Bt + (size_t)cur.pn * tstepB;
    S.a_ready(cur);
    if constexpr (SP2) {
        PG8_STAGE(PG8_SB(0, 0), cB, voffB); PG8_STAGE(PG8_SB(0, 1), cB + hstepB, voffB); PG8_STAGE(PG8_SA(0, 0), cA, voffA); PG8_STAGE(PG8_SA(0, 1), cA + hstepA, voffA);
        if (wr == 1) PG8_BAR;
        PG8_WAIT_V(2); PG8_BAR;
        PG8_STAGE(PG8_SB(1, 0), cB + kstep, voffB); PG8_STAGE(PG8_SA(1, 0), cA + kstep, voffA); PG8_STAGE(PG8_SB(1, 1), cB + hstepB + kstep, voffB);
        PG8_WAIT_V(6); PG8_BAR;
    } else {
        PG8_STAGE(PG8_SB(0, 0), cB, voffB); PG8_STAGE(PG8_SA(0, 0), cA, voffA); PG8_STAGE(PG8_SB(0, 1), cB + hstepB, voffB); PG8_STAGE(PG8_SA(0, 1), cA + hstepA, voffA);
        if (wr == 1) PG8_BAR;
        PG8_WAIT_V(4); PG8_BAR;
        PG8_STAGE(PG8_SB(1, 0), cB + kstep, voffB); PG8_STAGE(PG8_SA(1, 0), cA + kstep, voffA); PG8_STAGE(PG8_SB(1, 1), cB + hstepB + kstep, voffB);
        PG8_WAIT_V(6); PG8_BAR;
    }
    for (;;) {
        const bool has_next = S.next(ui + 1, nxt);
        const char* nA = has_next ? (const char*)g.A + (size_t)nxt.pm * tstepA : cA; const char* nB = has_next ? (const char*)g.Bt + (size_t)nxt.pn * tstepB : cB;
        for (int t = 0; t < nt; t += 2) {
            const bool last = (t == nt - 2);
            const char* a1 = cA + (size_t)(t + 1) * kstep;
            const char* a2 = last ? nA : cA + (size_t)(t + 2) * kstep; const char* b2 = last ? nB : cB + (size_t)(t + 2) * kstep;
            const char* a3 = a2 + kstep; const char* b3 = b2 + kstep;
            if (last && has_next) S.a_ready(nxt);
            if constexpr (SP2) {
            PG8_LDB(B0, 0, 0); PG8_LDB(B1, 0, 1); PG8_SCHED; PG8_LDA(At, 0, 0); PG8_STAGE(PG8_SA(1, 1), a1 + hstepA, voffA);
            PG8_WAIT_V(8); PG8_WAIT_L(0); PG8_BAR; PG8_MMA(0, 0, At, B0); PG8_MMA(0, 1, At, B1); PG8_BAR; PG8_SCHED;
            PG8_LDA(At, 0, 1); PG8_STAGE(PG8_SB(0, 0), b2, voffB); PG8_STAGE(PG8_SB(0, 1), b2 + hstepB, voffB); PG8_STAGE(PG8_SA(0, 0), a2, voffA);
            PG8_WAIT_V(8); PG8_WAIT_L(0); PG8_BAR; PG8_MMA(1, 0, At, B0); PG8_MMA(1, 1, At, B1); PG8_BAR; PG8_SCHED;
            PG8_LDB(B0, 1, 0); PG8_LDB(B1, 1, 1); PG8_SCHED; PG8_LDA(At, 1, 0); PG8_STAGE(PG8_SA(0, 1), a2 + hstepA, voffA);
            PG8_WAIT_V(8); PG8_WAIT_L(0); PG8_BAR; PG8_MMA(0, 0, At, B0); PG8_MMA(0, 1, At, B1); PG8_BAR; PG8_SCHED;
            PG8_LDA(At, 1, 1); PG8_STAGE(PG8_SB(1, 0), b3, voffB); PG8_STAGE(PG8_SB(1, 1), b3 + hstepB, voffB); PG8_STAGE(PG8_SA(1, 0), a3, voffA);
            PG8_WAIT_V(8); PG8_WAIT_L(0); PG8_BAR; PG8_MMA(1, 0, At, B0); PG8_MMA(1, 1, At, B1); PG8_BAR; PG8_SCHED;
            } else {
            PG8_LDB(B0, 0, 0); PG8_SCHED; PG8_LDA(At, 0, 0); PG8_STAGE(PG8_SA(1, 1), a1 + hstepA, voffA);
            PG8_WAIT_L(8); PG8_BAR; PG8_WAIT_L(0); PG8_MMA(0, 0, At, B0); PG8_BAR; PG8_SCHED;
            PG8_LDB(B1, 0, 1); PG8_STAGE(PG8_SB(0, 0), b2, voffB);
            PG8_BAR; PG8_WAIT_L(0); PG8_MMA(0, 1, At, B1); PG8_BAR;
            PG8_LDA(At, 0, 1); PG8_STAGE(PG8_SA(0, 0), a2, voffA);
            PG8_BAR; PG8_WAIT_L(0); PG8_MMA(1, 0, At, B0); PG8_BAR; PG8_SCHED;
            PG8_STAGE(PG8_SB(0, 1), b2 + hstepB, voffB);
            PG8_WAIT_V(6); PG8_BAR; PG8_MMA(1, 1, At, B1); PG8_BAR;
            PG8_LDB(B0, 1, 0); PG8_SCHED; PG8_LDA(At, 1, 0); PG8_STAGE(PG8_SA(0, 1), a2 + hstepA, voffA);
            PG8_WAIT_L(8); PG8_BAR; PG8_WAIT_L(0); PG8_MMA(0, 0, At, B0); PG8_BAR; PG8_SCHED;
            PG8_LDB(B1, 1, 1); PG8_STAGE(PG8_SB(1, 0), b3, voffB);
            PG8_BAR; PG8_WAIT_L(0); PG8_MMA(0, 1, At, B1); PG8_BAR;
            PG8_LDA(At, 1, 1); PG8_STAGE(PG8_SA(1, 0), a3, voffA);
            PG8_BAR; PG8_WAIT_L(0); PG8_MMA(1, 0, At, B0); PG8_BAR; PG8_SCHED;
            PG8_STAGE(PG8_SB(1, 1), b3 + hstepB, voffB);
            PG8_WAIT_V(6); PG8_BAR; PG8_MMA(1, 1, At, B1); PG8_BAR;
            }
        }
        if constexpr (ALIGN_EPI) { if (wr == 0) PG8_BAR; }
        if constexpr (!Epi::AFTER_DRAIN) { E(acc, cur, wr, wc, fr, fq); S.done(cur); }
        if (!has_next) break;
#pragma unroll
        for (int a = 0; a < 2; ++a)
#pragma unroll
            for (int b = 0; b < 2; ++b)
#pragma unroll
                for (int m = 0; m < 4; ++m)
#pragma unroll
                    for (int n = 0; n < 2; ++n) acc[a][b][m][n] = (f32x4){0.f, 0.f, 0.f, 0.f};
        cur = nxt; cA = nA; cB = nB; ++ui;
        if constexpr (ALIGN_EPI) { if (wr == 1) PG8_BAR; }
    }
    PG8_WAIT_V(0);
    if constexpr (!ALIGN_EPI) { if (wr == 0) PG8_BAR; }
    PG8_BAR;
    if constexpr (Epi::AFTER_DRAIN) { E.fused(acc, cur, wr, wc, fr, fq, lds, wid, lane); S.done(cur); }
#undef PG8_SA
#undef PG8_SB
#undef PG8_STAGE
#undef PG8_LDA
#undef PG8_LDB
#undef PG8_MMA
#undef PG8_WAIT_V
#undef PG8_WAIT_L
#undef PG8_BAR
#undef PG8_SCHED
}
}
#ifndef PG8_SP2
#define PG8_SP2 true
#endif
#ifndef PG8_ALIGN
#define PG8_ALIGN true
#endif
namespace att {
constexpr int KSTR = 400, VSTR = 320;
constexpr int KBUF = 64 * KSTR, VBUF = 64 * VSTR;
constexpr int OFF_K = 0, OFF_V = 2 * KBUF, OFF_WS = OFF_V + 2 * VBUF, LDS_NEED = OFF_WS + NWAVES * 256;
constexpr float C2 = 0.07216878364870322f * 1.4426950408889634f;
static_assert(LDS_NEED <= RING_BYTES, "attention LDS");
typedef float f32x2_t __attribute__((ext_vector_type(2))); typedef __bf16 bf16x2_t __attribute__((ext_vector_type(2)));
typedef short v4i16_t __attribute__((ext_vector_type(4)));
__device__ __forceinline__ unsigned cvtpk(float lo, float hi) { f32x2_t v = {lo, hi}; bf16x2_t b = __builtin_convertvector(v, bf16x2_t); return __builtin_bit_cast(unsigned, b); }
__device__ __forceinline__ s16x4 trd(const LAS unsigned char* p) { return __builtin_bit_cast(s16x4, __builtin_amdgcn_ds_read_tr16_b64_v4i16((LAS v4i16_t*)p)); }
__device__ __forceinline__ int crow(int r, int hi) { return (r & 3) + 8 * (r >> 2) + 4 * hi; }
#define ATT_MFMA(a, b, c) __builtin_amdgcn_mfma_f32_32x32x16_bf16((a), (b), (c), 0, 0, 0)

__device__ __forceinline__ void attn_block(int b, int h, int qb, const bf16* __restrict__ Q, const bf16* __restrict__ KV, const bf16* __restrict__ KPE, const float* __restrict__ cosT, const float* __restrict__ sinT, bf16* __restrict__ MIXo, LAS unsigned char* lds) {
    int tid_l = threadIdx.x; asm volatile("" : "+v"(tid_l));
    const int tid = tid_l, lane = tid & 63, c = lane & 31, hi = lane >> 5;
    const int wid = __builtin_amdgcn_readfirstlane(tid >> 6);
    const size_t rowbase = (size_t)b * SEQ; const int q0 = qb * 256, qlo = q0 + wid * 32;
    const int NT = 4 * qb + 4;
    const bf16* qrow = Q + (rowbase + qlo + c) * QW + h * QKD + 8 * hi;
    bf16x8 qr[12];
#pragma unroll
    for (int d = 0; d < 12; ++d) qr[d] = *(const bf16x8*)(qrow + 16 * d);
    {
        const float* ct = cosT + (rowbase + qlo + c) * 32 + 4 * hi; const float* st = sinT + (rowbase + qlo + c) * 32 + 4 * hi;
#pragma unroll
        for (int dd = 0; dd < 4; ++dd) { const f32x4 cs = *(const f32x4*)(ct + 8 * dd), sn = *(const f32x4*)(st + 8 * dd);
            v4u w = __builtin_bit_cast(v4u, qr[8 + dd]);
#pragma unroll
            for (int e = 0; e < 4; ++e) { const float x1 = bflo(w[e]), x2 = bfhi(w[e]); w[e] = cvtpk(x1 * cs[e] - x2 * sn[e], x2 * cs[e] + x1 * sn[e]); }
            qr[8 + dd] = __builtin_bit_cast(bf16x8, w); }
    }
    const int kkey = tid >> 4, kch = tid & 15, pkey = tid >> 3, pch = tid & 7;
    const bf16* gk = KV + (rowbase + kkey) * KVW + h * 256 + kch * 8;
    const bf16* gv = gk + 128;
    const bf16* gp = KPE + (rowbase + pkey) * 64 + pch * 8;
    const int lk0 = kkey * KSTR + kch * 16, lk1 = lk0 + 32 * KSTR, lp = pkey * KSTR + 256 + pch * 16;
    const int lv0 = kkey * VSTR + kch * 16, lv1 = lv0 + 32 * VSTR;
    v4u sk0, sk1, sp, sv0, sv1;
#define ATT_LOAD(t) do { const size_t o_ = (size_t)(t) * 64 * KVW; sk0 = *(const v4u*)(gk + o_); sk1 = *(const v4u*)(gk + o_ + 32 * KVW); \
        sv0 = *(const v4u*)(gv + o_); sv1 = *(const v4u*)(gv + o_ + 32 * KVW); sp = *(const v4u*)(gp + (size_t)(t) * 64 * 64); } while (0)
#define ATT_WRITE(bi) do { LAS unsigned char* kb_ = lds + OFF_K + (bi) * KBUF; LAS unsigned char* vb_ = lds + OFF_V + (bi) * VBUF; \
        *(LAS v4u*)(kb_ + lk0) = sk0; *(LAS v4u*)(kb_ + lk1) = sk1; *(LAS v4u*)(kb_ + lp) = sp; *(LAS v4u*)(vb_ + lv0) = sv0; *(LAS v4u*)(vb_ + lv1) = sv1; } while (0)
    LAS float* wsf = (LAS float*)(lds + OFF_WS) + wid * 64;
    float m_run = -1e30f, l_run = 0.f;
    f32x16 o[4];
#pragma unroll
    for (int d0 = 0; d0 < 4; ++d0)
#pragma unroll
        for (int r = 0; r < 16; ++r) o[d0][r] = 0.f;
    const int i16 = lane & 15, qq = i16 >> 2, pp = i16 & 3, blk = (lane >> 4) & 1;
    const int voff = (4 * hi + qq) * VSTR + 32 * blk + 8 * pp;
    const int koff = c * KSTR + hi * 16;
    ATT_LOAD(0); ATT_WRITE(0); __syncthreads();
    for (int t = 0; t < NT; ++t) {
        const int cur = t & 1, kb0 = 64 * t;
        if (t + 1 < NT) ATT_LOAD(t + 1);
        if (kb0 <= qlo + 31) {
            f32x16 p0, p1;
#pragma unroll
            for (int r = 0; r < 16; ++r) { p0[r] = 0.f; p1[r] = 0.f; }
            const LAS unsigned char* kp = lds + OFF_K + cur * KBUF + koff;
#pragma unroll
            for (int dg = 0; dg < 3; ++dg) {
                bf16x8 k0[4], k1[4];
#pragma unroll
                for (int j = 0; j < 4; ++j) { k0[j] = *(const LAS bf16x8*)(kp + (4 * dg + j) * 32); k1[j] = *(const LAS bf16x8*)(kp + 32 * KSTR + (4 * dg + j) * 32); }
                __builtin_amdgcn_sched_barrier(0);
#pragma unroll
                for (int j = 0; j < 4; ++j) { p0 = ATT_MFMA(k0[j], qr[4 * dg + j], p0); p1 = ATT_MFMA(k1[j], qr[4 * dg + j], p1); }
            }
            if (kb0 + 63 > qlo) {
                const int dq = qlo + c - kb0 - 4 * hi; const float NEG = -__builtin_inff();
#pragma unroll
                for (int r = 0; r < 16; ++r) { const int cr = (r & 3) + 8 * (r >> 2); if (cr > dq) p0[r] = NEG; if (cr + 32 > dq) p1[r] = NEG; }
            }
            float mx = p0[0];
#pragma unroll
            for (int r = 1; r < 16; ++r) mx = fmaxf(mx, p0[r]);
#pragma unroll
            for (int r = 0; r < 16; ++r) mx = fmaxf(mx, p1[r]);
            mx = fmaxf(mx, __shfl_xor(mx, 32));
            float mn = m_run, alpha = 1.0f;
            if (!__all((mx - m_run) * C2 <= 6.0f)) { mn = fmaxf(m_run, mx); alpha = __builtin_amdgcn_exp2f((m_run - mn) * C2); m_run = mn; }
            const float mnc = mn * C2;
            float rs = 0.f;
#pragma unroll
            for (int r = 0; r < 16; ++r) { p0[r] = __builtin_amdgcn_exp2f(p0[r] * C2 - mnc); p1[r] = __builtin_amdgcn_exp2f(p1[r] * C2 - mnc); rs += p0[r] + p1[r]; }
            rs += __shfl_xor(rs, 32);
            l_run = l_run * alpha + rs;
            if (__any(alpha < 1.0f)) {
                if (hi == 0) wsf[c] = alpha;
                LDS_WAIT();
#pragma unroll
                for (int r = 0; r < 16; ++r) { const float a = wsf[crow(r, hi)];
#pragma unroll
                    for (int d0 = 0; d0 < 4; ++d0) o[d0][r] *= a; }
            }
            const LAS unsigned char* vp = lds + OFF_V + cur * VBUF + voff;
#pragma unroll
            for (int kb = 0; kb < 2; ++kb)
#pragma unroll
                for (int s = 0; s < 2; ++s) {
                    v4u pw;
                    if (kb == 0) { pw.x = cvtpk(p0[8 * s + 0], p0[8 * s + 1]); pw.y = cvtpk(p0[8 * s + 2], p0[8 * s + 3]); pw.z = cvtpk(p0[8 * s + 4], p0[8 * s + 5]); pw.w = cvtpk(p0[8 * s + 6], p0[8 * s + 7]); }
                    else         { pw.x = cvtpk(p1[8 * s + 0], p1[8 * s + 1]); pw.y = cvtpk(p1[8 * s + 2], p1[8 * s + 3]); pw.z = cvtpk(p1[8 * s + 4], p1[8 * s + 5]); pw.w = cvtpk(p1[8 * s + 6], p1[8 * s + 7]); }
                    const bf16x8 pa = __builtin_bit_cast(bf16x8, pw);
                    s16x4 lo[4], hh[4];
#pragma unroll
                    for (int d0 = 0; d0 < 4; ++d0) { lo[d0] = trd(vp + (32 * kb + 16 * s) * VSTR + 64 * d0); hh[d0] = trd(vp + (32 * kb + 16 * s + 8) * VSTR + 64 * d0); }
                    __builtin_amdgcn_sched_barrier(0);
#pragma unroll
                    for (int d0 = 0; d0 < 4; ++d0) o[d0] = ATT_MFMA(pa, __builtin_shufflevector(lo[d0], hh[d0], 0, 1, 2, 3, 4, 5, 6, 7), o[d0]);
                }
        }
        if (t + 1 < NT) ATT_WRITE(cur ^ 1);
        __syncthreads();
    }
    if (hi == 0) wsf[32 + c] = l_run;
    LDS_WAIT();
    bf16* ob = MIXo + (rowbase + qlo) * 4096 + h * 128 + c;
#pragma unroll
    for (int r = 0; r < 16; ++r) { const int orow = crow(r, hi); const float rl = 1.0f / wsf[32 + orow];
#pragma unroll
        for (int d0 = 0; d0 < 4; ++d0) { const float v = o[d0][r] * rl, vn = __shfl_xor(v, 1);
            if ((c & 1) == 0) *(unsigned*)(ob + (size_t)orow * 4096 + d0 * 32) = pk2(v, vn); } }
    LDS_WAIT();
#undef ATT_LOAD
#undef ATT_WRITE
}
}
namespace ssd {
constexpr int RS = 272;
constexpr int BUF = 128 * RS + 128 * 64 + 2560;
constexpr int OFF_X = 128 * RS, OFF_SC = OFF_X + 128 * 64, OFF_S = 2 * BUF;
constexpr int SC_ACS = 0, SC_DT = 512, SC_ECS = 1024, SC_WEND = 1536, SC_ETOT = 2048, LDS_NEED = OFF_S + 2 * 32 * RS;
static_assert(LDS_NEED <= RING_BYTES && BUF % 16 == 0, "ssd LDS");
constexpr float LOG2E = 1.4426950408889634f;
#define SSD_MFMA(a, b, c) __builtin_amdgcn_mfma_f32_32x32x16_bf16((a), (b), (c), 0, 0, 0)
#define SSD_BAR() do { asm volatile("s_waitcnt lgkmcnt(0)" ::: "memory"); __builtin_amdgcn_s_barrier(); asm volatile("" ::: "memory"); } while (0)

__device__ __forceinline__ void ssd_unit(int unit, const bf16* __restrict__ XBC, const float* __restrict__ DT, const bf16* __restrict__ PROJ, const float* a_log, const float* d_skip,
                                         bf16* __restrict__ MIXo, LAS unsigned char* lds) {
    int tid_l = threadIdx.x; asm volatile("" : "+v"(tid_l));
    const int tid = tid_l, lane = tid & 63, c = lane & 31, hi = lane >> 5;
    const int wid = __builtin_amdgcn_readfirstlane(tid >> 6);
    const int b = unit >> 6, h = (unit >> 1) & 31, ph = unit & 1, g = h >> 2, pcol0 = h * 64 + 32 * ph;
    const float A2 = -expf(a_log[h]) * LOG2E, Dk = d_skip[h];
    const size_t mb = (size_t)b * SEQ;
    LAS unsigned char* Ss = lds + OFF_S;
    const int srow = tid >> 4, sch = tid & 15, xrow = tid >> 2, xch = tid & 3;
    const bf16* gB = XBC + (mb + srow) * 4096 + 2048 + g * 128 + sch * 8;
    const bf16* gX = XBC + (mb + xrow) * 4096 + pcol0 + xch * 8;
    const float* gD = DT + (mb + 2 * lane) * 32 + h;
    const bf16* gCf = XBC + (mb + 32 * (wid & 3) + c) * 4096 + 3072 + g * 128 + 8 * hi;
    const int lcb = srow * RS + sch * 16, lx = OFF_X + xrow * 64 + xch * 16;
    v4u sb0, sb1, sb2, sb3, sx; float sd0 = 0.f, sd1 = 0.f;
#define SSD_LOAD(ch) do { const size_t o_ = (size_t)(ch) * 128 * 4096; \
        sb0 = *(const v4u*)(gB + o_); sb1 = *(const v4u*)(gB + o_ + 32 * 4096); sb2 = *(const v4u*)(gB + o_ + 64 * 4096); sb3 = *(const v4u*)(gB + o_ + 96 * 4096); \
        sx = *(const v4u*)(gX + o_); if (wid == 0) { sd0 = gD[(size_t)(ch) * 128 * 32]; sd1 = gD[(size_t)(ch) * 128 * 32 + 32]; } } while (0)
#define SSD_WRITE(bufp) do { LAS unsigned char* wb_ = (bufp); \
        *(LAS v4u*)(wb_ + lcb) = sb0; *(LAS v4u*)(wb_ + lcb + 32 * RS) = sb1; *(LAS v4u*)(wb_ + lcb + 64 * RS) = sb2; *(LAS v4u*)(wb_ + lcb + 96 * RS) = sb3; \
        *(LAS v4u*)(wb_ + lx) = sx; \
        if (wid == 0) {     \
            LAS float* sc_ = (LAS float*)(wb_ + OFF_SC); \
            const float a0_ = sd0 * A2, a1_ = sd1 * A2, pr_ = a0_ + a1_; float inc_ = pr_; \
            _Pragma("unroll") for (int o_ = 1; o_ < 64; o_ <<= 1) { const float v_ = __shfl_up(inc_, o_); if (lane >= o_) inc_ += v_; } \
            const float cs0_ = inc_ - pr_ + a0_, cs1_ = inc_, tot_ = __shfl(inc_, 63); \
            *(LAS f32x2*)(sc_ + SC_ACS / 4 + 2 * lane) = (f32x2){cs0_, cs1_}; *(LAS f32x2*)(sc_ + SC_DT / 4 + 2 * lane) = (f32x2){sd0, sd1}; \
            *(LAS f32x2*)(sc_ + SC_ECS / 4 + 2 * lane) = (f32x2){__builtin_amdgcn_exp2f(cs0_), __builtin_amdgcn_exp2f(cs1_)}; \
            *(LAS f32x2*)(sc_ + SC_WEND / 4 + 2 * lane) = (f32x2){sd0 * __builtin_amdgcn_exp2f(tot_ - cs0_), sd1 * __builtin_amdgcn_exp2f(tot_ - cs1_)}; \
            if (lane == 63) sc_[SC_ETOT / 4] = __builtin_amdgcn_exp2f(tot_); } } while (0)
    const int i16 = lane & 15, qq = i16 >> 2, pp = i16 & 3, blk = (lane >> 4) & 1;
    f32x16 ST;
#pragma unroll
    for (int r = 0; r < 16; ++r) ST[r] = 0.f;
    bf16x8 cfn[8];
#pragma unroll
    for (int ks = 0; ks < 8; ++ks) cfn[ks] = *(const bf16x8*)(gCf + 16 * ks);
    SSD_LOAD(0); SSD_WRITE(lds);
    for (int i = tid; i < (32 * RS) / 16; i += NTHREADS) *(LAS v4u*)(Ss + i * 16) = (v4u){0u, 0u, 0u, 0u};
    SSD_BAR();
    for (int ch = 0; ch < SEQ / 128; ++ch) {
        const int chn = ch + 1 < SEQ / 128 ? ch + 1 : ch;
        SSD_LOAD(chn);
        const size_t m0 = mb + (size_t)ch * 128;
        LAS unsigned char* cb = lds + (ch & 1) * BUF;
        LAS unsigned char* Bs = cb; LAS unsigned char* Xs = cb + OFF_X;
        LAS float* acs = (LAS float*)(cb + OFF_SC + SC_ACS); LAS float* dtv = (LAS float*)(cb + OFF_SC + SC_DT); LAS float* ecs = (LAS float*)(cb + OFF_SC + SC_ECS);
        LAS float* wend = (LAS float*)(cb + OFF_SC + SC_WEND); LAS float* etot = (LAS float*)(cb + OFF_SC + SC_ETOT);
        if (wid < 4) {
            const int lb = wid;
            unsigned short zr[16];
            { const bf16* zp = PROJ + (m0 + 32 * lb + 4 * hi) * INCP + O_Z + pcol0 + c;
#pragma unroll
              for (int r = 0; r < 16; ++r) zr[r] = zp[(size_t)((r & 3) + 8 * (r >> 2)) * INCP]; }
            bf16x8 cf[8];
#pragma unroll
            for (int ks = 0; ks < 8; ++ks) cf[ks] = cfn[ks];
#pragma unroll
            for (int ks = 0; ks < 8; ++ks) cfn[ks] = *(const bf16x8*)(gCf + (size_t)chn * 128 * 4096 + 16 * ks);
            f32x16 y;
#pragma unroll
            for (int r = 0; r < 16; ++r) y[r] = 0.f;
            { const LAS unsigned char* sp = Ss + (ch & 1) * 32 * RS + c * RS + hi * 16; bf16x8 sf[8];
#pragma unroll
              for (int ks = 0; ks < 8; ++ks) sf[ks] = *(const LAS bf16x8*)(sp + ks * 32);
              __builtin_amdgcn_sched_barrier(0);
#pragma unroll
              for (int ks = 0; ks < 8; ++ks) y = SSD_MFMA(cf[ks], sf[ks], y); }
#pragma unroll
            for (int g4 = 0; g4 < 4; ++g4) { const f32x4 e = *(const LAS f32x4*)(ecs + 32 * lb + 8 * g4 + 4 * hi);
#pragma unroll
                for (int i = 0; i < 4; ++i) y[4 * g4 + i] *= e[i]; }
            const float acl = acs[32 * lb + c];
            for (int sb = 0; sb <= lb; ++sb) {
                f32x16 gt;
#pragma unroll
                for (int r = 0; r < 16; ++r) gt[r] = 0.f;
                const LAS unsigned char* bp = Bs + (32 * sb + c) * RS + hi * 16;
                const LAS unsigned char* xp0 = Xs + (32 * sb + 4 * hi + qq) * 64 + (16 * blk + 4 * pp) * 2;
                const s16x4 xl0 = att::trd(xp0), xh0 = att::trd(xp0 + 8 * 64), xl1 = att::trd(xp0 + 16 * 64), xh1 = att::trd(xp0 + 24 * 64);
#pragma unroll
                for (int kg = 0; kg < 2; ++kg) { bf16x8 bfr[4];
#pragma unroll
                    for (int k4 = 0; k4 < 4; ++k4) bfr[k4] = *(const LAS bf16x8*)(bp + (4 * kg + k4) * 32);
                    __builtin_amdgcn_sched_barrier(0);
#pragma unroll
                    for (int k4 = 0; k4 < 4; ++k4) gt = SSD_MFMA(bfr[k4], cf[4 * kg + k4], gt); }
                const int dl = 32 * (lb - sb) + c - 4 * hi;
#pragma unroll
                for (int gh = 0; gh < 2; ++gh) { f32x4 as4[2], ds4[2];
#pragma unroll
                    for (int g2 = 0; g2 < 2; ++g2) { as4[g2] = *(const LAS f32x4*)(acs + 32 * sb + 8 * (2 * gh + g2) + 4 * hi); ds4[g2] = *(const LAS f32x4*)(dtv + 32 * sb + 8 * (2 * gh + g2) + 4 * hi); }
#pragma unroll
                    for (int g2 = 0; g2 < 2; ++g2) { const int g4 = 2 * gh + g2;
#pragma unroll
                        for (int i = 0; i < 4; ++i) { const float w = __builtin_amdgcn_exp2f(fminf(acl - as4[g2][i], 0.f)) * ds4[g2][i]; gt[4 * g4 + i] = (8 * g4 + i <= dl) ? gt[4 * g4 + i] * w : 0.f; } } }
#pragma unroll
                for (int s2 = 0; s2 < 2; ++s2) {
                    v4u pw; pw.x = att::cvtpk(gt[8 * s2 + 0], gt[8 * s2 + 1]); pw.y = att::cvtpk(gt[8 * s2 + 2], gt[8 * s2 + 3]); pw.z = att::cvtpk(gt[8 * s2 + 4], gt[8 * s2 + 5]); pw.w = att::cvtpk(gt[8 * s2 + 6], gt[8 * s2 + 7]);
                    const s16x4 lo = s2 ? xl1 : xl0, hh = s2 ? xh1 : xh0;
                    y = SSD_MFMA(__builtin_bit_cast(bf16x8, pw), __builtin_shufflevector(lo, hh, 0, 1, 2, 3, 4, 5, 6, 7), y);
                }
            }
            bf16* op = MIXo + (m0 + 32 * lb + 4 * hi) * 4096 + 2048 + pcol0 + c;
            const LAS unsigned short* xl = (const LAS unsigned short*)(Xs + (32 * lb + 4 * hi) * 64 + 2 * c);
            unsigned short xr[16];
#pragma unroll
            for (int r = 0; r < 16; ++r) xr[r] = xl[((r & 3) + 8 * (r >> 2)) * 32];
            __builtin_amdgcn_sched_barrier(0);
#pragma unroll
            for (int r = 0; r < 16; ++r) { const int lr = (r & 3) + 8 * (r >> 2);
                const float v = (y[r] + Dk * bf1(xr[r])) * silu_f(bf1(zr[r]));
                op[(size_t)lr * 4096] = (bf16)f2bf(v); }
        } else {
            const int nb = wid - 4;
            const float et = etot[0];
#pragma unroll
            for (int r = 0; r < 16; ++r) ST[r] *= et;
            const LAS unsigned char* ap = Bs + (8 * hi + qq) * RS + (32 * nb + 16 * blk + 4 * pp) * 2;
            const LAS unsigned char* xp = Xs + (8 * hi + qq) * 64 + (16 * blk + 4 * pp) * 2;
#pragma unroll
            for (int kg = 0; kg < 2; ++kg) {
                s16x4 alo[4], ahh[4], xlo[4], xhh[4]; f32x4 w0[4], w1[4];
#pragma unroll
                for (int k4 = 0; k4 < 4; ++k4) { const int ks = 4 * kg + k4;
                    alo[k4] = att::trd(ap + 16 * ks * RS); ahh[k4] = att::trd(ap + (16 * ks + 4) * RS);
                    xlo[k4] = att::trd(xp + 16 * ks * 64); xhh[k4] = att::trd(xp + (16 * ks + 4) * 64);
                    w0[k4] = *(const LAS f32x4*)(wend + 16 * ks + 8 * hi); w1[k4] = *(const LAS f32x4*)(wend + 16 * ks + 8 * hi + 4); }
                __builtin_amdgcn_sched_barrier(0);
#pragma unroll
                for (int k4 = 0; k4 < 4; ++k4) {
                    v4u xw;
                    xw.x = att::cvtpk(bf1((bf16)xlo[k4][0]) * w0[k4][0], bf1((bf16)xlo[k4][1]) * w0[k4][1]); xw.y = att::cvtpk(bf1((bf16)xlo[k4][2]) * w0[k4][2], bf1((bf16)xlo[k4][3]) * w0[k4][3]);
                    xw.z = att::cvtpk(bf1((bf16)xhh[k4][0]) * w1[k4][0], bf1((bf16)xhh[k4][1]) * w1[k4][1]); xw.w = att::cvtpk(bf1((bf16)xhh[k4][2]) * w1[k4][2], bf1((bf16)xhh[k4][3]) * w1[k4][3]);
                    ST = SSD_MFMA(__builtin_shufflevector(alo[k4], ahh[k4], 0, 1, 2, 3, 4, 5, 6, 7), __builtin_bit_cast(bf16x8, xw), ST);
                }
            }
            LAS unsigned char* so = Ss + ((ch + 1) & 1) * 32 * RS + c * RS + (32 * nb + 4 * hi) * 2;
#pragma unroll
            for (int g4 = 0; g4 < 4; ++g4) { v2u w; w.x = att::cvtpk(ST[4 * g4], ST[4 * g4 + 1]); w.y = att::cvtpk(ST[4 * g4 + 2], ST[4 * g4 + 3]); *(LAS v2u*)(so + g4 * 16) = w; }
        }
        SSD_WRITE(lds + ((ch + 1) & 1) * BUF);
        SSD_BAR();
    }
    VM_WAIT();
#undef SSD_LOAD
#undef SSD_WRITE
}
}
struct Frame {
    LAS unsigned char* lds;
    volatile LAS unsigned* MISC;
    gu32* ctl;
    int wave;
    int vcu, G;
};

__device__ __forceinline__ void row_copy_ss(const float* xrow, bf16* orow, unsigned long long* ss, int lane) {
    const f32x4* xr = (const f32x4*)xrow + lane;
    f32x4 v[16]; float s = 0.f;
#pragma unroll
    for (int j = 0; j < 16; ++j) { v[j] = xr[64 * j]; s += (v[j].x * v[j].x + v[j].y * v[j].y) + (v[j].z * v[j].z + v[j].w * v[j].w); }
    s = wave_sum(s);
    v2u* o8 = (v2u*)orow + lane;
#pragma unroll
    for (int j = 0; j < 16; ++j) { v2u wb; wb.x = pk2(v[j].x, v[j].y); wb.y = pk2(v[j].z, v[j].w); o8[64 * j] = wb; }
    if (lane == 0) *ss = (unsigned long long)(s * 1048576.0f + 0.5f);
}
__device__ __forceinline__ void rms_row_out(const bf16* xrow, const float* gain, float* orow, int lane) {
    const v4u* xr = (const v4u*)xrow + lane; float v[64]; float s = 0.f;
#pragma unroll
    for (int j = 0; j < 8; ++j) { const v4u w = xr[64 * j];
#pragma unroll
        for (int e = 0; e < 4; ++e) { v[8 * j + 2 * e] = bflo(w[e]); v[8 * j + 2 * e + 1] = bfhi(w[e]); s += v[8 * j + 2 * e] * v[8 * j + 2 * e] + v[8 * j + 2 * e + 1] * v[8 * j + 2 * e + 1]; } }
    const float rstd = 1.0f / sqrtf(wave_sum(s) * (1.0f / DM) + EPS);
#pragma unroll
    for (int j = 0; j < 8; ++j) { const f32x4 g0 = *(const f32x4*)(gain + 512 * j + 8 * lane), g1 = *(const f32x4*)(gain + 512 * j + 8 * lane + 4);
        f32x4 o0, o1;
#pragma unroll
        for (int e = 0; e < 4; ++e) { o0[e] = v[8 * j + e] * rstd * g0[e]; o1[e] = v[8 * j + 4 + e] * rstd * g1[e]; }
        *(f32x4*)(orow + 512 * j + 8 * lane) = o0; *(f32x4*)(orow + 512 * j + 8 * lane + 4) = o1; }
}
__device__ __forceinline__ void prep_rows4(int m0, const bf16* PROJ, const float* cosT, const float* sinT, const float* dt_bias, unsigned long long* SSQ, bf16* KPE, float* DT, int lane) {
    v4u w[4][3]; unsigned short dtr[4];
#pragma unroll
    for (int r = 0; r < 4; ++r) { const bf16* pr = PROJ + (size_t)(m0 + r) * INCP;
        w[r][0] = *(const v4u*)(pr + 8 * lane); w[r][1] = *(const v4u*)(pr + 8 * (64 + lane));
        w[r][2] = lane < 56 ? *(const v4u*)(pr + 8 * (128 + lane)) : (v4u){0u, 0u, 0u, 0u};
        dtr[r] = lane < 32 ? pr[O_DT + lane] : (unsigned short)0; }
#pragma unroll
    for (int r = 0; r < 4; ++r) { const int m = m0 + r;
        float s0 = 0.f, s1 = 0.f, s2 = 0.f;
#pragma unroll
        for (int e = 0; e < 4; ++e) { float a = bflo(w[r][0][e]), b = bfhi(w[r][0][e]); s0 += a * a + b * b; a = bflo(w[r][1][e]); b = bfhi(w[r][1][e]); s1 += a * a + b * b; a = bflo(w[r][2][e]); b = bfhi(w[r][2][e]); s2 += a * a + b * b; }
        const float sq = wave_sum(s0 + (lane < 48 ? s1 : 0.f)), sk = wave_sum((lane < 48 ? 0.f : s1) + (lane < 48 ? s2 : 0.f));
        if (lane == 0) { SSQ[m] = (unsigned long long)(sq * 1048576.0f + 0.5f); SSQ[M + m] = (unsigned long long)(sk * 1048576.0f + 0.5f); }
        if (lane >= 48 && lane < 56) {
            const int ip = 4 * (lane - 48); const f32x4 cs = *(const f32x4*)(cosT + (size_t)m * 32 + ip), sn = *(const f32x4*)(sinT + (size_t)m * 32 + ip);
            v4u o;
#pragma unroll
            for (int e = 0; e < 4; ++e) { const float x1 = bflo(w[r][2][e]), x2 = bfhi(w[r][2][e]); o[e] = pk2(x1 * cs[e] - x2 * sn[e], x2 * cs[e] + x1 * sn[e]); }
            *(v4u*)(KPE + (size_t)m * 64 + 2 * ip) = o; }
        if (lane < 32) { const float v = bf1(dtr[r]) + dt_bias[lane]; DT[(size_t)m * 32 + lane] = fmaxf(v, 0.f) + log1pf(expf(-fabsf(v))); }
    }
}
__device__ __forceinline__ void conv_item(int item, const bf16* PROJ, const float* conv_w, const float* conv_b, bf16* XBC, int lane) {
    const int rr = item >> 3, sl = item & 7, ch0 = sl * 512 + lane * 8, m0 = rr * 32, t0 = m0 & (SEQ - 1);
    const bf16* src = PROJ + (size_t)m0 * INCP + O_XBC + ch0;
    bf16* dst = XBC + (size_t)m0 * 4096 + ch0;
    v4u x[35];
#pragma unroll
    for (int i = 0; i < 3; ++i) x[i] = t0 > 0 ? *(const v4u*)(src + (ptrdiff_t)(i - 3) * INCP) : (v4u){0u, 0u, 0u, 0u};
#pragma unroll
    for (int i = 0; i < 32; ++i) x[3 + i] = *(const v4u*)(src + (size_t)i * INCP);
    float w[4][8], bb[8];
#pragma unroll
    for (int k = 0; k < 4; ++k) { const f32x4 a = *(const f32x4*)(conv_w + k * CONVD + ch0), b2 = *(const f32x4*)(conv_w + k * CONVD + ch0 + 4);
#pragma unroll
        for (int e = 0; e < 4; ++e) { w[k][e] = a[e]; w[k][4 + e] = b2[e]; } }
    { const f32x4 a = *(const f32x4*)(conv_b + ch0), b2 = *(const f32x4*)(conv_b + ch0 + 4);
#pragma unroll
      for (int e = 0; e < 4; ++e) { bb[e] = a[e]; bb[4 + e] = b2[e]; } }
#pragma unroll
    for (int i = 0; i < 32; ++i) { v4u o;
#pragma unroll
        for (int e = 0; e < 4; ++e) {
            const float ya = bb[2 * e] + w[0][2 * e] * bflo(x[i][e]) + w[1][2 * e] * bflo(x[i + 1][e]) + w[2][2 * e] * bflo(x[i + 2][e]) + w[3][2 * e] * bflo(x[i + 3][e]);
            const float yc = bb[2 * e + 1] + w[0][2 * e + 1] * bfhi(x[i][e]) + w[1][2 * e + 1] * bfhi(x[i + 1][e]) + w[2][2 * e + 1] * bfhi(x[i + 2][e]) + w[3][2 * e + 1] * bfhi(x[i + 3][e]);
            o[e] = pk2(silu_f(ya), silu_f(yc)); }
        *(v4u*)(dst + (size_t)i * 4096) = o; }
}
template <int NR> __device__ __forceinline__ void gnorm_rows(bf16* row0, size_t rstride, const float* gw, int lane) {
    v4u w[NR][4];
#pragma unroll
    for (int r = 0; r < NR; ++r) { const v4u* p = (const v4u*)(row0 + r * rstride + 32 * lane);
#pragma unroll
        for (int j = 0; j < 4; ++j) w[r][j] = p[j]; }
    const float* g = gw + 32 * lane;
#pragma unroll
    for (int r = 0; r < NR; ++r) { float s = 0.f;
#pragma unroll
        for (int j = 0; j < 4; ++j)
#pragma unroll
            for (int e = 0; e < 4; ++e) { const float a = bflo(w[r][j][e]), b = bfhi(w[r][j][e]); s += a * a + b * b; }
        s += __shfl_xor(s, 1); s += __shfl_xor(s, 2); s += __shfl_xor(s, 4);
        const float rstd = 1.0f / sqrtf(s * (1.0f / 256.0f) + EPS);
        v4u* p = (v4u*)(row0 + r * rstride + 32 * lane);
#pragma unroll
        for (int j = 0; j < 4; ++j) { v4u o;
#pragma unroll
            for (int e = 0; e < 4; ++e) o[e] = pk2(bflo(w[r][j][e]) * rstd * g[8 * j + 2 * e], bfhi(w[r][j][e]) * rstd * g[8 * j + 2 * e + 1]);
            p[j] = o; } }
}
__device__ __forceinline__ void ssd_item(int item, const bf16* XBC, const float* DT, const bf16* PROJ, const float* a_log, const float* d_skip, bf16* MIXo, int lane) {
    const int pi = lane >> 4, ns = lane & 15;
    const int b = item >> 9, h = (item >> 4) & 31, pq = item & 15, g = h >> 2;
    const float A2 = -expf(a_log[h]) * 1.4426950408889634f, Dk = d_skip[h];
    const int pcol = h * 64 + pq * 4 + pi;
    float st[8];
#pragma unroll
    for (int k = 0; k < 8; ++k) st[k] = 0.f;
    const bf16* xb = XBC + (size_t)b * SEQ * 4096; const float* dtp = DT + (size_t)b * SEQ * 32 + h;
    const bf16* zp = PROJ + (size_t)b * SEQ * INCP + O_Z + pcol; bf16* op = MIXo + (size_t)b * SEQ * 4096 + 2048 + pcol;
#pragma unroll 4
    for (int t = 0; t < SEQ; ++t) {
        const bf16* xr = xb + (size_t)t * 4096;
        const float dtv = dtp[(size_t)t * 32];
        const float xv = bf1(xr[pcol]);
        const v4u Bw = *(const v4u*)(xr + 2048 + g * 128 + ns * 8);
        const v4u Cw = *(const v4u*)(xr + 3072 + g * 128 + ns * 8);
        const float zv = bf1(zp[(size_t)t * INCP]);
        const float dA = __builtin_amdgcn_exp2f(dtv * A2), xdt = dtv * xv;
        float part = 0.f;
#pragma unroll
        for (int e = 0; e < 4; ++e) {
            st[2 * e] = dA * st[2 * e] + xdt * bflo(Bw[e]); part += bflo(Cw[e]) * st[2 * e];
            st[2 * e + 1] = dA * st[2 * e + 1] + xdt * bfhi(Bw[e]); part += bfhi(Cw[e]) * st[2 * e + 1]; }
        part += __shfl_xor(part, 1); part += __shfl_xor(part, 2); part += __shfl_xor(part, 4); part += __shfl_xor(part, 8);
        if (ns == 0) op[(size_t)t * 4096] = (bf16)f2bf((part + Dk * xv) * silu_f(zv));
    }
}
__device__ __forceinline__ int dst_row(int kind, int n) {
    if (kind == 1) return ((n >> 7) << 8) + (n & 127);
    if (kind == 2) return ((n >> 7) << 8) + 128 + (n & 127);
    if (kind == 3) { const int hh = n / QKD, j = n - hh * QKD; if (j < NOPE) return n; const int i = j - NOPE; return hh * QKD + NOPE + (i < 32 ? 2 * i : 2 * (i - 32) + 1); }
    if (kind == 4) { if (n < O_KPE || n >= O_KPE + ROPE) return n; const int i = n - O_KPE; return O_KPE + (i < 32 ? 2 * i : 2 * (i - 32) + 1); }
    return n;
}
__device__ __forceinline__ void p0_transpose_item(const float* W, int K, int N, bf16* WT, int kind, const float* gain, LAS float* scr, int item, int lane) {
    const bool f16w = false;
    const int nblk = N / 32, kb = item / nblk, nb = item - kb * nblk, k0 = 64 * kb, n0 = 32 * nb;
    float v[32];
    const float* wp = W + (size_t)(k0 + (lane >> 5)) * N + n0 + (lane & 31);
#pragma unroll
    for (int i = 0; i < 32; ++i) v[i] = wp[(size_t)(2 * i) * N];
    const int c = lane & 7;
    f32x4 g0 = (f32x4){1.f, 1.f, 1.f, 1.f}, g1 = g0;
    if (gain) { g0 = *(const f32x4*)(gain + k0 + 8 * c); g1 = *(const f32x4*)(gain + k0 + 8 * c + 4); }
#pragma unroll
    for (int i = 0; i < 32; ++i) scr[(2 * i + (lane >> 5)) * 33 + (lane & 31)] = v[i];
    LDS_WAIT(); asm volatile("" ::: "memory");
#pragma unroll
    for (int j = 0; j < 4; ++j) { const int n = (lane >> 3) + 8 * j; const LAS float* s = scr + (8 * c) * 33 + n;
        const float e0 = s[0 * 33] * g0[0], e1 = s[1 * 33] * g0[1], e2 = s[2 * 33] * g0[2], e3 = s[3 * 33] * g0[3], e4 = s[4 * 33] * g1[0], e5 = s[5 * 33] * g1[1], e6 = s[6 * 33] * g1[2], e7 = s[7 * 33] * g1[3];
        v4u o; if (f16w) { o.x = pkh2(e0, e1); o.y = pkh2(e2, e3); o.z = pkh2(e4, e5); o.w = pkh2(e6, e7); } else { o.x = pk2(e0, e1); o.y = pk2(e2, e3); o.z = pk2(e4, e5); o.w = pk2(e6, e7); }
        *(v4u*)(WT + (size_t)dst_row(kind, n0 + n) * K + k0 + 8 * c) = o; }
    LDS_WAIT(); asm volatile("" ::: "memory");
}
struct InPtrs { const float* p[24]; };
#ifndef DEFER_D2
#define DEFER_D2 1
#endif
constexpr int IT_FFN = (DM / 64) * (FF / 32);
constexpr int IT_IN = (DM / 64) * (INC / 32);
constexpr int IT_QU = (QL / 64) * (QW / 32);
constexpr int IT_KVU = (KVL / 64) * (KVW / 32);
constexpr int IT_O = (DM / 64) * (DM / 32);
constexpr int IT_LAYER = 6 * IT_FFN + IT_IN + IT_QU + IT_KVU + IT_O;
__device__ __forceinline__ void p0_prologue(Frame& F, const InPtrs& in, unsigned char* ws, int lane) {
    LAS float* scr = (LAS float*)(F.lds + RING_OFF + F.wave * 16384);
    const int gw = F.vcu * NWAVES + F.wave, NGW = F.G * NWAVES;
    for (int it = gw; it < DEPTH * IT_LAYER; it += NGW) {
        const int l = it / IT_LAYER; int r = it - l * IT_LAYER;
        unsigned char* wl = ws + WS_W + (size_t)l * W_LAYER;
        const size_t lFF = (size_t)l * DM * FF;
        if (r < IT_FFN) { p0_transpose_item(in.p[3] + lFF, DM, FF, (bf16*)(wl + W_GU1), 1, in.p[2] + (size_t)l * DM, scr, r, lane); continue; } r -= IT_FFN;
        if (r < IT_FFN) { p0_transpose_item(in.p[4] + lFF, DM, FF, (bf16*)(wl + W_GU1), 2, in.p[2] + (size_t)l * DM, scr, r, lane); continue; } r -= IT_FFN;
        if (r < IT_FFN) { p0_transpose_item(in.p[5] + lFF, FF, DM, (bf16*)(wl + W_D1), 0, nullptr, scr, r, lane); continue; } r -= IT_FFN;
        if (r < IT_IN) { p0_transpose_item(in.p[7] + (size_t)l * DM * INC, DM, INC, (bf16*)(wl + W_IN), 4, in.p[6] + (size_t)l * DM, scr, r, lane); continue; } r -= IT_IN;
        if (r < IT_QU) { p0_transpose_item(in.p[9] + (size_t)l * QL * QW, QL, QW, (bf16*)(wl + W_QU), 3, in.p[8] + (size_t)l * QL, scr, r, lane); continue; } r -= IT_QU;
        if (r < IT_KVU) { p0_transpose_item(in.p[11] + (size_t)l * KVL * KVW, KVL, KVW, (bf16*)(wl + W_KVU), 0, in.p[10] + (size_t)l * KVL, scr, r, lane); continue; } r -= IT_KVU;
        if (r < IT_O) { p0_transpose_item(in.p[18] + (size_t)l * DM * DM, DM, DM, (bf16*)(wl + W_O), 0, nullptr, scr, r, lane); continue; } r -= IT_O;
        if (r < IT_FFN) { if (!(l >= 1 && DEFER_D2 >= 2)) p0_transpose_item(in.p[20] + lFF, DM, FF, (bf16*)(wl + W_GU2), 1, in.p[19] + (size_t)l * DM, scr, r, lane); continue; } r -= IT_FFN;
        if (r < IT_FFN) { p0_transpose_item(in.p[21] + lFF, DM, FF, (bf16*)(wl + W_GU2), 2, in.p[19] + (size_t)l * DM, scr, r, lane); continue; } r -= IT_FFN;
        if (l >= 1 && DEFER_D2) continue;
        p0_transpose_item(in.p[22] + lFF, FF, DM, (bf16*)(wl + W_D2), 0, nullptr, scr, r, lane);
    }
    const int gt = gw * 64 + lane, NGT = NGW * 64;
    for (int i = gt; i < DEPTH * 16384; i += NGT) { const int l = i >> 14, j = i & 16383;
        *(v4u*)(ws + WS_W + (size_t)l * W_LAYER + W_IN + (size_t)INC * DM * 2 + (size_t)j * 16) = (v4u){0u, 0u, 0u, 0u}; }
    const int* pos = (const int*)in.p[1]; float* cosT = (float*)(ws + WS_COS); float* sinT = (float*)(ws + WS_SIN);
    float invf;
    {   const double y = -(double)(lane & 31) * 0.28782313662425575;
        const double kd = __builtin_rint(y * 1.4426950408889634);
        double r = __builtin_fma(-kd, 0.6931471803691238, y); r = __builtin_fma(-kd, 1.9082149292705877e-10, r);
        double e = 1.0;
#pragma unroll
        for (int k = 18; k >= 1; --k) e = 1.0 + e * r * (1.0 / (double)k);
        invf = (float)__builtin_ldexp(e, (int)kd); }
    for (int i = gt; i < M * 32; i += NGT) { const int m = i >> 5;
        const float ang = (float)pos[m] * invf;
        const double x = (double)ang, n = __builtin_rint(x * 0.15915494309189535);
        double r = __builtin_fma(-n, 6.283185307179586, x); r = __builtin_fma(-n, 2.4492935982947064e-16, r);
        const double r2 = r * r; double sn = 1.0, cs = 1.0;
#pragma unroll
        for (int k = 14; k >= 1; --k) { sn = 1.0 - sn * r2 * (1.0 / (double)((2 * k) * (2 * k + 1))); cs = 1.0 - cs * r2 * (1.0 / (double)((2 * k - 1) * (2 * k))); }
        cosT[i] = (float)cs; sinT[i] = (float)(sn * r); }
    for (int m = gw; m < M; m += NGW) row_copy_ss(in.p[0] + (size_t)m * DM, (bf16*)(ws + WS_XN) + (size_t)m * DM, (unsigned long long*)(ws + WS_SS) + m, lane);
}
#ifndef REP_GEMM
#define REP_GEMM 1
#endif
#ifndef REP_RES
#define REP_RES 1
#endif
#ifndef REP_BAR
#define REP_BAR 0
#endif
#ifndef REP_ATT
#define REP_ATT 1
#endif
#ifndef REP_SSD
#define REP_SSD 1
#endif
#ifndef REP_THIN
#define REP_THIN 1
#endif
#ifndef DBG_EN
#define DBG_EN 0xffff
#endif
constexpr int PH_PER_LAYER = 9, N_PHASES = 1 + PH_PER_LAYER * DEPTH + 1;
struct Args { const float* in[24]; float* out; unsigned char* ws; int ph_lo, ph_hi; };
static_assert(sizeof(Args) == 24 * 8 + 16 + 8, "Args has no holes");

__global__ void __launch_bounds__(NTHREADS, 2) trunk_fwd(Args args) {
    extern __shared__ __attribute__((aligned(16))) unsigned char lds[];
    Frame F;
    F.lds = (LAS unsigned char*)lds;
    F.MISC = (volatile LAS unsigned*)(F.lds + MISC_OFF);
    F.wave = __builtin_amdgcn_readfirstlane(threadIdx.x >> 6);
    F.G = gridDim.x; { const int bx = blockIdx.x; F.vcu = (F.G % 8 == 0) ? (bx % 8) * (F.G / 8) + bx / 8 : bx; }
    unsigned char* ws = args.ws;
    F.ctl = (gu32*)(ws + WS_CTL);
    for (int u = threadIdx.x; u < (LDS_BYTES - LDSCTL_OFF) / 4; u += NTHREADS) ((LAS unsigned*)(F.lds + LDSCTL_OFF))[u] = 0u;
    __syncthreads();
    XcdBarrier bar; bar.bar = (unsigned*)(F.ctl + CW_BAR); bar.x = 0; bar.st = nullptr;
    if (MK_ONE_LAUNCH) bar = xcd_barrier_post((unsigned*)(F.ctl + CW_BAR), F.MISC + 8);
#define GRID_BAR() do { if (MK_ONE_LAUNCH) xcd_barrier(bar); } while (0)
    const int lo = args.ph_lo, hi = args.ph_hi;
#define IN(k) (lo <= (k) && (k) < hi)
#ifndef XBAR
#define XBAR 0
#endif
#define SEAM(k) do { if (IN((k) + 1)) { GRID_BAR(); for (int xb_ = 0; xb_ < XBAR; ++xb_) GRID_BAR(); } } while (0)
#define ROWFAC(ssp_, invn_) ({ LAS float* tab_ = (LAS float*)(F.lds + RSTAB_OFF); const int rb_ = 2048 * ((int)blockIdx.x & 7); int t0_ = threadIdx.x; asm volatile("" : "+v"(t0_)); __syncthreads(); \
        for (int r_ = t0_; r_ < 2048; r_ += NTHREADS) tab_[r_] = pg8::row_rstd((ssp_), rb_ + r_, (invn_)); \
        __syncthreads(); pg8::RowFac rf_; rf_.tab = tab_ - rb_; rf_; })
#define LANE_L() ({ int l_ = threadIdx.x; asm volatile("" : "+v"(l_)); l_ & 63; })
#define PH_VARS() const int ln = LANE_L(); int gw_ = F.vcu * NWAVES + F.wave; asm volatile("" : "+s"(gw_)); const int gw = gw_, NGW = F.G * NWAVES; (void)ln; (void)gw; (void)NGW

    bf16* XB = (bf16*)(ws + WS_XN); bf16* HB = (bf16*)(ws + WS_BIG); bf16* PROJ = (bf16*)(ws + WS_BIG);
    bf16* KPE = (bf16*)(ws + WS_KPE); float* DT = (float*)(ws + WS_DT); unsigned long long* SSQ = (unsigned long long*)(ws + WS_SSQ); unsigned long long* SS = (unsigned long long*)(ws + WS_SS);
    bf16* XBC = (bf16*)(ws + WS_XBC); bf16* QB = (bf16*)(ws + WS_Q); bf16* KVB = (bf16*)(ws + WS_KV); bf16* MIX = (bf16*)(ws + WS_MIX);
    const float* cosT = (const float*)(ws + WS_COS); const float* sinT = (const float*)(ws + WS_SIN);

    if ((DBG_EN & 1) && IN(0)) { PH_VARS(); InPtrs ip;
#pragma unroll
        for (int i = 0; i < 24; ++i) ip.p[i] = args.in[i];
        for (int rep = 0; rep < REP_THIN; ++rep) p0_prologue(F, ip, ws, ln); SEAM(0); }

    for (int l = 0; l < DEPTH; ++l) {
        const int pb = 1 + PH_PER_LAYER * l;
        unsigned char* wl = ws + WS_W + (size_t)l * W_LAYER;
        for (int f = 0; f < 2; ++f) {
            if (f == 1) {
                if ((DBG_EN & 4) && IN(pb + 2)) { PH_VARS(); pg8::Gemm g{XB, (const bf16*)(wl + W_IN), M, INCP, DM, DM, DM}; pg8::StaticOrder S; S.init(M, INCP, F.G, (int)blockIdx.x);
                    pg8::EpiStore E{PROJ, INCP, ROWFAC(SS + (size_t)(3 * l + 1) * M, 1.0f / DM)};
                    for (int rep = 0; rep < REP_GEMM; ++rep) { if (REP_BAR && rep) GRID_BAR(); pg8::gemm_phase<pg8::EpiStore, pg8::StaticOrder, PG8_ALIGN, PG8_SP2>(F.lds + RING_OFF, g, S, E); }
                    if (DEFER_D2 && l + 1 < DEPTH && F.G == 256 && blockIdx.x >= 128) {
                        LAS float* scr = (LAS float*)(F.lds + RING_OFF + F.wave * 16384);
                        bf16* wt = (bf16*)(ws + WS_W + (size_t)(l + 1) * W_LAYER + W_D2); const float* wsrc = args.in[22] + (size_t)(l + 1) * DM * FF;
                        for (int it = ((int)blockIdx.x - 128) * NWAVES + F.wave; it < IT_FFN; it += 128 * NWAVES) p0_transpose_item(wsrc, FF, DM, wt, 0, nullptr, scr, it, ln);
                        if (DEFER_D2 >= 2) { bf16* wg = (bf16*)(ws + WS_W + (size_t)(l + 1) * W_LAYER + W_GU2); const float* gsrc = args.in[20] + (size_t)(l + 1) * DM * FF; const float* gg = args.in[19] + (size_t)(l + 1) * DM;
                            for (int it = ((int)blockIdx.x - 128) * NWAVES + F.wave; it < IT_FFN; it += 128 * NWAVES) p0_transpose_item(gsrc, DM, FF, wg, 1, gg, scr, it, ln); }
                    } else if (DEFER_D2 && l + 1 < DEPTH && F.G != 256) {
                        LAS float* scr = (LAS float*)(F.lds + RING_OFF + F.wave * 16384);
                        bf16* wt = (bf16*)(ws + WS_W + (size_t)(l + 1) * W_LAYER + W_D2); const float* wsrc = args.in[22] + (size_t)(l + 1) * DM * FF;
                        for (int it = gw; it < IT_FFN; it += NGW) p0_transpose_item(wsrc, FF, DM, wt, 0, nullptr, scr, it, ln);
                        if (DEFER_D2 >= 2) { bf16* wg = (bf16*)(ws + WS_W + (size_t)(l + 1) * W_LAYER + W_GU2); const float* gsrc = args.in[20] + (size_t)(l + 1) * DM * FF; const float* gg = args.in[19] + (size_t)(l + 1) * DM;
                            for (int it = gw; it < IT_FFN; it += NGW) p0_transpose_item(gsrc, DM, FF, wg, 1, gg, scr, it, ln); }
                    }
                    SEAM(pb + 2); }
                if ((DBG_EN & 8) && IN(pb + 3)) { PH_VARS();
                    for (int rep = 0; rep < REP_THIN; ++rep) for (int m = 4 * gw; m < M; m += 4 * NGW) prep_rows4(m, PROJ, cosT, sinT, args.in[14] + (size_t)l * SSD_H, SSQ, KPE, DT, ln);
                    for (int rep = 0; rep < REP_THIN; ++rep) for (int it = gw; it < (M / 32) * 8; it += NGW) conv_item(it, PROJ, args.in[12] + (size_t)l * 4 * CONVD, args.in[13] + (size_t)l * CONVD, XBC, ln);
                    SEAM(pb + 3); }
                if ((DBG_EN & 16) && IN(pb + 4)) { PH_VARS();
                    for (int rep = 0; rep < REP_SSD; ++rep) for (int u = F.vcu; u < BATCH * SSD_H * 2; u += F.G) ssd::ssd_unit(u, XBC, DT, PROJ, args.in[15] + (size_t)l * SSD_H, args.in[16] + (size_t)l * SSD_H, MIX, F.lds + RING_OFF);
                    for (int s2 = 0; s2 < 2; ++s2) {
                        const int kk = s2 ? KVL : QL, nn = s2 ? KVW : QW;
                        pg8::Gemm g{PROJ + (s2 ? O_CKV : O_CQ), (const bf16*)(wl + (s2 ? W_KVU : W_QU)), M, nn, kk, INCP, kk}; pg8::StaticOrder S; S.init(M, nn, F.G, (int)blockIdx.x);
                        pg8::EpiStore E{s2 ? KVB : QB, nn, ROWFAC(SSQ + (size_t)s2 * M, 1.0f / (float)kk)};
                        for (int rep = 0; rep < REP_GEMM; ++rep) { if (REP_BAR && rep) GRID_BAR(); pg8::gemm_phase<pg8::EpiStore, pg8::StaticOrder, PG8_ALIGN, PG8_SP2>(F.lds + RING_OFF, g, S, E); } }
                    SEAM(pb + 4); }
                if ((DBG_EN & 32) && IN(pb + 5)) { PH_VARS();
                    for (int rep = 0; rep < REP_ATT; ++rep) for (int u = F.vcu; u < BATCH * NH * 8; u += F.G) { const int bh = u >> 3, xq = u & 7;
                        att::attn_block(bh >> 4, bh & 15, xq, QB, KVB, KPE, cosT, sinT, MIX, F.lds + RING_OFF);
                        att::attn_block(bh >> 4, bh & 15, 15 - xq, QB, KVB, KPE, cosT, sinT, MIX, F.lds + RING_OFF); }
                    { const float* g = args.in[17] + (size_t)l * SSD_W;
                      for (int m = 4 * gw; m < M; m += 4 * NGW) gnorm_rows<4>(MIX + (size_t)m * 4096 + 2048, 4096, g, ln); }
                    SEAM(pb + 5); }
                if ((DBG_EN & 128) && IN(pb + 6)) { PH_VARS(); pg8::Gemm g{MIX, (const bf16*)(wl + W_O), M, DM, DM, DM, DM}; pg8::StaticOrder S; S.init(M, DM, F.G, (int)blockIdx.x);
                    for (int rep = 0; rep < REP_RES; ++rep) { pg8::EpiResid E{XB, rep ? (unsigned long long*)(ws + WS_SSP) : SS + (size_t)(3 * l + 2) * M, DM, rep == 0 ? 1.0f : 0.0f};
                    pg8::gemm_phase<pg8::EpiResid, pg8::StaticOrder, PG8_ALIGN, PG8_SP2>(F.lds + RING_OFF, g, S, E); }
                    SEAM(pb + 6); }
            }
            const int fb = pb + 7 * f;
            if ((DBG_EN & 512) && IN(fb)) { PH_VARS(); pg8::Gemm g{XB, (const bf16*)(wl + (f ? W_GU2 : W_GU1)), M, 2 * FF, DM, DM, DM}; pg8::StaticOrder S; S.init(M, 2 * FF, F.G, (int)blockIdx.x);
                pg8::EpiSwiGLU E{HB, FF, ROWFAC(SS + (size_t)(3 * l + 2 * f) * M, 1.0f / DM)};
                for (int rep = 0; rep < REP_GEMM; ++rep) { if (REP_BAR && rep) GRID_BAR(); pg8::gemm_phase<pg8::EpiSwiGLU, pg8::StaticOrder, PG8_ALIGN, PG8_SP2>(F.lds + RING_OFF, g, S, E); }
                SEAM(fb); }
            if ((DBG_EN & 1024) && IN(fb + 1)) { PH_VARS(); pg8::Gemm g{HB, (const bf16*)(wl + (f ? W_D2 : W_D1)), M, DM, FF, FF, FF}; pg8::StaticOrder S; S.init(M, DM, F.G, (int)blockIdx.x);
                for (int rep = 0; rep < REP_RES; ++rep) { pg8::EpiResid E{XB, rep ? (unsigned long long*)(ws + WS_SSP) : SS + (size_t)(3 * l + 2 * f + 1) * M, DM, rep == 0 ? 0.5f : 0.0f};
                pg8::gemm_phase<pg8::EpiResid, pg8::StaticOrder, PG8_ALIGN, PG8_SP2>(F.lds + RING_OFF, g, S, E); }
                SEAM(fb + 1); }
        }
    }
    if ((DBG_EN & 2048) && IN(N_PHASES - 1)) { PH_VARS(); for (int m = gw; m < M; m += NGW) rms_row_out(XB + (size_t)m * DM, args.in[23], args.out + (size_t)m * DM, ln); }
#undef IN
#undef SEAM
#undef GRID_BAR
}

extern "C" void kernel_launch(void* const* d_in, const int* in_sizes, int n_in, void* d_out, int out_size, void* d_ws, size_t ws_size, hipStream_t stream) {
    static int grid = 0;
    if (grid == 0) {
        if (n_in != 24 || in_sizes[0] != M * DM || out_size != M * DM || ws_size < WS_END) {
            fprintf(stderr, "kernel_launch: built for 24 inputs, x/out of %d floats, >= %zu bytes of workspace; got n_in %d, in0 %d, out %d, ws %zu; nothing launched\n", M * DM, (size_t)WS_END, n_in, n_in > 0 ? in_sizes[0] : -1, out_size, ws_size);
            grid = -1; return; }
        int dev = 0, cus = 0, per_cu = 0;
        if (hipGetDevice(&dev) != hipSuccess || hipDeviceGetAttribute(&cus, hipDeviceAttributeMultiprocessorCount, dev) != hipSuccess) { fprintf(stderr, "kernel_launch: device query failed\n"); grid = -1; return; }
        if (hipFuncSetAttribute((const void*)trunk_fwd, hipFuncAttributeMaxDynamicSharedMemorySize, LDS_BYTES) != hipSuccess) { fprintf(stderr, "kernel_launch: hipFuncSetAttribute failed\n"); grid = -1; return; }
        if (hipOccupancyMaxActiveBlocksPerMultiprocessor(&per_cu, (const void*)trunk_fwd, NTHREADS, LDS_BYTES) != hipSuccess || per_cu < 1)
            fprintf(stderr, "kernel_launch: note: occupancy query reports %d workgroups per CU\n", per_cu);
        (void)hipGetLastError();
        if (cus != 256) { fprintf(stderr, "kernel_launch: built for a 256-CU device (the GEMM epilogues' row-factor tables assume the 256-workgroup unit deal); found %d CUs; nothing launched\n", cus); grid = -1; return; }
        grid = cus;
    }
    if (grid < 0) return;
    if (hipMemsetAsync((char*)d_ws + WS_CTL, 0, CTL_ZERO_BYTES, stream) != hipSuccess) { fprintf(stderr, "kernel_launch: memset failed\n"); return; }
    Args a{};
    for (int i = 0; i < 24; ++i) a.in[i] = (const float*)d_in[i];
    a.out = (float*)d_out; a.ws = (unsigned char*)d_ws;
#if MK_ONE_LAUNCH
    a.ph_lo = 0; a.ph_hi = N_PHASES;
    hipLaunchKernelGGL(trunk_fwd, dim3(grid), dim3(NTHREADS), LDS_BYTES, stream, a);
#else
    for (int p = 0; p < N_PHASES; ++p) { a.ph_lo = p; a.ph_hi = p + 1; hipLaunchKernelGGL(trunk_fwd, dim3(grid), dim3(NTHREADS), LDS_BYTES, stream, a); }
#endif
    const hipError_t le = hipPeekAtLastError();
    if (le != hipSuccess) fprintf(stderr, "kernel_launch: launch failed: %s\n", hipGetErrorName(le));
}
```

```cpp
#include <hip/hip_runtime.h>
#include <cstdio>
#include <cstdint>

#ifndef MK_ONE_LAUNCH
#define MK_ONE_LAUNCH 1
#endif

constexpr int BATCH = 4, SEQ = 4096, DM = 4096, DEPTH = 4, FF = 6144;
constexpr int M = BATCH * SEQ;
constexpr int NH = 16, QL = 896, KVL = 512, NOPE = 128, ROPE = 64, VH = 128, QKD = NOPE + ROPE;
constexpr int QW = NH * QKD;
constexpr int KVW = NH * (NOPE + VH);
constexpr int SSD_P = 64, SSD_H = 32, SSD_G = 8, SSD_N = 128, SSD_W = 2048, CONVD = 4096;
constexpr int INC = 7648, INCP = 7680;
constexpr int O_CQ = 0, O_CKV = 896, O_KPE = 1408, O_Z = 1472, O_XBC = 3520, O_DT = 7616;
constexpr float EPS = 1e-6f;
constexpr int NWAVES = 8, NTHREADS = NWAVES * 64;

constexpr size_t MiB = 1u << 20;
constexpr size_t WS_CTL = 0, CTL_ZERO_BYTES = 3 * MiB;
constexpr size_t WS_SS = 1 * MiB;
constexpr int N_SS = 3 * DEPTH + 1;
static_assert(WS_SS + (size_t)N_SS * M * 8 <= CTL_ZERO_BYTES, "ss arrays inside the memset region");
constexpr size_t WS_COS = 3 * MiB, WS_SIN = 5 * MiB;
constexpr size_t WS_SSQ = 7 * MiB;
constexpr size_t WS_X = 8 * MiB;
constexpr size_t WS_XN = 264 * MiB;
constexpr size_t WS_BIG = 392 * MiB;
constexpr size_t WS_SSP = 632 * MiB;
constexpr size_t WS_KPE = 676 * MiB;
constexpr size_t WS_DT = 678 * MiB;
constexpr size_t WS_XBC = 680 * MiB;
constexpr size_t WS_Q = 808 * MiB;
constexpr size_t WS_KV = 904 * MiB;
constexpr size_t WS_MIX = 1032 * MiB;
constexpr size_t WS_W = 1160 * MiB;
constexpr size_t W_GU1 = 0, W_D1 = 96 * MiB, W_IN = 144 * MiB, W_QU = 204 * MiB, W_KVU = 210 * MiB, W_O = 214 * MiB, W_GU2 = 246 * MiB, W_D2 = 342 * MiB, W_LAYER = 390 * MiB;
constexpr size_t WS_END = WS_W + DEPTH * W_LAYER;
static_assert(WS_BIG + (size_t)M * INCP * 2 <= WS_SSP && WS_SSP + (size_t)M * 64 * 4 <= WS_KPE && WS_XBC + (size_t)M * 4096 * 2 <= WS_Q && WS_Q + (size_t)M * QW * 2 <= WS_KV, "d_ws map");
constexpr int CW_TMO = 0, CW_CODE = 1, CW_BAR = 4096;

constexpr int RING_OFF = 0, RING_BYTES = 131072;
constexpr int LDSCTL_OFF = RING_BYTES, MISC_OFF = LDSCTL_OFF + 320, RSTAB_OFF = LDSCTL_OFF + 1024;
static_assert(RSTAB_OFF + 2048 * 4 <= 147456, "LDS map");
constexpr int LDS_BYTES = 147456;

#define GAS __attribute__((address_space(1)))
#define LAS __attribute__((address_space(3)))
typedef unsigned short bf16;
typedef unsigned v4u __attribute__((ext_vector_type(4)));
typedef unsigned v2u __attribute__((ext_vector_type(2)));
typedef float f32x4 __attribute__((ext_vector_type(4)));
typedef float f32x2 __attribute__((ext_vector_type(2)));
typedef float f32x16 __attribute__((ext_vector_type(16)));
typedef short bf16x8 __attribute__((ext_vector_type(8)));
typedef short s16x4 __attribute__((ext_vector_type(4)));
typedef GAS unsigned gu32;
#define RLX_AGENT __ATOMIC_RELAXED, __HIP_MEMORY_SCOPE_AGENT
#define LDS_WAIT() asm volatile("s_waitcnt lgkmcnt(0)" ::: "memory")
#define VM_WAIT() asm volatile("s_waitcnt vmcnt(0)" ::: "memory")
__device__ __forceinline__ unsigned f2bf(float f) { unsigned u = __builtin_bit_cast(unsigned, f); return (u + 0x7fffu + ((u >> 16) & 1u)) >> 16; }
__device__ __forceinline__ unsigned pk2(float lo, float hi) { return f2bf(lo) | (f2bf(hi) << 16); }
__device__ __forceinline__ float bflo(unsigned w) { return __builtin_bit_cast(float, w << 16); }
__device__ __forceinline__ float bfhi(unsigned w) { return __builtin_bit_cast(float, w & 0xffff0000u); }
__device__ __forceinline__ float bf1(bf16 b) { return __builtin_bit_cast(float, (unsigned)b << 16); }
typedef _Float16 h16x2 __attribute__((ext_vector_type(2)));
__device__ __forceinline__ unsigned pkh2(float lo, float hi) { f32x2 v = {lo, hi}; h16x2 h = __builtin_convertvector(v, h16x2); return __builtin_bit_cast(unsigned, h); }
__device__ __forceinline__ float hlo(unsigned w) { return (float)__builtin_bit_cast(h16x2, w)[0]; }
__device__ __forceinline__ float hhi(unsigned w) { return (float)__builtin_bit_cast(h16x2, w)[1]; }
__device__ __forceinline__ float wave_sum(float v) {
#pragma unroll
    for (int o = 1; o < 64; o <<= 1) v += __shfl_xor(v, o);
    return v;
}
__device__ __forceinline__ float fast_exp(float x) { return __builtin_amdgcn_exp2f(x * 1.4426950408889634f); }
__device__ __forceinline__ float silu_f(float x) { return x * __builtin_amdgcn_rcpf(1.0f + fast_exp(-x)); }
#define XB_TMO      128
#define XB_XCNT(j)  (256  + 64 * (j))
#define XB_XSUB(j)  (1280 + 64 * (j))
#define XB_XGEN(j)  (2304 + 64 * (j))
#define XB_TOP      3328
#define XB_TOPGEN   3392
#define XCD_BAR_WORDS 3456
#define XB_SPIN_CAP (1u << 18)

__device__ __forceinline__ unsigned xb_ld(unsigned* p)              { return __hip_atomic_load(p, __ATOMIC_RELAXED, __HIP_MEMORY_SCOPE_AGENT); }
__device__ __forceinline__ unsigned xb_add(unsigned* p, unsigned v) { return __hip_atomic_fetch_add(p, v, __ATOMIC_RELAXED, __HIP_MEMORY_SCOPE_AGENT); }
__device__ __forceinline__ unsigned xb_xcc_id() { return (unsigned)__builtin_amdgcn_s_getreg((3 << 11) | 20) & 0xFu; }
#define XB_SPIN(cond, bar) do { unsigned _sp = 0; while (cond) { __builtin_amdgcn_s_sleep(1); \
    if ((++_sp & 255u) == 0u) { if (xb_ld(&(bar)[XB_TMO])) break; if (_sp > XB_SPIN_CAP) { atomicAdd(&(bar)[XB_TMO], 1u); break; } } } } while (0)

struct XcdBarrier {
    unsigned* bar; unsigned x;
    volatile LAS unsigned* st;
};

__device__ __forceinline__ XcdBarrier xcd_barrier_post(unsigned* bar, volatile LAS unsigned* st) {
    XcdBarrier b; b.bar = bar; b.x = xb_xcc_id(); b.st = st;
    if (threadIdx.x == 0) (void)xb_add(&bar[XB_XCNT(b.x)], 1u);
    return b;
}
__device__ __forceinline__ void xcd_barrier_complete(unsigned* bar, unsigned x, unsigned& nloc, unsigned& nx) {
    const unsigned G = gridDim.x * gridDim.y * gridDim.z;
    unsigned sum, cnt, mine, sp = 0u;
    for (;;) {
        sum = 0u; cnt = 0u; mine = 0u;
#pragma unroll
        for (unsigned j = 0; j < 16; ++j) { const unsigned c = xb_ld(&bar[XB_XCNT(j)]); sum += c; cnt += (c > 0u) ? 1u : 0u; mine = (j == x) ? c : mine; }
        if (sum == G) break;
        __builtin_amdgcn_s_sleep(1);
        if ((++sp & 255u) == 0u) { if (xb_ld(&bar[XB_TMO])) break; if (sp > XB_SPIN_CAP) { atomicAdd(&bar[XB_TMO], 1u); break; } }
    }
    nloc = mine > 0u ? mine : 1u; nx = cnt > 0u ? cnt : 1u;
}

__device__ __forceinline__ void xcd_barrier(const XcdBarrier& b) {
    asm volatile("s_waitcnt vmcnt(0)" ::: "memory");
    __syncthreads();
    if (threadIdx.x == 0) {
        unsigned* bar = b.bar;
        __builtin_amdgcn_s_waitcnt(0);
        unsigned nloc = b.st[0], nx = b.st[1];
        if (nloc == 0u) { xcd_barrier_complete(bar, b.x, nloc, nx); b.st[0] = nloc; b.st[1] = nx; }
        const unsigned old = xb_add(&bar[XB_XSUB(b.x)], 1u);
        const unsigned gen = old / nloc;
        if (old + 1u == (gen + 1u) * nloc) {
            __builtin_amdgcn_fence(__ATOMIC_RELEASE, "agent");
            asm volatile("s_waitcnt vmcnt(0)" ::: "memory");
            const unsigned og = xb_add(&bar[XB_TOP], 1u);
            const unsigned tg = og / nx;
            if (og + 1u == (tg + 1u) * nx) xb_add(&bar[XB_TOPGEN], 1u);
            else XB_SPIN(xb_ld(&bar[XB_TOPGEN]) == tg, bar);
            __builtin_amdgcn_fence(__ATOMIC_ACQUIRE, "agent");
            xb_add(&bar[XB_XGEN(b.x)], 1u);
            asm volatile("s_waitcnt vmcnt(0)" ::: "memory");
        } else {
            XB_SPIN(xb_ld(&bar[XB_XGEN(b.x)]) == gen, bar);
            __builtin_amdgcn_fence(__ATOMIC_ACQUIRE, "agent");
            asm volatile("s_waitcnt vmcnt(0)" ::: "memory");
        }
    }
    __syncthreads();
}
namespace pg8 {
#define PG8_LAS __attribute__((address_space(3)))
typedef unsigned short bf16_t;
typedef short bf16x8 __attribute__((ext_vector_type(8)));
typedef float f32x4 __attribute__((ext_vector_type(4)));
typedef unsigned u32x4 __attribute__((ext_vector_type(4)));
typedef _Float16 h16x8 __attribute__((ext_vector_type(8)));
constexpr int BM = 256, BK = 64, HALF = 128, HTB = HALF * BK * 2  , STAGE_BYTES = 8 * HTB, NXCD = 8, WGM = 8;

__host__ __device__ __forceinline__ int lds_byte(int r, int c) { const int st = (r >> 4) * 2 + (c >> 5), rr = r & 15, cc = c & 31, ob = rr * 64 + cc * 2; return st * 1024 + (ob ^ (((ob >> 9) & 1) << 5)); }
__host__ __device__ __forceinline__ void stage_rc(int b, int& R, int& C) { const int st = b / 1024, sb = b % 1024, swz = sb ^ (((sb >> 9) & 1) << 5); R = (st >> 1) * 16 + swz / 64; C = (st & 1) * 32 + (swz % 64) / 2; }
__host__ __device__ __forceinline__ int perm32(int rho) { const int n = rho >> 4, i = rho & 15; return 8 * (i >> 2) + 4 * n + (i & 3); }

struct Unit { int pm, pn; };
struct Gemm { const bf16_t* A; const bf16_t* Bt; int M, N, K, lda, ldb; };

struct StaticOrder {
    int nM, nN, nwg, G, c;
    __host__ __device__ void init(int M, int N, int G_, int c_) { nM = M / BM; nN = N / BM; nwg = nM * nN; G = G_; c = c_; }
    __host__ __device__ bool next(int i, Unit& u) const {
        const long L = (long)i * G + c; if (L >= nwg) return false;
        int wgid = (int)L; { const int q = nwg / NXCD, r = nwg % NXCD, xcd = wgid % NXCD, off = wgid / NXCD; wgid = (xcd < r ? xcd * (q + 1) : r * (q + 1) + (xcd - r) * q) + off; }
        const int nig = WGM * nN, gid = wgid / nig, fm = gid * WGM, gsz = (nM - fm) < WGM ? (nM - fm) : WGM;
        u.pm = fm + ((wgid % nig) % gsz); u.pn = (wgid % nig) / gsz; return true;
    }
    __device__ __forceinline__ void a_ready(const Unit&) const {}
    __device__ __forceinline__ void done(const Unit&) const {}
};

__device__ __forceinline__ unsigned cvt_pk_bf16(float lo, float hi) { unsigned r; asm volatile("v_cvt_pk_bf16_f32 %0, %1, %2" : "=v"(r) : "v"(lo), "v"(hi)); return r; }

__device__ __forceinline__ float row_rstd(const unsigned long long* ss, int row, float inv_n) { return 1.0f / sqrtf((float)ss[row] * (inv_n * 9.5367431640625e-07f) + 1e-6f); }
struct RowFac { const PG8_LAS float* tab;
    __device__ __forceinline__ float get(int row) const { return tab[row]; } };
struct EpiStore {
    static constexpr bool PERM = true, AFTER_DRAIN = false;
    bf16_t* O; int ldc; RowFac rf;
    __device__ __forceinline__ void operator()(const f32x4 (&acc)[2][2][4][2], const Unit& u, int wr, int wc, int fr, int fq) const {
        const int row0 = u.pm * BM + wr * 64 + fr, col0 = u.pn * BM + wc * 32 + 8 * fq;
#pragma unroll
        for (int ai = 0; ai < 2; ++ai)
#pragma unroll
            for (int m = 0; m < 4; ++m) { const int row = row0 + ai * HALF + m * 16; bf16_t* rowp = O + (size_t)row * ldc + col0;
                const float rs = rf.get(row);
#pragma unroll
                for (int bj = 0; bj < 2; ++bj) { const f32x4 v0 = acc[ai][bj][m][0] * rs, v1 = acc[ai][bj][m][1] * rs;
                    u32x4 w; w.x = cvt_pk_bf16(v0[0], v0[1]); w.y = cvt_pk_bf16(v0[2], v0[3]); w.z = cvt_pk_bf16(v1[0], v1[1]); w.w = cvt_pk_bf16(v1[2], v1[3]);
                    *(u32x4*)(rowp + bj * HALF) = w; } }
    }
};
struct EpiSwiGLU {
    static constexpr bool PERM = true, AFTER_DRAIN = false;
    bf16_t* O; int ldc; RowFac rf;
    __device__ __forceinline__ void operator()(const f32x4 (&acc)[2][2][4][2], const Unit& u, int wr, int wc, int fr, int fq) const {
        const int row0 = u.pm * BM + wr * 64 + fr, col0 = u.pn * HALF + wc * 32 + 8 * fq;
#pragma unroll
        for (int ai = 0; ai < 2; ++ai)
#pragma unroll
            for (int m = 0; m < 4; ++m) { const int row = row0 + ai * HALF + m * 16; bf16_t* rowp = O + (size_t)row * ldc + col0;
                const float rs = rf.get(row), c1 = rs * -1.4426950408889634f, irs2 = __builtin_amdgcn_rcpf(rs * rs);
                float t[8], h[8];
#pragma unroll
                for (int n = 0; n < 2; ++n)
#pragma unroll
                    for (int i = 0; i < 4; ++i) { t[n * 4 + i] = __builtin_amdgcn_exp2f(acc[ai][0][m][n][i] * c1); h[n * 4 + i] = acc[ai][0][m][n][i] * acc[ai][1][m][n][i]; }
                __builtin_amdgcn_sched_barrier(0);
#pragma unroll
                for (int k = 0; k < 8; ++k) t[k] = __builtin_amdgcn_rcpf(__builtin_fmaf(t[k], irs2, irs2));
                __builtin_amdgcn_sched_barrier(0);
#pragma unroll
                for (int k = 0; k < 8; ++k) h[k] *= t[k];
                u32x4 w; w.x = cvt_pk_bf16(h[0], h[1]); w.y = cvt_pk_bf16(h[2], h[3]); w.z = cvt_pk_bf16(h[4], h[5]); w.w = cvt_pk_bf16(h[6], h[7]);
                *(u32x4*)rowp = w; }
    }
};
struct EpiResid {
    static constexpr bool PERM = true, AFTER_DRAIN = false;
    bf16_t* xb; unsigned long long* ssn; int ldc; float alpha;
    __device__ __forceinline__ void operator()(const f32x4 (&acc)[2][2][4][2], const Unit& u, int wr, int wc, int fr, int fq) const {
        const int row0 = u.pm * BM + wr * 64 + fr, col0 = u.pn * BM + wc * 32 + 8 * fq;
        u32x4 old[2][4][2];
#pragma unroll
        for (int ai = 0; ai < 2; ++ai)
#pragma unroll
            for (int m = 0; m < 4; ++m)
#pragma unroll
                for (int bj = 0; bj < 2; ++bj) old[ai][m][bj] = *(const u32x4*)(xb + (size_t)(row0 + ai * HALF + m * 16) * ldc + col0 + bj * HALF);
#pragma unroll
        for (int ai = 0; ai < 2; ++ai)
#pragma unroll
            for (int m = 0; m < 4; ++m) { const int row = row0 + ai * HALF + m * 16; bf16_t* rowp = xb + (size_t)row * ldc + col0; float sq = 0.f;
#pragma unroll
                for (int bj = 0; bj < 2; ++bj) { const u32x4 b = old[ai][m][bj];
                    float v[8];
#pragma unroll
                    for (int e = 0; e < 4; ++e) { v[2 * e] = __builtin_bit_cast(float, b[e] << 16) + acc[ai][bj][m][e >> 1][2 * (e & 1)] * alpha;
                                                  v[2 * e + 1] = __builtin_bit_cast(float, b[e] & 0xffff0000u) + acc[ai][bj][m][e >> 1][2 * (e & 1) + 1] * alpha; }
#pragma unroll
                    for (int e = 0; e < 8; ++e) sq += v[e] * v[e];
                    u32x4 w; w.x = cvt_pk_bf16(v[0], v[1]); w.y = cvt_pk_bf16(v[2], v[3]); w.z = cvt_pk_bf16(v[4], v[5]); w.w = cvt_pk_bf16(v[6], v[7]);
                    *(u32x4*)(rowp + bj * HALF) = w; }
                sq += __shfl_xor(sq, 16); sq += __shfl_xor(sq, 32);
                if (fq == 0) __hip_atomic_fetch_add(ssn + row, (unsigned long long)(sq * 1048576.0f + 0.5f), __ATOMIC_RELAXED, __HIP_MEMORY_SCOPE_AGENT); }
    }
};

template <class Epi, class Sched, bool ALIGN_EPI = false, bool SP2 = false, bool F16 = false>
__device__ __forceinline__ void gemm_phase(PG8_LAS unsigned char* lds, const Gemm g, const Sched& S, const Epi& E) {
    __builtin_amdgcn_s_waitcnt(0);
    int tid_l = threadIdx.x; asm volatile("" : "+v"(tid_l));
    const int tid = tid_l, wid = __builtin_amdgcn_readfirstlane(tid >> 6), lane = tid & 63, wr = wid >> 2, wc = wid & 3, fr = lane & 15, fq = lane >> 4;
    const int K = g.K, nt = K / BK, lda = g.lda, ldb = g.ldb;
    unsigned voffA[2], voffB[2];
#pragma unroll
    for (int i = 0; i < 2; ++i) { int R, C; stage_rc(tid * 16 + i * 8192, R, C); const int Rb = Epi::PERM ? ((R & ~31) + perm32(R & 31)) : R;
        voffA[i] = (unsigned)(R * lda + C) * 2u; voffB[i] = (unsigned)(Rb * ldb + C) * 2u; }
    const size_t kstep = (size_t)(BK * 2);
    const size_t hstepA = (size_t)HALF * lda * 2, hstepB = (size_t)HALF * ldb * 2;
    const size_t tstepA = 2 * hstepA, tstepB = 2 * hstepB;
    const unsigned ldsw = (unsigned)wid * 1024u;
    const int aoff = lds_byte(wr * 64 + fr, fq * 8), boff = lds_byte(wc * 32 + fr, fq * 8);
#define PG8_SA(b, h) (((b) * 2 + (h)) * HTB)
#define PG8_SB(b, h) ((4 + (b) * 2 + (h)) * HTB)
#define PG8_STAGE(bufoff, gbase, voff) do { _Pragma("unroll") for (int _i = 0; _i < 2; ++_i) \
        __builtin_amdgcn_global_load_lds((const unsigned*)((const char*)(gbase) + (voff)[_i]), (PG8_LAS unsigned*)(lds + (bufoff) + ldsw + _i * 8192), 16, 0, 0); } while (0)
#define PG8_LDA(dst, b, h) do { _Pragma("unroll") for (int m = 0; m < 4; ++m) _Pragma("unroll") for (int k = 0; k < 2; ++k) dst[m][k] = *(const PG8_LAS bf16x8*)(lds + PG8_SA(b, h) + aoff + m * 2048 + k * 1024); } while (0)
#define PG8_LDB(dst, b, h) do { _Pragma("unroll") for (int n = 0; n < 2; ++n) _Pragma("unroll") for (int k = 0; k < 2; ++k) dst[n][k] = *(const PG8_LAS bf16x8*)(lds + PG8_SB(b, h) + boff + n * 2048 + k * 1024); } while (0)
#define PG8_MMA(ai, bj, At, Bt) do { __builtin_amdgcn_s_setprio(1); _Pragma("unroll") for (int m = 0; m < 4; ++m) _Pragma("unroll") for (int n = 0; n < 2; ++n) _Pragma("unroll") for (int k = 0; k < 2; ++k) \
        acc[ai][bj][m][n] = F16 ? __builtin_amdgcn_mfma_f32_16x16x32_f16(__builtin_bit_cast(h16x8, Bt[n][k]), __builtin_bit_cast(h16x8, At[m][k]), acc[ai][bj][m][n], 0, 0, 0) \
                                : __builtin_amdgcn_mfma_f32_16x16x32_bf16(Bt[n][k], At[m][k], acc[ai][bj][m][n], 0, 0, 0); __builtin_amdgcn_s_setprio(0); } while (0)
#define PG8_WAIT_V(n) asm volatile("s_waitcnt vmcnt(" #n ")" ::: "memory")
#define PG8_WAIT_L(n) asm volatile("s_waitcnt lgkmcnt(" #n ")" ::: "memory")
#define PG8_BAR __builtin_amdgcn_s_barrier()
#define PG8_SCHED __builtin_amdgcn_sched_barrier(0)
    Unit cur, nxt; int ui = 0;
    if (!S.next(0, cur)) return;
    f32x4 acc[2][2][4][2];
#pragma unroll
    for (int a = 0; a < 2; ++a)
#pragma unroll
        for (int b = 0; b < 2; ++b)
#pragma unroll
            for (int m = 0; m < 4; ++m)
#pragma unroll
                for (int n = 0; n < 2; ++n) acc[a][b][m][n] = (f32x4){0.f, 0.f, 0.f, 0.f};
    bf16x8 At[4][2], B0[2][2], B1[2][2];
    const char* cA = (const char*)g.A + (size_t)cur.pm * tstepA; const char* cB = (const char*)g.Bt + (size_t)cur.pn * tstepB;
    S.a_ready(cur);
    if constexpr (SP2) {
        PG8_STAGE(PG8_SB(0, 0), cB, voffB); PG8_STAGE(PG8_SB(0, 1), cB + hstepB, voffB); PG8_STAGE(PG8_SA(0, 0), cA, voffA); PG8_STAGE(PG8_SA(0, 1), cA + hstepA, voffA);
        if (wr == 1) PG8_BAR;
        PG8_WAIT_V(2); PG8_BAR;
        PG8_STAGE(PG8_SB(1, 0), cB + kstep, voffB); PG8_STAGE(PG8_SA(1, 0), cA + kstep, voffA); PG8_STAGE(PG8_SB(1, 1), cB + hstepB + kstep, voffB);
        PG8_WAIT_V(6); PG8_BAR;
    } else {
        PG8_STAGE(PG8_SB(0, 0), cB, voffB); PG8_STAGE(PG8_SA(0, 0), cA, voffA); PG8_STAGE(PG8_SB(0, 1), cB + hstepB, voffB); PG8_STAGE(PG8_SA(0, 1), cA + hstepA, voffA);
        if (wr == 1) PG8_BAR;
        PG8_WAIT_V(4); PG8_BAR;
        PG8_STAGE(PG8_SB(1, 0), cB + kstep, voffB); PG8_STAGE(PG8_SA(1, 0), cA + kstep, voffA); PG8_STAGE(PG8_SB(1, 1), cB + hstepB + kstep, voffB);
        PG8_WAIT_V(6); PG8_BAR;
    }
    for (;;) {
        const bool has_next = S.next(ui + 1, nxt);
        const char* nA = has_next ? (const char*)g.A + (size_t)nxt.pm * tstepA : cA; const char* nB = has_next ? (const char*)g.Bt + (size_t)nxt.pn * tstepB : cB;
        for (int t = 0; t < nt; t += 2) {
            const bool last = (t == nt - 2);
            const char* a1 = cA + (size_t)(t + 1) * kstep;
            const char* a2 = last ? nA : cA + (size_t)(t + 2) * kstep; const char* b2 = last ? nB : cB + (size_t)(t + 2) * kstep;
            const char* a3 = a2 + kstep; const char* b3 = b2 + kstep;
            if (last && has_next) S.a_ready(nxt);
            if constexpr (SP2) {
            PG8_LDB(B0, 0, 0); PG8_LDB(B1, 0, 1); PG8_SCHED; PG8_LDA(At, 0, 0); PG8_STAGE(PG8_SA(1, 1), a1 + hstepA, voffA);
            PG8_WAIT_V(8); PG8_WAIT_L(0); PG8_BAR; PG8_MMA(0, 0, At, B0); PG8_MMA(0, 1, At, B1); PG8_BAR; PG8_SCHED;
            PG8_LDA(At, 0, 1); PG8_STAGE(PG8_SB(0, 0), b2, voffB); PG8_STAGE(PG8_SB(0, 1), b2 + hstepB, voffB); PG8_STAGE(PG8_SA(0, 0), a2, voffA);
            PG8_WAIT_V(8); PG8_WAIT_L(0); PG8_BAR; PG8_MMA(1, 0, At, B0); PG8_MMA(1, 1, At, B1); PG8_BAR; PG8_SCHED;
            PG8_LDB(B0, 1, 0); PG8_LDB(B1, 1, 1); PG8_SCHED; PG8_LDA(At, 1, 0); PG8_STAGE(PG8_SA(0, 1), a2 + hstepA, voffA);
            PG8_WAIT_V(8); PG8_WAIT_L(0); PG8_BAR; PG8_MMA(0, 0, At, B0); PG8_MMA(0, 1, At, B1); PG8_BAR; PG8_SCHED;
            PG8_LDA(At, 1, 1); PG8_STAGE(PG8_SB(1, 0), b3, voffB); PG8_STAGE(PG8_SB(1, 1), b3 + hstepB, voffB); PG8_STAGE(PG8_SA(1, 0), a3, voffA);
            PG8_WAIT_V(8); PG8_WAIT_L(0); PG8_BAR; PG8_MMA(1, 0, At, B0); PG8_MMA(1, 1, At, B1); PG8_BAR; PG8_SCHED;
            } else {
            PG8_LDB(B0, 0, 0); PG8_SCHED; PG8_LDA(At, 0, 0); PG8_STAGE(PG8_SA(1, 1), a1 + hstepA, voffA);
            PG8_WAIT_L(8); PG8_BAR; PG8_WAIT_L(0); PG8_MMA(0, 0, At, B0); PG8_BAR; PG8_SCHED;
            PG8_LDB(B1, 0, 1); PG8_STAGE(PG8_SB(0, 0), b2, voffB);
            PG8_BAR; PG8_WAIT_L(0); PG8_MMA(0, 1, At, B1); PG8_BAR;
            PG8_LDA(At, 0, 1); PG8_STAGE(PG8_SA(0, 0), a2, voffA);
            PG8_BAR; PG8_WAIT_L(0); PG8_MMA(1, 0, At, B0); PG8_BAR; PG8_SCHED;
            PG8_STAGE(PG8_SB(0, 1), b2 + hstepB, voffB);
            PG8_WAIT_V(6); PG8_BAR; PG8_MMA(1, 1, At, B1); PG8_BAR;
            PG8_LDB(B0, 1, 0); PG8_SCHED; PG8_LDA(At, 1, 0); PG8_STAGE(PG8_SA(0, 1), a2 + hstepA, voffA);
            PG8_WAIT_L(8); PG8_BAR; PG8_WAIT_L(0); PG8_MMA(0, 0, At, B0); PG8_BAR; PG8_SCHED;
            PG8_LDB(B1, 1, 1); PG8_STAGE(PG8_SB(1, 0), b3, voffB);
            PG8_BAR; PG8_WAIT_L(0); PG8_MMA(0, 1, At, B1); PG8_BAR;
            PG8_LDA(At, 1, 1); PG8_STAGE(PG8_SA(1, 0), a3, voffA);
            PG8_BAR; PG8_WAIT_L(0); PG8_MMA(1, 0, At, B0); PG8_BAR; PG8_SCHED;
            PG8_STAGE(PG8_SB(1, 1), b3 + hstepB, voffB);
            PG8_WAIT_V(6); PG8_BAR; PG8_MMA(1, 1, At, B1); PG8_BAR;
            }
        }
        if constexpr (ALIGN_EPI) { if (wr == 0) PG8_BAR; }
        if constexpr (!Epi::AFTER_DRAIN) { E(acc, cur, wr, wc, fr, fq); S.done(cur); }
        if (!has_next) break;
#pragma unroll
        for (int a = 0; a < 2; ++a)
#pragma unroll
            for (int b = 0; b < 2; ++b)
#pragma unroll
                for (int m = 0; m < 4; ++m)
#pragma unroll
                    for (int n = 0; n < 2; ++n) acc[a][b][m][n] = (f32x4){0.f, 0.f, 0.f, 0.f};
        cur = nxt; cA = nA; cB = nB; ++ui;
        if constexpr (ALIGN_EPI) { if (wr == 1) PG8_BAR; }
    }
    PG8_WAIT_V(0);
    if constexpr (!ALIGN_EPI) { if (wr == 0) PG8_BAR; }
    PG8_BAR;
    if constexpr (Epi::AFTER_DRAIN) { E.fused(acc, cur, wr, wc, fr, fq, lds, wid, lane); S.done(cur); }
#undef PG8_SA
#undef PG8_SB
#undef PG8_STAGE
#undef PG8_LDA
#undef PG8_LDB
#undef PG8_MMA
#undef PG8_WAIT_V
#undef PG8_WAIT_L
#undef PG8_BAR
#undef PG8_SCHED
}
}
#ifndef PG8_SP2
#define PG8_SP2 true
#endif
#ifndef PG8_ALIGN
#define PG8_ALIGN true
#endif
namespace att {
constexpr int KSTR = 400, VSTR = 320;
constexpr int KBUF = 64 * KSTR, VBUF = 64 * VSTR;
constexpr int OFF_K = 0, OFF_V = 2 * KBUF, OFF_WS = OFF_V + 2 * VBUF, LDS_NEED = OFF_WS + NWAVES * 256;
constexpr float C2 = 0.07216878364870322f * 1.4426950408889634f;
static_assert(LDS_NEED <= RING_BYTES, "attention LDS");
typedef float f32x2_t __attribute__((ext_vector_type(2))); typedef __bf16 bf16x2_t __attribute__((ext_vector_type(2)));
typedef short v4i16_t __attribute__((ext_vector_type(4)));
__device__ __forceinline__ unsigned cvtpk(float lo, float hi) { f32x2_t v = {lo, hi}; bf16x2_t b = __builtin_convertvector(v, bf16x2_t); return __builtin_bit_cast(unsigned, b); }
__device__ __forceinline__ s16x4 trd(const LAS unsigned char* p) { return __builtin_bit_cast(s16x4, __builtin_amdgcn_ds_read_tr16_b64_v4i16((LAS v4i16_t*)p)); }
__device__ __forceinline__ int crow(int r, int hi) { return (r & 3) + 8 * (r >> 2) + 4 * hi; }
#define ATT_MFMA(a, b, c) __builtin_amdgcn_mfma_f32_32x32x16_bf16((a), (b), (c), 0, 0, 0)

__device__ __forceinline__ void attn_block(int b, int h, int qb, const bf16* __restrict__ Q, const bf16* __restrict__ KV, const bf16* __restrict__ KPE, const float* __restrict__ cosT, const float* __restrict__ sinT, bf16* __restrict__ MIXo, LAS unsigned char* lds) {
    int tid_l = threadIdx.x; asm volatile("" : "+v"(tid_l));
    const int tid = tid_l, lane = tid & 63, c = lane & 31, hi = lane >> 5;
    const int wid = __builtin_amdgcn_readfirstlane(tid >> 6);
    const size_t rowbase = (size_t)b * SEQ; const int q0 = qb * 256, qlo = q0 + wid * 32;
    const int NT = 4 * qb + 4;
    const bf16* qrow = Q + (rowbase + qlo + c) * QW + h * QKD + 8 * hi;
    bf16x8 qr[12];
#pragma unroll
    for (int d = 0; d < 12; ++d) qr[d] = *(const bf16x8*)(qrow + 16 * d);
    {
        const float* ct = cosT + (rowbase + qlo + c) * 32 + 4 * hi; const float* st = sinT + (rowbase + qlo + c) * 32 + 4 * hi;
#pragma unroll
        for (int dd = 0; dd < 4; ++dd) { const f32x4 cs = *(const f32x4*)(ct + 8 * dd), sn = *(const f32x4*)(st + 8 * dd);
            v4u w = __builtin_bit_cast(v4u, qr[8 + dd]);
#pragma unroll
            for (int e = 0; e < 4; ++e) { const float x1 = bflo(w[e]), x2 = bfhi(w[e]); w[e] = cvtpk(x1 * cs[e] - x2 * sn[e], x2 * cs[e] + x1 * sn[e]); }
            qr[8 + dd] = __builtin_bit_cast(bf16x8, w); }
    }
    const int kkey = tid >> 4, kch = tid & 15, pkey = tid >> 3, pch = tid & 7;
    const bf16* gk = KV + (rowbase + kkey) * KVW + h * 256 + kch * 8;
    const bf16* gv = gk + 128;
    const bf16* gp = KPE + (rowbase + pkey) * 64 + pch * 8;
    const int lk0 = kkey * KSTR + kch * 16, lk1 = lk0 + 32 * KSTR, lp = pkey * KSTR + 256 + pch * 16;
    const int lv0 = kkey * VSTR + kch * 16, lv1 = lv0 + 32 * VSTR;
    v4u sk0, sk1, sp, sv0, sv1;
#define ATT_LOAD(t) do { const size_t o_ = (size_t)(t) * 64 * KVW; sk0 = *(const v4u*)(gk + o_); sk1 = *(const v4u*)(gk + o_ + 32 * KVW); \
        sv0 = *(const v4u*)(gv + o_); sv1 = *(const v4u*)(gv + o_ + 32 * KVW); sp = *(const v4u*)(gp + (size_t)(t) * 64 * 64); } while (0)
#define ATT_WRITE(bi) do { LAS unsigned char* kb_ = lds + OFF_K + (bi) * KBUF; LAS unsigned char* vb_ = lds + OFF_V + (bi) * VBUF; \
        *(LAS v4u*)(kb_ + lk0) = sk0; *(LAS v4u*)(kb_ + lk1) = sk1; *(LAS v4u*)(kb_ + lp) = sp; *(LAS v4u*)(vb_ + lv0) = sv0; *(LAS v4u*)(vb_ + lv1) = sv1; } while (0)
    LAS float* wsf = (LAS float*)(lds + OFF_WS) + wid * 64;
    float m_run = -1e30f, l_run = 0.f;
    f32x16 o[4];
#pragma unroll
    for (int d0 = 0; d0 < 4; ++d0)
#pragma unroll
        for (int r = 0; r < 16; ++r) o[d0][r] = 0.f;
    const int i16 = lane & 15, qq = i16 >> 2, pp = i16 & 3, blk = (lane >> 4) & 1;
    const int voff = (4 * hi + qq) * VSTR + 32 * blk + 8 * pp;
    const int koff = c * KSTR + hi * 16;
    ATT_LOAD(0); ATT_WRITE(0); __syncthreads();
    for (int t = 0; t < NT; ++t) {
        const int cur = t & 1, kb0 = 64 * t;
        if (t + 1 < NT) ATT_LOAD(t + 1);
        if (kb0 <= qlo + 31) {
            f32x16 p0, p1;
#pragma unroll
            for (int r = 0; r < 16; ++r) { p0[r] = 0.f; p1[r] = 0.f; }
            const LAS unsigned char* kp = lds + OFF_K + cur * KBUF + koff;
#pragma unroll
            for (int dg = 0; dg < 3; ++dg) {
                bf16x8 k0[4], k1[4];
#pragma unroll
                for (int j = 0; j < 4; ++j) { k0[j] = *(const LAS bf16x8*)(kp + (4 * dg + j) * 32); k1[j] = *(const LAS bf16x8*)(kp + 32 * KSTR + (4 * dg + j) * 32); }
                __builtin_amdgcn_sched_barrier(0);
#pragma unroll
                for (int j = 0; j < 4; ++j) { p0 = ATT_MFMA(k0[j], qr[4 * dg + j], p0); p1 = ATT_MFMA(k1[j], qr[4 * dg + j], p1); }
            }
            if (kb0 + 63 > qlo) {
                const int dq = qlo + c - kb0 - 4 * hi; const float NEG = -__builtin_inff();
#pragma unroll
                for (int r = 0; r < 16; ++r) { const int cr = (r & 3) + 8 * (r >> 2); if (cr > dq) p0[r] = NEG; if (cr + 32 > dq) p1[r] = NEG; }
            }
            float mx = p0[0];
#pragma unroll
            for (int r = 1; r < 16; ++r) mx = fmaxf(mx, p0[r]);
#pragma unroll
            for (int r = 0; r < 16; ++r) mx = fmaxf(mx, p1[r]);
            mx = fmaxf(mx, __shfl_xor(mx, 32));
            float mn = m_run, alpha = 1.0f;
            if (!__all((mx - m_run) * C2 <= 6.0f)) { mn = fmaxf(m_run, mx); alpha = __builtin_amdgcn_exp2f((m_run - mn) * C2); m_run = mn; }
            const float mnc = mn * C2;
            float rs = 0.f;
#pragma unroll
            for (int r = 0; r < 16; ++r) { p0[r] = __builtin_amdgcn_exp2f(p0[r] * C2 - mnc); p1[r] = __builtin_amdgcn_exp2f(p1[r] * C2 - mnc); rs += p0[r] + p1[r]; }
            rs += __shfl_xor(rs, 32);
            l_run = l_run * alpha + rs;
            if (__any(alpha < 1.0f)) {
                if (hi == 0) wsf[c] = alpha;
                LDS_WAIT();
#pragma unroll
                for (int r = 0; r < 16; ++r) { const float a = wsf[crow(r, hi)];
#pragma unroll
                    for (int d0 = 0; d0 < 4; ++d0) o[d0][r] *= a; }
            }
            const LAS unsigned char* vp = lds + OFF_V + cur * VBUF + voff;
#pragma unroll
            for (int kb = 0; kb < 2; ++kb)
#pragma unroll
                for (int s = 0; s < 2; ++s) {
                    v4u pw;
                    if (kb == 0) { pw.x = cvtpk(p0[8 * s + 0], p0[8 * s + 1]); pw.y = cvtpk(p0[8 * s + 2], p0[8 * s + 3]); pw.z = cvtpk(p0[8 * s + 4], p0[8 * s + 5]); pw.w = cvtpk(p0[8 * s + 6], p0[8 * s + 7]); }
                    else         { pw.x = cvtpk(p1[8 * s + 0], p1[8 * s + 1]); pw.y = cvtpk(p1[8 * s + 2], p1[8 * s + 3]); pw.z = cvtpk(p1[8 * s + 4], p1[8 * s + 5]); pw.w = cvtpk(p1[8 * s + 6], p1[8 * s + 7]); }
                    const bf16x8 pa = __builtin_bit_cast(bf16x8, pw);
                    s16x4 lo[4], hh[4];
#pragma unroll
                    for (int d0 = 0; d0 < 4; ++d0) { lo[d0] = trd(vp + (32 * kb + 16 * s) * VSTR + 64 * d0); hh[d0] = trd(vp + (32 * kb + 16 * s + 8) * VSTR + 64 * d0); }
                    __builtin_amdgcn_sched_barrier(0);
#pragma unroll
                    for (int d0 = 0; d0 < 4; ++d0) o[d0] = ATT_MFMA(pa, __builtin_shufflevector(lo[d0], hh[d0], 0, 1, 2, 3, 4, 5, 6, 7), o[d0]);
                }
        }
        if (t + 1 < NT) ATT_WRITE(cur ^ 1);
        __syncthreads();
    }
    if (hi == 0) wsf[32 + c] = l_run;
    LDS_WAIT();
    bf16* ob = MIXo + (rowbase + qlo) * 4096 + h * 128 + c;
#pragma unroll
    for (int r = 0; r < 16; ++r) { const int orow = crow(r, hi); const float rl = 1.0f / wsf[32 + orow];
#pragma unroll
        for (int d0 = 0; d0 < 4; ++d0) { const float v = o[d0][r] * rl, vn = __shfl_xor(v, 1);
            if ((c & 1) == 0) *(unsigned*)(ob + (size_t)orow * 4096 + d0 * 32) = pk2(v, vn); } }
    LDS_WAIT();
#undef ATT_LOAD
#undef ATT_WRITE
}
}
namespace ssd {
constexpr int RS = 272;
constexpr int BUF = 128 * RS + 128 * 64 + 2560;
constexpr int OFF_X = 128 * RS, OFF_SC = OFF_X + 128 * 64, OFF_S = 2 * BUF;
constexpr int SC_ACS = 0, SC_DT = 512, SC_ECS = 1024, SC_WEND = 1536, SC_ETOT = 2048, LDS_NEED = OFF_S + 2 * 32 * RS;
static_assert(LDS_NEED <= RING_BYTES && BUF % 16 == 0, "ssd LDS");
constexpr float LOG2E = 1.4426950408889634f;
#define SSD_MFMA(a, b, c) __builtin_amdgcn_mfma_f32_32x32x16_bf16((a), (b), (c), 0, 0, 0)
#define SSD_BAR() do { asm volatile("s_waitcnt lgkmcnt(0)" ::: "memory"); __builtin_amdgcn_s_barrier(); asm volatile("" ::: "memory"); } while (0)

__device__ __forceinline__ void ssd_unit(int unit, const bf16* __restrict__ XBC, const float* __restrict__ DT, const bf16* __restrict__ PROJ, const float* a_log, const float* d_skip,
                                         bf16* __restrict__ MIXo, LAS unsigned char* lds) {
    int tid_l = threadIdx.x; asm volatile("" : "+v"(tid_l));
    const int tid = tid_l, lane = tid & 63, c = lane & 31, hi = lane >> 5;
    const int wid = __builtin_amdgcn_readfirstlane(tid >> 6);
    const int b = unit >> 6, h = (unit >> 1) & 31, ph = unit & 1, g = h >> 2, pcol0 = h * 64 + 32 * ph;
    const float A2 = -expf(a_log[h]) * LOG2E, Dk = d_skip[h];
    const size_t mb = (size_t)b * SEQ;
    LAS unsigned char* Ss = lds + OFF_S;
    const int srow = tid >> 4, sch = tid & 15, xrow = tid >> 2, xch = tid & 3;
    const bf16* gB = XBC + (mb + srow) * 4096 + 2048 + g * 128 + sch * 8;
    const bf16* gX = XBC + (mb + xrow) * 4096 + pcol0 + xch * 8;
    const float* gD = DT + (mb + 2 * lane) * 32 + h;
    const bf16* gCf = XBC + (mb + 32 * (wid & 3) + c) * 4096 + 3072 + g * 128 + 8 * hi;
    const int lcb = srow * RS + sch * 16, lx = OFF_X + xrow * 64 + xch * 16;
    v4u sb0, sb1, sb2, sb3, sx; float sd0 = 0.f, sd1 = 0.f;
#define SSD_LOAD(ch) do { const size_t o_ = (size_t)(ch) * 128 * 4096; \
        sb0 = *(const v4u*)(gB + o_); sb1 = *(const v4u*)(gB + o_ + 32 * 4096); sb2 = *(const v4u*)(gB + o_ + 64 * 4096); sb3 = *(const v4u*)(gB + o_ + 96 * 4096); \
        sx = *(const v4u*)(gX + o_); if (wid == 0) { sd0 = gD[(size_t)(ch) * 128 * 32]; sd1 = gD[(size_t)(ch) * 128 * 32 + 32]; } } while (0)
#define SSD_WRITE(bufp) do { LAS unsigned char* wb_ = (bufp); \
        *(LAS v4u*)(wb_ + lcb) = sb0; *(LAS v4u*)(wb_ + lcb + 32 * RS) = sb1; *(LAS v4u*)(wb_ + lcb + 64 * RS) = sb2; *(LAS v4u*)(wb_ + lcb + 96 * RS) = sb3; \
        *(LAS v4u*)(wb_ + lx) = sx; \
        if (wid == 0) {     \
            LAS float* sc_ = (LAS float*)(wb_ + OFF_SC); \
            const float a0_ = sd0 * A2, a1_ = sd1 * A2, pr_ = a0_ + a1_; float inc_ = pr_; \
            _Pragma("unroll") for (int o_ = 1; o_ < 64; o_ <<= 1) { const float v_ = __shfl_up(inc_, o_); if (lane >= o_) inc_ += v_; } \
            const float cs0_ = inc_ - pr_ + a0_, cs1_ = inc_, tot_ = __shfl(inc_, 63); \
            *(LAS f32x2*)(sc_ + SC_ACS / 4 + 2 * lane) = (f32x2){cs0_, cs1_}; *(LAS f32x2*)(sc_ + SC_DT / 4 + 2 * lane) = (f32x2){sd0, sd1}; \
            *(LAS f32x2*)(sc_ + SC_ECS / 4 + 2 * lane) = (f32x2){__builtin_amdgcn_exp2f(cs0_), __builtin_amdgcn_exp2f(cs1_)}; \
            *(LAS f32x2*)(sc_ + SC_WEND / 4 + 2 * lane) = (f32x2){sd0 * __builtin_amdgcn_exp2f(tot_ - cs0_), sd1 * __builtin_amdgcn_exp2f(tot_ - cs1_)}; \
            if (lane == 63) sc_[SC_ETOT / 4] = __builtin_amdgcn_exp2f(tot_); } } while (0)
    const int i16 = lane & 15, qq = i16 >> 2, pp = i16 & 3, blk = (lane >> 4) & 1;
    f32x16 ST;
#pragma unroll
    for (int r = 0; r < 16; ++r) ST[r] = 0.f;
    bf16x8 cfn[8];
#pragma unroll
    for (int ks = 0; ks < 8; ++ks) cfn[ks] = *(const bf16x8*)(gCf + 16 * ks);
    SSD_LOAD(0); SSD_WRITE(lds);
    for (int i = tid; i < (32 * RS) / 16; i += NTHREADS) *(LAS v4u*)(Ss + i * 16) = (v4u){0u, 0u, 0u, 0u};
    SSD_BAR();
    for (int ch = 0; ch < SEQ / 128; ++ch) {
        const int chn = ch + 1 < SEQ / 128 ? ch + 1 : ch;
        SSD_LOAD(chn);
        const size_t m0 = mb + (size_t)ch * 128;
        LAS unsigned char* cb = lds + (ch & 1) * BUF;
        LAS unsigned char* Bs = cb; LAS unsigned char* Xs = cb + OFF_X;
        LAS float* acs = (LAS float*)(cb + OFF_SC + SC_ACS); LAS float* dtv = (LAS float*)(cb + OFF_SC + SC_DT); LAS float* ecs = (LAS float*)(cb + OFF_SC + SC_ECS);
        LAS float* wend = (LAS float*)(cb + OFF_SC + SC_WEND); LAS float* etot = (LAS float*)(cb + OFF_SC + SC_ETOT);
        if (wid < 4) {
            const int lb = wid;
            unsigned short zr[16];
            { const bf16* zp = PROJ + (m0 + 32 * lb + 4 * hi) * INCP + O_Z + pcol0 + c;
#pragma unroll
              for (int r = 0; r < 16; ++r) zr[r] = zp[(size_t)((r & 3) + 8 * (r >> 2)) * INCP]; }
            bf16x8 cf[8];
#pragma unroll
            for (int ks = 0; ks < 8; ++ks) cf[ks] = cfn[ks];
#pragma unroll
            for (int ks = 0; ks < 8; ++ks) cfn[ks] = *(const bf16x8*)(gCf + (size_t)chn * 128 * 4096 + 16 * ks);
            f32x16 y;
#pragma unroll
            for (int r = 0; r < 16; ++r) y[r] = 0.f;
            { const LAS unsigned char* sp = Ss + (ch & 1) * 32 * RS + c * RS + hi * 16; bf16x8 sf[8];
#pragma unroll
              for (int ks = 0; ks < 8; ++ks) sf[ks] = *(const LAS bf16x8*)(sp + ks * 32);
              __builtin_amdgcn_sched_barrier(0);
#pragma unroll
              for (int ks = 0; ks < 8; ++ks) y = SSD_MFMA(cf[ks], sf[ks], y); }
#pragma unroll
            for (int g4 = 0; g4 < 4; ++g4) { const f32x4 e = *(const LAS f32x4*)(ecs + 32 * lb + 8 * g4 + 4 * hi);
#pragma unroll
                for (int i = 0; i < 4; ++i) y[4 * g4 + i] *= e[i]; }
            const float acl = acs[32 * lb + c];
            for (int sb = 0; sb <= lb; ++sb) {
                f32x16 gt;
#pragma unroll
                for (int r = 0; r < 16; ++r) gt[r] = 0.f;
                const LAS unsigned char* bp = Bs + (32 * sb + c) * RS + hi * 16;
                const LAS unsigned char* xp0 = Xs + (32 * sb + 4 * hi + qq) * 64 + (16 * blk + 4 * pp) * 2;
                const s16x4 xl0 = att::trd(xp0), xh0 = att::trd(xp0 + 8 * 64), xl1 = att::trd(xp0 + 16 * 64), xh1 = att::trd(xp0 + 24 * 64);
#pragma unroll
                for (int kg = 0; kg < 2; ++kg) { bf16x8 bfr[4];
#pragma unroll
                    for (int k4 = 0; k4 < 4; ++k4) bfr[k4] = *(const LAS bf16x8*)(bp + (4 * kg + k4) * 32);
                    __builtin_amdgcn_sched_barrier(0);
#pragma unroll
                    for (int k4 = 0; k4 < 4; ++k4) gt = SSD_MFMA(bfr[k4], cf[4 * kg + k4], gt); }
                const int dl = 32 * (lb - sb) + c - 4 * hi;
#pragma unroll
                for (int gh = 0; gh < 2; ++gh) { f32x4 as4[2], ds4[2];
#pragma unroll
                    for (int g2 = 0; g2 < 2; ++g2) { as4[g2] = *(const LAS f32x4*)(acs + 32 * sb + 8 * (2 * gh + g2) + 4 * hi); ds4[g2] = *(const LAS f32x4*)(dtv + 32 * sb + 8 * (2 * gh + g2) + 4 * hi); }
#pragma unroll
                    for (int g2 = 0; g2 < 2; ++g2) { const int g4 = 2 * gh + g2;
#pragma unroll
                        for (int i = 0; i < 4; ++i) { const float w = __builtin_amdgcn_exp2f(fminf(acl - as4[g2][i], 0.f)) * ds4[g2][i]; gt[4 * g4 + i] = (8 * g4 + i <= dl) ? gt[4 * g4 + i] * w : 0.f; } } }
#pragma unroll
                for (int s2 = 0; s2 < 2; ++s2) {
                    v4u pw; pw.x = att::cvtpk(gt[8 * s2 + 0], gt[8 * s2 + 1]); pw.y = att::cvtpk(gt[8 * s2 + 2], gt[8 * s2 + 3]); pw.z = att::cvtpk(gt[8 * s2 + 4], gt[8 * s2 + 5]); pw.w = att::cvtpk(gt[8 * s2 + 6], gt[8 * s2 + 7]);
                    const s16x4 lo = s2 ? xl1 : xl0, hh = s2 ? xh1 : xh0;
                    y = SSD_MFMA(__builtin_bit_cast(bf16x8, pw), __builtin_shufflevector(lo, hh, 0, 1, 2, 3, 4, 5, 6, 7), y);
                }
            }
            bf16* op = MIXo + (m0 + 32 * lb + 4 * hi) * 4096 + 2048 + pcol0 + c;
            const LAS unsigned short* xl = (const LAS unsigned short*)(Xs + (32 * lb + 4 * hi) * 64 + 2 * c);
            unsigned short xr[16];
#pragma unroll
            for (int r = 0; r < 16; ++r) xr[r] = xl[((r & 3) + 8 * (r >> 2)) * 32];
            __builtin_amdgcn_sched_barrier(0);
#pragma unroll
            for (int r = 0; r < 16; ++r) { const int lr = (r & 3) + 8 * (r >> 2);
                const float v = (y[r] + Dk * bf1(xr[r])) * silu_f(bf1(zr[r]));
                op[(size_t)lr * 4096] = (bf16)f2bf(v); }
        } else {
            const int nb = wid - 4;
            const float et = etot[0];
#pragma unroll
            for (int r = 0; r < 16; ++r) ST[r] *= et;
            const LAS unsigned char* ap = Bs + (8 * hi + qq) * RS + (32 * nb + 16 * blk + 4 * pp) * 2;
            const LAS unsigned char* xp = Xs + (8 * hi + qq) * 64 + (16 * blk + 4 * pp) * 2;
#pragma unroll
            for (int kg = 0; kg < 2; ++kg) {
                s16x4 alo[4], ahh[4], xlo[4], xhh[4]; f32x4 w0[4], w1[4];
#pragma unroll
                for (int k4 = 0; k4 < 4; ++k4) { const int ks = 4 * kg + k4;
                    alo[k4] = att::trd(ap + 16 * ks * RS); ahh[k4] = att::trd(ap + (16 * ks + 4) * RS);
                    xlo[k4] = att::trd(xp + 16 * ks * 64); xhh[k4] = att::trd(xp + (16 * ks + 4) * 64);
                    w0[k4] = *(const LAS f32x4*)(wend + 16 * ks + 8 * hi); w1[k4] = *(const LAS f32x4*)(wend + 16 * ks + 8 * hi + 4); }
                __builtin_amdgcn_sched_barrier(0);
#pragma unroll
                for (int k4 = 0; k4 < 4; ++k4) {
                    v4u xw;
                    xw.x = att::cvtpk(bf1((bf16)xlo[k4][0]) * w0[k4][0], bf1((bf16)xlo[k4][1]) * w0[k4][1]); xw.y = att::cvtpk(bf1((bf16)xlo[k4][2]) * w0[k4][2], bf1((bf16)xlo[k4][3]) * w0[k4][3]);
                    xw.z = att::cvtpk(bf1((bf16)xhh[k4][0]) * w1[k4][0], bf1((bf16)xhh[k4][1]) * w1[k4][1]); xw.w = att::cvtpk(bf1((bf16)xhh[k4][2]) * w1[k4][2], bf1((bf16)xhh[k4][3]) * w1[k4][3]);
                    ST = SSD_MFMA(__builtin_shufflevector(alo[k4], ahh[k4], 0, 1, 2, 3, 4, 5, 6, 7), __builtin_bit_cast(bf16x8, xw), ST);
                }
            }
            LAS unsigned char* so = Ss + ((ch + 1) & 1) * 32 * RS + c * RS + (32 * nb + 4 * hi) * 2;
#pragma unroll
            for (int g4 = 0; g4 < 4; ++g4) { v2u w; w.x = att::cvtpk(ST[4 * g4], ST[4 * g4 + 1]); w.y = att::cvtpk(ST[4 * g4 + 2], ST[4 * g4 + 3]); *(LAS v2u*)(so + g4 * 16) = w; }
        }
        SSD_WRITE(lds + ((ch + 1) & 1) * BUF);
        SSD_BAR();
    }
    VM_WAIT();
#undef SSD_LOAD
#undef SSD_WRITE
}
}
struct Frame {
    LAS unsigned char* lds;
    volatile LAS unsigned* MISC;
    gu32* ctl;
    int wave;
    int vcu, G;
};

__device__ __forceinline__ void row_copy_ss(const float* xrow, bf16* orow, unsigned long long* ss, int lane) {
    const f32x4* xr = (const f32x4*)xrow + lane;
    f32x4 v[16]; float s = 0.f;
#pragma unroll
    for (int j = 0; j < 16; ++j) { v[j] = xr[64 * j]; s += (v[j].x * v[j].x + v[j].y * v[j].y) + (v[j].z * v[j].z + v[j].w * v[j].w); }
    s = wave_sum(s);
    v2u* o8 = (v2u*)orow + lane;
#pragma unroll
    for (int j = 0; j < 16; ++j) { v2u wb; wb.x = pk2(v[j].x, v[j].y); wb.y = pk2(v[j].z, v[j].w); o8[64 * j] = wb; }
    if (lane == 0) *ss = (unsigned long long)(s * 1048576.0f + 0.5f);
}
__device__ __forceinline__ void rms_row_out(const bf16* xrow, const float* gain, float* orow, int lane) {
    const v4u* xr = (const v4u*)xrow + lane; float v[64]; float s = 0.f;
#pragma unroll
    for (int j = 0; j < 8; ++j) { const v4u w = xr[64 * j];
#pragma unroll
        for (int e = 0; e < 4; ++e) { v[8 * j + 2 * e] = bflo(w[e]); v[8 * j + 2 * e + 1] = bfhi(w[e]); s += v[8 * j + 2 * e] * v[8 * j + 2 * e] + v[8 * j + 2 * e + 1] * v[8 * j + 2 * e + 1]; } }
    const float rstd = 1.0f / sqrtf(wave_sum(s) * (1.0f / DM) + EPS);
#pragma unroll
    for (int j = 0; j < 8; ++j) { const f32x4 g0 = *(const f32x4*)(gain + 512 * j + 8 * lane), g1 = *(const f32x4*)(gain + 512 * j + 8 * lane + 4);
        f32x4 o0, o1;
#pragma unroll
        for (int e = 0; e < 4; ++e) { o0[e] = v[8 * j + e] * rstd * g0[e]; o1[e] = v[8 * j + 4 + e] * rstd * g1[e]; }
        *(f32x4*)(orow + 512 * j + 8 * lane) = o0; *(f32x4*)(orow + 512 * j + 8 * lane + 4) = o1; }
}
__device__ __forceinline__ void prep_rows4(int m0, const bf16* PROJ, const float* cosT, const float* sinT, const float* dt_bias, unsigned long long* SSQ, bf16* KPE, float* DT, int lane) {
    v4u w[4][3]; unsigned short dtr[4];
#pragma unroll
    for (int r = 0; r < 4; ++r) { const bf16* pr = PROJ + (size_t)(m0 + r) * INCP;
        w[r][0] = *(const v4u*)(pr + 8 * lane); w[r][1] = *(const v4u*)(pr + 8 * (64 + lane));
        w[r][2] = lane < 56 ? *(const v4u*)(pr + 8 * (128 + lane)) : (v4u){0u, 0u, 0u, 0u};
        dtr[r] = lane < 32 ? pr[O_DT + lane] : (unsigned short)0; }
#pragma unroll
    for (int r = 0; r < 4; ++r) { const int m = m0 + r;
        float s0 = 0.f, s1 = 0.f, s2 = 0.f;
#pragma unroll
        for (int e = 0; e < 4; ++e) { float a = bflo(w[r][0][e]), b = bfhi(w[r][0][e]); s0 += a * a + b * b; a = bflo(w[r][1][e]); b = bfhi(w[r][1][e]); s1 += a * a + b * b; a = bflo(w[r][2][e]); b = bfhi(w[r][2][e]); s2 += a * a + b * b; }
        const float sq = wave_sum(s0 + (lane < 48 ? s1 : 0.f)), sk = wave_sum((lane < 48 ? 0.f : s1) + (lane < 48 ? s2 : 0.f));
        if (lane == 0) { SSQ[m] = (unsigned long long)(sq * 1048576.0f + 0.5f); SSQ[M + m] = (unsigned long long)(sk * 1048576.0f + 0.5f); }
        if (lane >= 48 && lane < 56) {
            const int ip = 4 * (lane - 48); const f32x4 cs = *(const f32x4*)(cosT + (size_t)m * 32 + ip), sn = *(const f32x4*)(sinT + (size_t)m * 32 + ip);
            v4u o;
#pragma unroll
            for (int e = 0; e < 4; ++e) { const float x1 = bflo(w[r][2][e]), x2 = bfhi(w[r][2][e]); o[e] = pk2(x1 * cs[e] - x2 * sn[e], x2 * cs[e] + x1 * sn[e]); }
            *(v4u*)(KPE + (size_t)m * 64 + 2 * ip) = o; }
        if (lane < 32) { const float v = bf1(dtr[r]) + dt_bias[lane]; DT[(size_t)m * 32 + lane] = fmaxf(v, 0.f) + log1pf(expf(-fabsf(v))); }
    }
}
__device__ __forceinline__ void conv_item(int item, const bf16* PROJ, const float* conv_w, const float* conv_b, bf16* XBC, int lane) {
    const int rr = item >> 3, sl = item & 7, ch0 = sl * 512 + lane * 8, m0 = rr * 32, t0 = m0 & (SEQ - 1);
    const bf16* src = PROJ + (size_t)m0 * INCP + O_XBC + ch0;
    bf16* dst = XBC + (size_t)m0 * 4096 + ch0;
    v4u x[35];
#pragma unroll
    for (int i = 0; i < 3; ++i) x[i] = t0 > 0 ? *(const v4u*)(src + (ptrdiff_t)(i - 3) * INCP) : (v4u){0u, 0u, 0u, 0u};
#pragma unroll
    for (int i = 0; i < 32; ++i) x[3 + i] = *(const v4u*)(src + (size_t)i * INCP);
    float w[4][8], bb[8];
#pragma unroll
    for (int k = 0; k < 4; ++k) { const f32x4 a = *(const f32x4*)(conv_w + k * CONVD + ch0), b2 = *(const f32x4*)(conv_w + k * CONVD + ch0 + 4);
#pragma unroll
        for (int e = 0; e < 4; ++e) { w[k][e] = a[e]; w[k][4 + e] = b2[e]; } }
    { const f32x4 a = *(const f32x4*)(conv_b + ch0), b2 = *(const f32x4*)(conv_b + ch0 + 4);
#pragma unroll
      for (int e = 0; e < 4; ++e) { bb[e] = a[e]; bb[4 + e] = b2[e]; } }
#pragma unroll
    for (int i = 0; i < 32; ++i) { v4u o;
#pragma unroll
        for (int e = 0; e < 4; ++e) {
            const float ya = bb[2 * e] + w[0][2 * e] * bflo(x[i][e]) + w[1][2 * e] * bflo(x[i + 1][e]) + w[2][2 * e] * bflo(x[i + 2][e]) + w[3][2 * e] * bflo(x[i + 3][e]);
            const float yc = bb[2 * e + 1] + w[0][2 * e + 1] * bfhi(x[i][e]) + w[1][2 * e + 1] * bfhi(x[i + 1][e]) + w[2][2 * e + 1] * bfhi(x[i + 2][e]) + w[3][2 * e + 1] * bfhi(x[i + 3][e]);
            o[e] = pk2(silu_f(ya), silu_f(yc)); }
        *(v4u*)(dst + (size_t)i * 4096) = o; }
}
template <int NR> __device__ __forceinline__ void gnorm_rows(bf16* row0, size_t rstride, const float* gw, int lane) {
    v4u w[NR][4];
#pragma unroll
    for (int r = 0; r < NR; ++r) { const v4u* p = (const v4u*)(row0 + r * rstride + 32 * lane);
#pragma unroll
        for (int j = 0; j < 4; ++j) w[r][j] = p[j]; }
    const float* g = gw + 32 * lane;
#pragma unroll
    for (int r = 0; r < NR; ++r) { float s = 0.f;
#pragma unroll
        for (int j = 0; j < 4; ++j)
#pragma unroll
            for (int e = 0; e < 4; ++e) { const float a = bflo(w[r][j][e]), b = bfhi(w[r][j][e]); s += a * a + b * b; }
        s += __shfl_xor(s, 1); s += __shfl_xor(s, 2); s += __shfl_xor(s, 4);
        const float rstd = 1.0f / sqrtf(s * (1.0f / 256.0f) + EPS);
        v4u* p = (v4u*)(row0 + r * rstride + 32 * lane);
#pragma unroll
        for (int j = 0; j < 4; ++j) { v4u o;
#pragma unroll
            for (int e = 0; e < 4; ++e) o[e] = pk2(bflo(w[r][j][e]) * rstd * g[8 * j + 2 * e], bfhi(w[r][j][e]) * rstd * g[8 * j + 2 * e + 1]);
            p[j] = o; } }
}
__device__ __forceinline__ void ssd_item(int item, const bf16* XBC, const float* DT, const bf16* PROJ, const float* a_log, const float* d_skip, bf16* MIXo, int lane) {
    const int pi = lane >> 4, ns = lane & 15;
    const int b = item >> 9, h = (item >> 4) & 31, pq = item & 15, g = h >> 2;
    const float A2 = -expf(a_log[h]) * 1.4426950408889634f, Dk = d_skip[h];
    const int pcol = h * 64 + pq * 4 + pi;
    float st[8];
#pragma unroll
    for (int k = 0; k < 8; ++k) st[k] = 0.f;
    const bf16* xb = XBC + (size_t)b * SEQ * 4096; const float* dtp = DT + (size_t)b * SEQ * 32 + h;
    const bf16* zp = PROJ + (size_t)b * SEQ * INCP + O_Z + pcol; bf16* op = MIXo + (size_t)b * SEQ * 4096 + 2048 + pcol;
#pragma unroll 4
    for (int t = 0; t < SEQ; ++t) {
        const bf16* xr = xb + (size_t)t * 4096;
        const float dtv = dtp[(size_t)t * 32];
        const float xv = bf1(xr[pcol]);
        const v4u Bw = *(const v4u*)(xr + 2048 + g * 128 + ns * 8);
        const v4u Cw = *(const v4u*)(xr + 3072 + g * 128 + ns * 8);
        const float zv = bf1(zp[(size_t)t * INCP]);
        const float dA = __builtin_amdgcn_exp2f(dtv * A2), xdt = dtv * xv;
        float part = 0.f;
#pragma unroll
        for (int e = 0; e < 4; ++e) {
            st[2 * e] = dA * st[2 * e] + xdt * bflo(Bw[e]); part += bflo(Cw[e]) * st[2 * e];
            st[2 * e + 1] = dA * st[2 * e + 1] + xdt * bfhi(Bw[e]); part += bfhi(Cw[e]) * st[2 * e + 1]; }
        part += __shfl_xor(part, 1); part += __shfl_xor(part, 2); part += __shfl_xor(part, 4); part += __shfl_xor(part, 8);
        if (ns == 0) op[(size_t)t * 4096] = (bf16)f2bf((part + Dk * xv) * silu_f(zv));
    }
}
__device__ __forceinline__ int dst_row(int kind, int n) {
    if (kind == 1) return ((n >> 7) << 8) + (n & 127);
    if (kind == 2) return ((n >> 7) << 8) + 128 + (n & 127);
    if (kind == 3) { const int hh = n / QKD, j = n - hh * QKD; if (j < NOPE) return n; const int i = j - NOPE; return hh * QKD + NOPE + (i < 32 ? 2 * i : 2 * (i - 32) + 1); }
    if (kind == 4) { if (n < O_KPE || n >= O_KPE + ROPE) return n; const int i = n - O_KPE; return O_KPE + (i < 32 ? 2 * i : 2 * (i - 32) + 1); }
    return n;
}
__device__ __forceinline__ void p0_transpose_item(const float* W, int K, int N, bf16* WT, int kind, const float* gain, LAS float* scr, int item, int lane) {
    const bool f16w = false;
    const int nblk = N / 32, kb = item / nblk, nb = item - kb * nblk, k0 = 64 * kb, n0 = 32 * nb;
    float v[32];
    const float* wp = W + (size_t)(k0 + (lane >> 5)) * N + n0 + (lane & 31);
#pragma unroll
    for (int i = 0; i < 32; ++i) v[i] = wp[(size_t)(2 * i) * N];
    const int c = lane & 7;
    f32x4 g0 = (f32x4){1.f, 1.f, 1.f, 1.f}, g1 = g0;
    if (gain) { g0 = *(const f32x4*)(gain + k0 + 8 * c); g1 = *(const f32x4*)(gain + k0 + 8 * c + 4); }
#pragma unroll
    for (int i = 0; i < 32; ++i) scr[(2 * i + (lane >> 5)) * 33 + (lane & 31)] = v[i];
    LDS_WAIT(); asm volatile("" ::: "memory");
#pragma unroll
    for (int j = 0; j < 4; ++j) { const int n = (lane >> 3) + 8 * j; const LAS float* s = scr + (8 * c) * 33 + n;
        const float e0 = s[0 * 33] * g0[0], e1 = s[1 * 33] * g0[1], e2 = s[2 * 33] * g0[2], e3 = s[3 * 33] * g0[3], e4 = s[4 * 33] * g1[0], e5 = s[5 * 33] * g1[1], e6 = s[6 * 33] * g1[2], e7 = s[7 * 33] * g1[3];
        v4u o; if (f16w) { o.x = pkh2(e0, e1); o.y = pkh2(e2, e3); o.z = pkh2(e4, e5); o.w = pkh2(e6, e7); } else { o.x = pk2(e0, e1); o.y = pk2(e2, e3); o.z = pk2(e4, e5); o.w = pk2(e6, e7); }
        *(v4u*)(WT + (size_t)dst_row(kind, n0 + n) * K + k0 + 8 * c) = o; }
    LDS_WAIT(); asm volatile("" ::: "memory");
}
struct InPtrs { const float* p[24]; };
#ifndef DEFER_D2
#define DEFER_D2 1
#endif
constexpr int IT_FFN = (DM / 64) * (FF / 32);
constexpr int IT_IN = (DM / 64) * (INC / 32);
constexpr int IT_QU = (QL / 64) * (QW / 32);
constexpr int IT_KVU = (KVL / 64) * (KVW / 32);
constexpr int IT_O = (DM / 64) * (DM / 32);
constexpr int IT_LAYER = 6 * IT_FFN + IT_IN + IT_QU + IT_KVU + IT_O;
__device__ __forceinline__ void p0_prologue(Frame& F, const InPtrs& in, unsigned char* ws, int lane) {
    LAS float* scr = (LAS float*)(F.lds + RING_OFF + F.wave * 16384);
    const int gw = F.vcu * NWAVES + F.wave, NGW = F.G * NWAVES;
    for (int it = gw; it < DEPTH * IT_LAYER; it += NGW) {
        const int l = it / IT_LAYER; int r = it - l * IT_LAYER;
        unsigned char* wl = ws + WS_W + (size_t)l * W_LAYER;
        const size_t lFF = (size_t)l * DM * FF;
        if (r < IT_FFN) { p0_transpose_item(in.p[3] + lFF, DM, FF, (bf16*)(wl + W_GU1), 1, in.p[2] + (size_t)l * DM, scr, r, lane); continue; } r -= IT_FFN;
        if (r < IT_FFN) { p0_transpose_item(in.p[4] + lFF, DM, FF, (bf16*)(wl + W_GU1), 2, in.p[2] + (size_t)l * DM, scr, r, lane); continue; } r -= IT_FFN;
        if (r < IT_FFN) { p0_transpose_item(in.p[5] + lFF, FF, DM, (bf16*)(wl + W_D1), 0, nullptr, scr, r, lane); continue; } r -= IT_FFN;
        if (r < IT_IN) { p0_transpose_item(in.p[7] + (size_t)l * DM * INC, DM, INC, (bf16*)(wl + W_IN), 4, in.p[6] + (size_t)l * DM, scr, r, lane); continue; } r -= IT_IN;
        if (r < IT_QU) { p0_transpose_item(in.p[9] + (size_t)l * QL * QW, QL, QW, (bf16*)(wl + W_QU), 3, in.p[8] + (size_t)l * QL, scr, r, lane); continue; } r -= IT_QU;
        if (r < IT_KVU) { p0_transpose_item(in.p[11] + (size_t)l * KVL * KVW, KVL, KVW, (bf16*)(wl + W_KVU), 0, in.p[10] + (size_t)l * KVL, scr, r, lane); continue; } r -= IT_KVU;
        if (r < IT_O) { p0_transpose_item(in.p[18] + (size_t)l * DM * DM, DM, DM, (bf16*)(wl + W_O), 0, nullptr, scr, r, lane); continue; } r -= IT_O;
        if (r < IT_FFN) { if (!(l >= 1 && DEFER_D2 >= 2)) p0_transpose_item(in.p[20] + lFF, DM, FF, (bf16*)(wl + W_GU2), 1, in.p[19] + (size_t)l * DM, scr, r, lane); continue; } r -= IT_FFN;
        if (r < IT_FFN) { p0_transpose_item(in.p[21] + lFF, DM, FF, (bf16*)(wl + W_GU2), 2, in.p[19] + (size_t)l * DM, scr, r, lane); continue; } r -= IT_FFN;
        if (l >= 1 && DEFER_D2) continue;
        p0_transpose_item(in.p[22] + lFF, FF, DM, (bf16*)(wl + W_D2), 0, nullptr, scr, r, lane);
    }
    const int gt = gw * 64 + lane, NGT = NGW * 64;
    for (int i = gt; i < DEPTH * 16384; i += NGT) { const int l = i >> 14, j = i & 16383;
        *(v4u*)(ws + WS_W + (size_t)l * W_LAYER + W_IN + (size_t)INC * DM * 2 + (size_t)j * 16) = (v4u){0u, 0u, 0u, 0u}; }
    const int* pos = (const int*)in.p[1]; float* cosT = (float*)(ws + WS_COS); float* sinT = (float*)(ws + WS_SIN);
    float invf;
    {   const double y = -(double)(lane & 31) * 0.28782313662425575;
        const double kd = __builtin_rint(y * 1.4426950408889634);
        double r = __builtin_fma(-kd, 0.6931471803691238, y); r = __builtin_fma(-kd, 1.9082149292705877e-10, r);
        double e = 1.0;
#pragma unroll
        for (int k = 18; k >= 1; --k) e = 1.0 + e * r * (1.0 / (double)k);
        invf = (float)__builtin_ldexp(e, (int)kd); }
    for (int i = gt; i < M * 32; i += NGT) { const int m = i >> 5;
        const float ang = (float)pos[m] * invf;
        const double x = (double)ang, n = __builtin_rint(x * 0.15915494309189535);
        double r = __builtin_fma(-n, 6.283185307179586, x); r = __builtin_fma(-n, 2.4492935982947064e-16, r);
        const double r2 = r * r; double sn = 1.0, cs = 1.0;
#pragma unroll
        for (int k = 14; k >= 1; --k) { sn = 1.0 - sn * r2 * (1.0 / (double)((2 * k) * (2 * k + 1))); cs = 1.0 - cs * r2 * (1.0 / (double)((2 * k - 1) * (2 * k))); }
        cosT[i] = (float)cs; sinT[i] = (float)(sn * r); }
    for (int m = gw; m < M; m += NGW) row_copy_ss(in.p[0] + (size_t)m * DM, (bf16*)(ws + WS_XN) + (size_t)m * DM, (unsigned long long*)(ws + WS_SS) + m, lane);
}
#ifndef REP_GEMM
#define REP_GEMM 1
#endif
#ifndef REP_RES
#define REP_RES 1
#endif
#ifndef REP_BAR
#define REP_BAR 0
#endif
#ifndef REP_ATT
#define REP_ATT 1
#endif
#ifndef REP_SSD
#define REP_SSD 1
#endif
#ifndef REP_THIN
#define REP_THIN 1
#endif
#ifndef DBG_EN
#define DBG_EN 0xffff
#endif
constexpr int PH_PER_LAYER = 9, N_PHASES = 1 + PH_PER_LAYER * DEPTH + 1;
struct Args { const float* in[24]; float* out; unsigned char* ws; int ph_lo, ph_hi; };
static_assert(sizeof(Args) == 24 * 8 + 16 + 8, "Args has no holes");

__global__ void __launch_bounds__(NTHREADS, 2) trunk_fwd(Args args) {
    extern __shared__ __attribute__((aligned(16))) unsigned char lds[];
    Frame F;
    F.lds = (LAS unsigned char*)lds;
    F.MISC = (volatile LAS unsigned*)(F.lds + MISC_OFF);
    F.wave = __builtin_amdgcn_readfirstlane(threadIdx.x >> 6);
    F.G = gridDim.x; { const int bx = blockIdx.x; F.vcu = (F.G % 8 == 0) ? (bx % 8) * (F.G / 8) + bx / 8 : bx; }
    unsigned char* ws = args.ws;
    F.ctl = (gu32*)(ws + WS_CTL);
    for (int u = threadIdx.x; u < (LDS_BYTES - LDSCTL_OFF) / 4; u += NTHREADS) ((LAS unsigned*)(F.lds + LDSCTL_OFF))[u] = 0u;
    __syncthreads();
    XcdBarrier bar; bar.bar = (unsigned*)(F.ctl + CW_BAR); bar.x = 0; bar.st = nullptr;
    if (MK_ONE_LAUNCH) bar = xcd_barrier_post((unsigned*)(F.ctl + CW_BAR), F.MISC + 8);
#define GRID_BAR() do { if (MK_ONE_LAUNCH) xcd_barrier(bar); } while (0)
    const int lo = args.ph_lo, hi = args.ph_hi;
#define IN(k) (lo <= (k) && (k) < hi)
#ifndef XBAR
#define XBAR 0
#endif
#define SEAM(k) do { if (IN((k) + 1)) { GRID_BAR(); for (int xb_ = 0; xb_ < XBAR; ++xb_) GRID_BAR(); } } while (0)
#define ROWFAC(ssp_, invn_) ({ LAS float* tab_ = (LAS float*)(F.lds + RSTAB_OFF); const int rb_ = 2048 * ((int)blockIdx.x & 7); int t0_ = threadIdx.x; asm volatile("" : "+v"(t0_)); __syncthreads(); \
        for (int r_ = t0_; r_ < 2048; r_ += NTHREADS) tab_[r_] = pg8::row_rstd((ssp_), rb_ + r_, (invn_)); \
        __syncthreads(); pg8::RowFac rf_; rf_.tab = tab_ - rb_; rf_; })
#define LANE_L() ({ int l_ = threadIdx.x; asm volatile("" : "+v"(l_)); l_ & 63; })
#define PH_VARS() const int ln = LANE_L(); int gw_ = F.vcu * NWAVES + F.wave; asm volatile("" : "+s"(gw_)); const int gw = gw_, NGW = F.G * NWAVES; (void)ln; (void)gw; (void)NGW

    bf16* XB = (bf16*)(ws + WS_XN); bf16* HB = (bf16*)(ws + WS_BIG); bf16* PROJ = (bf16*)(ws + WS_BIG);
    bf16* KPE = (bf16*)(ws + WS_KPE); float* DT = (float*)(ws + WS_DT); unsigned long long* SSQ = (unsigned long long*)(ws + WS_SSQ); unsigned long long* SS = (unsigned long long*)(ws + WS_SS);
    bf16* XBC = (bf16*)(ws + WS_XBC); bf16* QB = (bf16*)(ws + WS_Q); bf16* KVB = (bf16*)(ws + WS_KV); bf16* MIX = (bf16*)(ws + WS_MIX);
    const float* cosT = (const float*)(ws + WS_COS); const float* sinT = (const float*)(ws + WS_SIN);

    if ((DBG_EN & 1) && IN(0)) { PH_VARS(); InPtrs ip;
#pragma unroll
        for (int i = 0; i < 24; ++i) ip.p[i] = args.in[i];
        for (int rep = 0; rep < REP_THIN; ++rep) p0_prologue(F, ip, ws, ln); SEAM(0); }

    for (int l = 0; l < DEPTH; ++l) {
        const int pb = 1 + PH_PER_LAYER * l;
        unsigned char* wl = ws + WS_W + (size_t)l * W_LAYER;
        for (int f = 0; f < 2; ++f) {
            if (f == 1) {
                if ((DBG_EN & 4) && IN(pb + 2)) { PH_VARS(); pg8::Gemm g{XB, (const bf16*)(wl + W_IN), M, INCP, DM, DM, DM}; pg8::StaticOrder S; S.init(M, INCP, F.G, (int)blockIdx.x);
                    pg8::EpiStore E{PROJ, INCP, ROWFAC(SS + (size_t)(3 * l + 1) * M, 1.0f / DM)};
                    for (int rep = 0; rep < REP_GEMM; ++rep) { if (REP_BAR && rep) GRID_BAR(); pg8::gemm_phase<pg8::EpiStore, pg8::StaticOrder, PG8_ALIGN, PG8_SP2>(F.lds + RING_OFF, g, S, E); }
                    if (DEFER_D2 && l + 1 < DEPTH && F.G == 256 && blockIdx.x >= 128) {
                        LAS float* scr = (LAS float*)(F.lds + RING_OFF + F.wave * 16384);
                        bf16* wt = (bf16*)(ws + WS_W + (size_t)(l + 1) * W_LAYER + W_D2); const float* wsrc = args.in[22] + (size_t)(l + 1) * DM * FF;
                        for (int it = ((int)blockIdx.x - 128) * NWAVES + F.wave; it < IT_FFN; it += 128 * NWAVES) p0_transpose_item(wsrc, FF, DM, wt, 0, nullptr, scr, it, ln);
                        if (DEFER_D2 >= 2) { bf16* wg = (bf16*)(ws + WS_W + (size_t)(l + 1) * W_LAYER + W_GU2); const float* gsrc = args.in[20] + (size_t)(l + 1) * DM * FF; const float* gg = args.in[19] + (size_t)(l + 1) * DM;
                            for (int it = ((int)blockIdx.x - 128) * NWAVES + F.wave; it < IT_FFN; it += 128 * NWAVES) p0_transpose_item(gsrc, DM, FF, wg, 1, gg, scr, it, ln); }
                    } else if (DEFER_D2 && l + 1 < DEPTH && F.G != 256) {
                        LAS float* scr = (LAS float*)(F.lds + RING_OFF + F.wave * 16384);
                        bf16* wt = (bf16*)(ws + WS_W + (size_t)(l + 1) * W_LAYER + W_D2); const float* wsrc = args.in[22] + (size_t)(l + 1) * DM * FF;
                        for (int it = gw; it < IT_FFN; it += NGW) p0_transpose_item(wsrc, FF, DM, wt, 0, nullptr, scr, it, ln);
                        if (DEFER_D2 >= 2) { bf16* wg = (bf16*)(ws + WS_W + (size_t)(l + 1) * W_LAYER + W_GU2); const float* gsrc = args.in[20] + (size_t)(l + 1) * DM * FF; const float* gg = args.in[19] + (size_t)(l + 1) * DM;
                            for (int it = gw; it < IT_FFN; it += NGW) p0_transpose_item(gsrc, DM, FF, wg, 1, gg, scr, it, ln); }
                    }
                    SEAM(pb + 2); }
                if ((DBG_EN & 8) && IN(pb + 3)) { PH_VARS();
                    for (int rep = 0; rep < REP_THIN; ++rep) for (int m = 4 * gw; m < M; m += 4 * NGW) prep_rows4(m, PROJ, cosT, sinT, args.in[14] + (size_t)l * SSD_H, SSQ, KPE, DT, ln);
                    for (int rep = 0; rep < REP_THIN; ++rep) for (int it = gw; it < (M / 32) * 8; it += NGW) conv_item(it, PROJ, args.in[12] + (size_t)l * 4 * CONVD, args.in[13] + (size_t)l * CONVD, XBC, ln);
                    SEAM(pb + 3); }
                if ((DBG_EN & 16) && IN(pb + 4)) { PH_VARS();
                    for (int rep = 0; rep < REP_SSD; ++rep) for (int u = F.vcu; u < BATCH * SSD_H * 2; u += F.G) ssd::ssd_unit(u, XBC, DT, PROJ, args.in[15] + (size_t)l * SSD_H, args.in[16] + (size_t)l * SSD_H, MIX, F.lds + RING_OFF);
                    for (int s2 = 0; s2 < 2; ++s2) {
                        const int kk = s2 ? KVL : QL, nn = s2 ? KVW : QW;
                        pg8::Gemm g{PROJ + (s2 ? O_CKV : O_CQ), (const bf16*)(wl + (s2 ? W_KVU : W_QU)), M, nn, kk, INCP, kk}; pg8::StaticOrder S; S.init(M, nn, F.G, (int)blockIdx.x);
                        pg8::EpiStore E{s2 ? KVB : QB, nn, ROWFAC(SSQ + (size_t)s2 * M, 1.0f / (float)kk)};
                        for (int rep = 0; rep < REP_GEMM; ++rep) { if (REP_BAR && rep) GRID_BAR(); pg8::gemm_phase<pg8::EpiStore, pg8::StaticOrder, PG8_ALIGN, PG8_SP2>(F.lds + RING_OFF, g, S, E); } }
                    SEAM(pb + 4); }
                if ((DBG_EN & 32) && IN(pb + 5)) { PH_VARS();
                    for (int rep = 0; rep < REP_ATT; ++rep) for (int u = F.vcu; u < BATCH * NH * 8; u += F.G) { const int bh = u >> 3, xq = u & 7;
                        att::attn_block(bh >> 4, bh & 15, xq, QB, KVB, KPE, cosT, sinT, MIX, F.lds + RING_OFF);
                        att::attn_block(bh >> 4, bh & 15, 15 - xq, QB, KVB, KPE, cosT, sinT, MIX, F.lds + RING_OFF); }
                    { const float* g = args.in[17] + (size_t)l * SSD_W;
                      for (int m = 4 * gw; m < M; m += 4 * NGW) gnorm_rows<4>(MIX + (size_t)m * 4096 + 2048, 4096, g, ln); }
                    SEAM(pb + 5); }
                if ((DBG_EN & 128) && IN(pb + 6)) { PH_VARS(); pg8::Gemm g{MIX, (const bf16*)(wl + W_O), M, DM, DM, DM, DM}; pg8::StaticOrder S; S.init(M, DM, F.G, (int)blockIdx.x);
                    for (int rep = 0; rep < REP_RES; ++rep) { pg8::EpiResid E{XB, rep ? (unsigned long long*)(ws + WS_SSP) : SS + (size_t)(3 * l + 2) * M, DM, rep == 0 ? 1.0f : 0.0f};
                    pg8::gemm_phase<pg8::EpiResid, pg8::StaticOrder, PG8_ALIGN, PG8_SP2>(F.lds + RING_OFF, g, S, E); }
                    SEAM(pb + 6); }
            }
            const int fb = pb + 7 * f;
            if ((DBG_EN & 512) && IN(fb)) { PH_VARS(); pg8::Gemm g{XB, (const bf16*)(wl + (f ? W_GU2 : W_GU1)), M, 2 * FF, DM, DM, DM}; pg8::StaticOrder S; S.init(M, 2 * FF, F.G, (int)blockIdx.x);
                pg8::EpiSwiGLU E{HB, FF, ROWFAC(SS + (size_t)(3 * l + 2 * f) * M, 1.0f / DM)};
                for (int rep = 0; rep < REP_GEMM; ++rep) { if (REP_BAR && rep) GRID_BAR(); pg8::gemm_phase<pg8::EpiSwiGLU, pg8::StaticOrder, PG8_ALIGN, PG8_SP2>(F.lds + RING_OFF, g, S, E); }
                SEAM(fb); }
            if ((DBG_EN & 1024) && IN(fb + 1)) { PH_VARS(); pg8::Gemm g{HB, (const bf16*)(wl + (f ? W_D2 : W_D1)), M, DM, FF, FF, FF}; pg8::StaticOrder S; S.init(M, DM, F.G, (int)blockIdx.x);
                for (int rep = 0; rep < REP_RES; ++rep) { pg8::EpiResid E{XB, rep ? (unsigned long long*)(ws + WS_SSP) : SS + (size_t)(3 * l + 2 * f + 1) * M, DM, rep == 0 ? 0.5f : 0.0f};
                pg8::gemm_phase<pg8::EpiResid, pg8::StaticOrder, PG8_ALIGN, PG8_SP2>(F.lds + RING_OFF, g, S, E); }
                SEAM(fb + 1); }
        }
    }
    if ((DBG_EN & 2048) && IN(N_PHASES - 1)) { PH_VARS(); for (int m = gw; m < M; m += NGW) rms_row_out(XB + (size_t)m * DM, args.in[23], args.out + (size_t)m * DM, ln); }
#undef IN
#undef SEAM
#undef GRID_BAR
}

extern "C" void kernel_launch(void* const* d_in, const int* in_sizes, int n_in, void* d_out, int out_size, void* d_ws, size_t ws_size, hipStream_t stream) {
    static int grid = 0;
    if (grid == 0) {
        if (n_in != 24 || in_sizes[0] != M * DM || out_size != M * DM || ws_size < WS_END) {
            fprintf(stderr, "kernel_launch: built for 24 inputs, x/out of %d floats, >= %zu bytes of workspace; got n_in %d, in0 %d, out %d, ws %zu; nothing launched\n", M * DM, (size_t)WS_END, n_in, n_in > 0 ? in_sizes[0] : -1, out_size, ws_size);
            grid = -1; return; }
        int dev = 0, cus = 0, per_cu = 0;
        if (hipGetDevice(&dev) != hipSuccess || hipDeviceGetAttribute(&cus, hipDeviceAttributeMultiprocessorCount, dev) != hipSuccess) { fprintf(stderr, "kernel_launch: device query failed\n"); grid = -1; return; }
        if (hipFuncSetAttribute((const void*)trunk_fwd, hipFuncAttributeMaxDynamicSharedMemorySize, LDS_BYTES) != hipSuccess) { fprintf(stderr, "kernel_launch: hipFuncSetAttribute failed\n"); grid = -1; return; }
        if (hipOccupancyMaxActiveBlocksPerMultiprocessor(&per_cu, (const void*)trunk_fwd, NTHREADS, LDS_BYTES) != hipSuccess || per_cu < 1)
            fprintf(stderr, "kernel_launch: note: occupancy query reports %d workgroups per CU\n", per_cu);
        (void)hipGetLastError();
        if (cus != 256) { fprintf(stderr, "kernel_launch: built for a 256-CU device (the GEMM epilogues' row-factor tables assume the 256-workgroup unit deal); found %d CUs; nothing launched\n", cus); grid = -1; return; }
        grid = cus;
    }
    if (grid < 0) return;
    if (hipMemsetAsync((char*)d_ws + WS_CTL, 0, CTL_ZERO_BYTES, stream) != hipSuccess) { fprintf(stderr, "kernel_launch: memset failed\n"); return; }
    Args a{};
    for (int i = 0; i < 24; ++i) a.in[i] = (const float*)d_in[i];
    a.out = (float*)d_out; a.ws = (unsigned char*)d_ws;
#if MK_ONE_LAUNCH
    a.ph_lo = 0; a.ph_hi = N_PHASES;
    hipLaunchKernelGGL(trunk_fwd, dim3(grid), dim3(NTHREADS), LDS_BYTES, stream, a);
#else
    for (int p = 0; p < N_PHASES; ++p) { a.ph_lo = p; a.ph_hi = p + 1; hipLaunchKernelGGL(trunk_fwd, dim3(grid), dim3(NTHREADS), LDS_BYTES, stream, a); }
#endif
    const hipError_t le = hipPeekAtLastError();
    if (le != hipSuccess) fprintf(stderr, "kernel_launch: launch failed: %s\n", hipGetErrorName(le));
}
```

```cpp
#include <hip/hip_runtime.h>
#include <cstdio>
#include <cstdint>

#ifndef MK_ONE_LAUNCH
#define MK_ONE_LAUNCH 1
#endif

constexpr int BATCH = 4, SEQ = 4096, DM = 4096, DEPTH = 4, FF = 6144;
constexpr int M = BATCH * SEQ;
constexpr int NH = 16, QL = 896, KVL = 512, NOPE = 128, ROPE = 64, VH = 128, QKD = NOPE + ROPE;
constexpr int QW = NH * QKD;
constexpr int KVW = NH * (NOPE + VH);
constexpr int SSD_P = 64, SSD_H = 32, SSD_G = 8, SSD_N = 128, SSD_W = 2048, CONVD = 4096;
constexpr int INC = 7648, INCP = 7680;
constexpr int O_CQ = 0, O_CKV = 896, O_KPE = 1408, O_Z = 1472, O_XBC = 3520, O_DT = 7616;
constexpr float EPS = 1e-6f;
constexpr int NWAVES = 8, NTHREADS = NWAVES * 64;

constexpr size_t MiB = 1u << 20;
constexpr size_t WS_CTL = 0, CTL_ZERO_BYTES = 3 * MiB;
constexpr size_t WS_SS = 1 * MiB;
constexpr int N_SS = 3 * DEPTH + 1;
static_assert(WS_SS + (size_t)N_SS * M * 8 <= CTL_ZERO_BYTES, "ss arrays inside the memset region");
constexpr size_t WS_COS = 3 * MiB, WS_SIN = 5 * MiB;
constexpr size_t WS_SSQ = 7 * MiB;
constexpr size_t WS_X = 8 * MiB;
constexpr size_t WS_XN = 264 * MiB;
constexpr size_t WS_BIG = 392 * MiB;
constexpr size_t WS_SSP = 632 * MiB;
constexpr size_t WS_KPE = 676 * MiB;
constexpr size_t WS_DT = 678 * MiB;
constexpr size_t WS_XBC = 680 * MiB;
constexpr size_t WS_Q = 808 * MiB;
constexpr size_t WS_KV = 904 * MiB;
constexpr size_t WS_MIX = 1032 * MiB;
constexpr size_t WS_W = 1160 * MiB;
constexpr size_t W_GU1 = 0, W_D1 = 96 * MiB, W_IN = 144 * MiB, W_QU = 204 * MiB, W_KVU = 210 * MiB, W_O = 214 * MiB, W_GU2 = 246 * MiB, W_D2 = 342 * MiB, W_LAYER = 390 * MiB;
constexpr size_t WS_END = WS_W + DEPTH * W_LAYER;
static_assert(WS_BIG + (size_t)M * INCP * 2 <= WS_SSP && WS_SSP + (size_t)M * 64 * 4 <= WS_KPE && WS_XBC + (size_t)M * 4096 * 2 <= WS_Q && WS_Q + (size_t)M * QW * 2 <= WS_KV, "d_ws map");
constexpr int CW_TMO = 0, CW_CODE = 1, CW_BAR = 4096;

constexpr int RING_OFF = 0, RING_BYTES = 131072;
constexpr int LDSCTL_OFF = RING_BYTES, MISC_OFF = LDSCTL_OFF + 320, RSTAB_OFF = LDSCTL_OFF + 1024;
static_assert(RSTAB_OFF + 2048 * 4 <= 147456, "LDS map");
constexpr int LDS_BYTES = 147456;

#define GAS __attribute__((address_space(1)))
#define LAS __attribute__((address_space(3)))
typedef unsigned short bf16;
typedef unsigned v4u __attribute__((ext_vector_type(4)));
typedef unsigned v2u __attribute__((ext_vector_type(2)));
typedef float f32x4 __attribute__((ext_vector_type(4)));
typedef float f32x2 __attribute__((ext_vector_type(2)));
typedef float f32x16 __attribute__((ext_vector_type(16)));
typedef short bf16x8 __attribute__((ext_vector_type(8)));
typedef short s16x4 __attribute__((ext_vector_type(4)));
typedef GAS unsigned gu32;
#define RLX_AGENT __ATOMIC_RELAXED, __HIP_MEMORY_SCOPE_AGENT
#define LDS_WAIT() asm volatile("s_waitcnt lgkmcnt(0)" ::: "memory")
#define VM_WAIT() asm volatile("s_waitcnt vmcnt(0)" ::: "memory")
__device__ __forceinline__ unsigned f2bf(float f) { unsigned u = __builtin_bit_cast(unsigned, f); return (u + 0x7fffu + ((u >> 16) & 1u)) >> 16; }
__device__ __forceinline__ unsigned pk2(float lo, float hi) { return f2bf(lo) | (f2bf(hi) << 16); }
__device__ __forceinline__ float bflo(unsigned w) { return __builtin_bit_cast(float, w << 16); }
__device__ __forceinline__ float bfhi(unsigned w) { return __builtin_bit_cast(float, w & 0xffff0000u); }
__device__ __forceinline__ float bf1(bf16 b) { return __builtin_bit_cast(float, (unsigned)b << 16); }
typedef _Float16 h16x2 __attribute__((ext_vector_type(2)));
__device__ __forceinline__ unsigned pkh2(float lo, float hi) { f32x2 v = {lo, hi}; h16x2 h = __builtin_convertvector(v, h16x2); return __builtin_bit_cast(unsigned, h); }
__device__ __forceinline__ float hlo(unsigned w) { return (float)__builtin_bit_cast(h16x2, w)[0]; }
__device__ __forceinline__ float hhi(unsigned w) { return (float)__builtin_bit_cast(h16x2, w)[1]; }
__device__ __forceinline__ float wave_sum(float v) {
#pragma unroll
    for (int o = 1; o < 64; o <<= 1) v += __shfl_xor(v, o);
    return v;
}
__device__ __forceinline__ float fast_exp(float x) { return __builtin_amdgcn_exp2f(x * 1.4426950408889634f); }
__device__ __forceinline__ float silu_f(float x) { return x * __builtin_amdgcn_rcpf(1.0f + fast_exp(-x)); }
#define XB_TMO      128
#define XB_XCNT(j)  (256  + 64 * (j))
#define XB_XSUB(j)  (1280 + 64 * (j))
#define XB_XGEN(j)  (2304 + 64 * (j))
#define XB_TOP      3328
#define XB_TOPGEN   3392
#define XCD_BAR_WORDS 3456
#define XB_SPIN_CAP (1u << 18)

__device__ __forceinline__ unsigned xb_ld(unsigned* p)              { return __hip_atomic_load(p, __ATOMIC_RELAXED, __HIP_MEMORY_SCOPE_AGENT); }
__device__ __forceinline__ unsigned xb_add(unsigned* p, unsigned v) { return __hip_atomic_fetch_add(p, v, __ATOMIC_RELAXED, __HIP_MEMORY_SCOPE_AGENT); }
__device__ __forceinline__ unsigned xb_xcc_id() { return (unsigned)__builtin_amdgcn_s_getreg((3 << 11) | 20) & 0xFu; }
#define XB_SPIN(cond, bar) do { unsigned _sp = 0; while (cond) { __builtin_amdgcn_s_sleep(1); \
    if ((++_sp & 255u) == 0u) { if (xb_ld(&(bar)[XB_TMO])) break; if (_sp > XB_SPIN_CAP) { atomicAdd(&(bar)[XB_TMO], 1u); break; } } } } while (0)

struct XcdBarrier {
    unsigned* bar; unsigned x;
    volatile LAS unsigned* st;
};

__device__ __forceinline__ XcdBarrier xcd_barrier_post(unsigned* bar, volatile LAS unsigned* st) {
    XcdBarrier b; b.bar = bar; b.x = xb_xcc_id(); b.st = st;
    if (threadIdx.x == 0) (void)xb_add(&bar[XB_XCNT(b.x)], 1u);
    return b;
}
__device__ __forceinline__ void xcd_barrier_complete(unsigned* bar, unsigned x, unsigned& nloc, unsigned& nx) {
    const unsigned G = gridDim.x * gridDim.y * gridDim.z;
    unsigned sum, cnt, mine, sp = 0u;
    for (;;) {
        sum = 0u; cnt = 0u; mine = 0u;
#pragma unroll
        for (unsigned j = 0; j < 16; ++j) { const unsigned c = xb_ld(&bar[XB_XCNT(j)]); sum += c; cnt += (c > 0u) ? 1u : 0u; mine = (j == x) ? c : mine; }
        if (sum == G) break;
        __builtin_amdgcn_s_sleep(1);
        if ((++sp & 255u) == 0u) { if (xb_ld(&bar[XB_TMO])) break; if (sp > XB_SPIN_CAP) { atomicAdd(&bar[XB_TMO], 1u); break; } }
    }
    nloc = mine > 0u ? mine : 1u; nx = cnt > 0u ? cnt : 1u;
}

__device__ __forceinline__ void xcd_barrier(const XcdBarrier& b) {
    asm volatile("s_waitcnt vmcnt(0)" ::: "memory");
    __syncthreads();
    if (threadIdx.x == 0) {
        unsigned* bar = b.bar;
        __builtin_amdgcn_s_waitcnt(0);
        unsigned nloc = b.st[0], nx = b.st[1];
        if (nloc == 0u) { xcd_barrier_complete(bar, b.x, nloc, nx); b.st[0] = nloc; b.st[1] = nx; }
        const unsigned old = xb_add(&bar[XB_XSUB(b.x)], 1u);
        const unsigned gen = old / nloc;
        if (old + 1u == (gen + 1u) * nloc) {
            __builtin_amdgcn_fence(__ATOMIC_RELEASE, "agent");
            asm volatile("s_waitcnt vmcnt(0)" ::: "memory");
            const unsigned og = xb_add(&bar[XB_TOP], 1u);
            const unsigned tg = og / nx;
            if (og + 1u == (tg + 1u) * nx) xb_add(&bar[XB_TOPGEN], 1u);
            else XB_SPIN(xb_ld(&bar[XB_TOPGEN]) == tg, bar);
            __builtin_amdgcn_fence(__ATOMIC_ACQUIRE, "agent");
            xb_add(&bar[XB_XGEN(b.x)], 1u);
            asm volatile("s_waitcnt vmcnt(0)" ::: "memory");
        } else {
            XB_SPIN(xb_ld(&bar[XB_XGEN(b.x)]) == gen, bar);
            __builtin_amdgcn_fence(__ATOMIC_ACQUIRE, "agent");
            asm volatile("s_waitcnt vmcnt(0)" ::: "memory");
        }
    }
    __syncthreads();
}
namespace pg8 {
#define PG8_LAS __attribute__((address_space(3)))
typedef unsigned short bf16_t;
typedef short bf16x8 __attribute__((ext_vector_type(8)));
typedef float f32x4 __attribute__((ext_vector_type(4)));
typedef unsigned u32x4 __attribute__((ext_vector_type(4)));
typedef _Float16 h16x8 __attribute__((ext_vector_type(8)));
constexpr int BM = 256, BK = 64, HALF = 128, HTB = HALF * BK * 2  , STAGE_BYTES = 8 * HTB, NXCD = 8, WGM = 8;

__host__ __device__ __forceinline__ int lds_byte(int r, int c) { const int st = (r >> 4) * 2 + (c >> 5), rr = r & 15, cc = c & 31, ob = rr * 64 + cc * 2; return st * 1024 + (ob ^ (((ob >> 9) & 1) << 5)); }
__host__ __device__ __forceinline__ void stage_rc(int b, int& R, int& C) { const int st = b / 1024, sb = b % 1024, swz = sb ^ (((sb >> 9) & 1) << 5); R = (st >> 1) * 16 + swz / 64; C = (st & 1) * 32 + (swz % 64) / 2; }
__host__ __device__ __forceinline__ int perm32(int rho) { const int n = rho >> 4, i = rho & 15; return 8 * (i >> 2) + 4 * n + (i & 3); }

struct Unit { int pm, pn; };
struct Gemm { const bf16_t* A; const bf16_t* Bt; int M, N, K, lda, ldb; };

struct StaticOrder {
    int nM, nN, nwg, G, c;
    __host__ __device__ void init(int M, int N, int G_, int c_) { nM = M / BM; nN = N / BM; nwg = nM * nN; G = G_; c = c_; }
    __host__ __device__ bool next(int i, Unit& u) const {
        const long L = (long)i * G + c; if (L >= nwg) return false;
        int wgid = (int)L; { const int q = nwg / NXCD, r = nwg % NXCD, xcd = wgid % NXCD, off = wgid / NXCD; wgid = (xcd < r ? xcd * (q + 1) : r * (q + 1) + (xcd - r) * q) + off; }
        const int nig = WGM * nN, gid = wgid / nig, fm = gid * WGM, gsz = (nM - fm) < WGM ? (nM - fm) : WGM;
        u.pm = fm + ((wgid % nig) % gsz); u.pn = (wgid % nig) / gsz; return true;
    }
    __device__ __forceinline__ void a_ready(const Unit&) const {}
    __device__ __forceinline__ void done(const Unit&) const {}
};

__device__ __forceinline__ unsigned cvt_pk_bf16(float lo, float hi) { unsigned r; asm volatile("v_cvt_pk_bf16_f32 %0, %1, %2" : "=v"(r) : "v"(lo), "v"(hi)); return r; }

__device__ __forceinline__ float row_rstd(const unsigned long long* ss, int row, float inv_n) { return 1.0f / sqrtf((float)ss[row] * (inv_n * 9.5367431640625e-07f) + 1e-6f); }
struct RowFac { const PG8_LAS float* tab;
    __device__ __forceinline__ float get(int row) const { return tab[row]; } };
struct EpiStore {
    static constexpr bool PERM = true, AFTER_DRAIN = false;
    bf16_t* O; int ldc; RowFac rf;
    __device__ __forceinline__ void operator()(const f32x4 (&acc)[2][2][4][2], const Unit& u, int wr, int wc, int fr, int fq) const {
        const int row0 = u.pm * BM + wr * 64 + fr, col0 = u.pn * BM + wc * 32 + 8 * fq;
#pragma unroll
        for (int ai = 0; ai < 2; ++ai)
#pragma unroll
            for (int m = 0; m < 4; ++m) { const int row = row0 + ai * HALF + m * 16; bf16_t* rowp = O + (size_t)row * ldc + col0;
                const float rs = rf.get(row);
#pragma unroll
                for (int bj = 0; bj < 2; ++bj) { const f32x4 v0 = acc[ai][bj][m][0] * rs, v1 = acc[ai][bj][m][1] * rs;
                    u32x4 w; w.x = cvt_pk_bf16(v0[0], v0[1]); w.y = cvt_pk_bf16(v0[2], v0[3]); w.z = cvt_pk_bf16(v1[0], v1[1]); w.w = cvt_pk_bf16(v1[2], v1[3]);
                    *(u32x4*)(rowp + bj * HALF) = w; } }
    }
};
struct EpiSwiGLU {
    static constexpr bool PERM = true, AFTER_DRAIN = false;
    bf16_t* O; int ldc; RowFac rf;
    __device__ __forceinline__ void operator()(const f32x4 (&acc)[2][2][4][2], const Unit& u, int wr, int wc, int fr, int fq) const {
        const int row0 = u.pm * BM + wr * 64 + fr, col0 = u.pn * HALF + wc * 32 + 8 * fq;
#pragma unroll
        for (int ai = 0; ai < 2; ++ai)
#pragma unroll
            for (int m = 0; m < 4; ++m) { const int row = row0 + ai * HALF + m * 16; bf16_t* rowp = O + (size_t)row * ldc + col0;
                const float rs = rf.get(row), c1 = rs * -1.4426950408889634f, irs2 = __builtin_amdgcn_rcpf(rs * rs);
                float t[8], h[8];
#pragma unroll
                for (int n = 0; n < 2; ++n)
#pragma unroll
                    for (int i = 0; i < 4; ++i) { t[n * 4 + i] = __builtin_amdgcn_exp2f(acc[ai][0][m][n][i] * c1); h[n * 4 + i] = acc[ai][0][m][n][i] * acc[ai][1][m][n][i]; }
                __builtin_amdgcn_sched_barrier(0);
#pragma unroll
                for (int k = 0; k < 8; ++k) t[k] = __builtin_amdgcn_rcpf(__builtin_fmaf(t[k], irs2, irs2));
                __builtin_amdgcn_sched_barrier(0);
#pragma unroll
                for (int k = 0; k < 8; ++k) h[k] *= t[k];
                u32x4 w; w.x = cvt_pk_bf16(h[0], h[1]); w.y = cvt_pk_bf16(h[2], h[3]); w.z = cvt_pk_bf16(h[4], h[5]); w.w = cvt_pk_bf16(h[6], h[7]);
                *(u32x4*)rowp = w; }
    }
};
struct EpiResid {
    static constexpr bool PERM = true, AFTER_DRAIN = false;
    bf16_t* xb; unsigned long long* ssn; int ldc; float alpha;
    __device__ __forceinline__ void operator()(const f32x4 (&acc)[2][2][4][2], const Unit& u, int wr, int wc, int fr, int fq) const {
        const int row0 = u.pm * BM + wr * 64 + fr, col0 = u.pn * BM + wc * 32 + 8 * fq;
        u32x4 old[2][4][2];
#pragma unroll
        for (int ai = 0; ai < 2; ++ai)
#pragma unroll
            for (int m = 0; m < 4; ++m)
#pragma unroll
                for (int bj = 0; bj < 2; ++bj) old[ai][m][bj] = *(const u32x4*)(xb + (size_t)(row0 + ai * HALF + m * 16) * ldc + col0 + bj * HALF);
#pragma unroll
        for (int ai = 0; ai < 2; ++ai)
#pragma unroll
            for (int m = 0; m < 4; ++m) { const int row = row0 + ai * HALF + m * 16; bf16_t* rowp = xb + (size_t)row * ldc + col0; float sq = 0.f;
#pragma unroll
                for (int bj = 0; bj < 2; ++bj) { const u32x4 b = old[ai][m][bj];
                    float v[8];
#pragma unroll
                    for (int e = 0; e < 4; ++e) { v[2 * e] = __builtin_bit_cast(float, b[e] << 16) + acc[ai][bj][m][e >> 1][2 * (e & 1)] * alpha;
                                                  v[2 * e + 1] = __builtin_bit_cast(float, b[e] & 0xffff0000u) + acc[ai][bj][m][e >> 1][2 * (e & 1) + 1] * alpha; }
#pragma unroll
                    for (int e = 0; e < 8; ++e) sq += v[e] * v[e];
                    u32x4 w; w.x = cvt_pk_bf16(v[0], v[1]); w.y = cvt_pk_bf16(v[2], v[3]); w.z = cvt_pk_bf16(v[4], v[5]); w.w = cvt_pk_bf16(v[6], v[7]);
                    *(u32x4*)(rowp + bj * HALF) = w; }
                sq += __shfl_xor(sq, 16); sq += __shfl_xor(sq, 32);
                if (fq == 0) __hip_atomic_fetch_add(ssn + row, (unsigned long long)(sq * 1048576.0f + 0.5f), __ATOMIC_RELAXED, __HIP_MEMORY_SCOPE_AGENT); }
    }
};

template <class Epi, class Sched, bool ALIGN_EPI = false, bool SP2 = false, bool F16 = false>
__device__ __forceinline__ void gemm_phase(PG8_LAS unsigned char* lds, const Gemm g, const Sched& S, const Epi& E) {
    __builtin_amdgcn_s_waitcnt(0);
    int tid_l = threadIdx.x; asm volatile("" : "+v"(tid_l));
    const int tid = tid_l, wid = __builtin_amdgcn_readfirstlane(tid >> 6), lane = tid & 63, wr = wid >> 2, wc = wid & 3, fr = lane & 15, fq = lane >> 4;
    const int K = g.K, nt = K / BK, lda = g.lda, ldb = g.ldb;
    unsigned voffA[2], voffB[2];
#pragma unroll
    for (int i = 0; i < 2; ++i) { int R, C; stage_rc(tid * 16 + i * 8192, R, C); const int Rb = Epi::PERM ? ((R & ~31) + perm32(R & 31)) : R;
        voffA[i] = (unsigned)(R * lda + C) * 2u; voffB[i] = (unsigned)(Rb * ldb + C) * 2u; }
    const size_t kstep = (size_t)(BK * 2);
    const size_t hstepA = (size_t)HALF * lda * 2, hstepB = (size_t)HALF * ldb * 2;
    const size_t tstepA = 2 * hstepA, tstepB = 2 * hstepB;
    const unsigned ldsw = (unsigned)wid * 1024u;
    const int aoff = lds_byte(wr * 64 + fr, fq * 8), boff = lds_byte(wc * 32 + fr, fq * 8);
#define PG8_SA(b, h) (((b) * 2 + (h)) * HTB)
#define PG8_SB(b, h) ((4 + (b) * 2 + (h)) * HTB)
#define PG8_STAGE(bufoff, gbase, voff) do { _Pragma("unroll") for (int _i = 0; _i < 2; ++_i) \
        __builtin_amdgcn_global_load_lds((const unsigned*)((const char*)(gbase) + (voff)[_i]), (PG8_LAS unsigned*)(lds + (bufoff) + ldsw + _i * 8192), 16, 0, 0); } while (0)
#define PG8_LDA(dst, b, h) do { _Pragma("unroll") for (int m = 0; m < 4; ++m) _Pragma("unroll") for (int k = 0; k < 2; ++k) dst[m][k] = *(const PG8_LAS bf16x8*)(lds + PG8_SA(b, h) + aoff + m * 2048 + k * 1024); } while (0)
#define PG8_LDB(dst, b, h) do { _Pragma("unroll") for (int n = 0; n < 2; ++n) _Pragma("unroll") for (int k = 0; k < 2; ++k) dst[n][k] = *(const PG8_LAS bf16x8*)(lds + PG8_SB(b, h) + boff + n * 2048 + k * 1024); } while (0)
#define PG8_MMA(ai, bj, At, Bt) do { __builtin_amdgcn_s_setprio(1); _Pragma("unroll") for (int m = 0; m < 4; ++m) _Pragma("unroll") for (int n = 0; n < 2; ++n) _Pragma("unroll") for (int k = 0; k < 2; ++k) \
        acc[ai][bj][m][n] = F16 ? __builtin_amdgcn_mfma_f32_16x16x32_f16(__builtin_bit_cast(h16x8, Bt[n][k]), __builtin_bit_cast(h16x8, At[m][k]), acc[ai][bj][m][n], 0, 0, 0) \
                                : __builtin_amdgcn_mfma_f32_16x16x32_bf16(Bt[n][k], At[m][k], acc[ai][bj][m][n], 0, 0, 0); __builtin_amdgcn_s_setprio(0); } while (0)
#define PG8_WAIT_V(n) asm volatile("s_waitcnt vmcnt(" #n ")" ::: "memory")
#define PG8_WAIT_L(n) asm volatile("s_waitcnt lgkmcnt(" #n ")" ::: "memory")
#define PG8_BAR __builtin_amdgcn_s_barrier()
#define PG8_SCHED __builtin_amdgcn_sched_barrier(0)
    Unit cur, nxt; int ui = 0;
    if (!S.next(0, cur)) return;
    f32x4 acc[2][2][4][2];
#pragma unroll
    for (int a = 0; a < 2; ++a)
#pragma unroll
        for (int b = 0; b < 2; ++b)
#pragma unroll
            for (int m = 0; m < 4; ++m)
#pragma unroll
                for (int n = 0; n < 2; ++n) acc[a][b][m][n] = (f32x4){0.f, 0.f, 0.f, 0.f};
    bf16x8 At[4][2], B0[2][2], B1[2][2];
    const char* cA = (const char*)g.A + (size_t)cur.pm * tstepA; const char* cB = (const char*)g.Bt + (size_t)cur.pn * tstepB;
    S.a_ready(cur);
    if constexpr (SP2) {
        PG8_STAGE(PG8_SB(0, 0), cB, voffB); PG8_STAGE(PG8_SB(0, 1), cB + hstepB, voffB); PG8_STAGE(PG8_SA(0, 0), cA, voffA); PG8_STAGE(PG8_SA(0, 1), cA + hstepA, voffA);
        if (wr == 1) PG8_BAR;
        PG8_WAIT_V(2); PG8_BAR;
        PG8_STAGE(PG8_SB(1, 0), cB + kstep, voffB); PG8_STAGE(PG8_SA(1, 0), cA + kstep, voffA); PG8_STAGE(PG8_SB(1, 1), cB + hstepB + kstep, voffB);
        PG8_WAIT_V(6); PG8_BAR;
    } else {
        PG8_STAGE(PG8_SB(0, 0), cB, voffB); PG8_STAGE(PG8_SA(0, 0), cA, voffA); PG8_STAGE(PG8_SB(0, 1), cB + hstepB, voffB); PG8_STAGE(PG8_SA(0, 1), cA + hstepA, voffA);
        if (wr == 1) PG8_BAR;
        PG8_WAIT_V(4); PG8_BAR;
        PG8_STAGE(PG8_SB(1, 0), cB + kstep, voffB); PG8_STAGE(PG8_SA(1, 0), cA + kstep, voffA); PG8_STAGE(PG8_SB(1, 1), cB + hstepB + kstep, voffB);
        PG8_WAIT_V(6); PG8_BAR;
    }
    for (;;) {
        const bool has_next = S.next(ui + 1, nxt);
        const char* nA = has_next ? (const char*)g.A + (size_t)nxt.pm * tstepA : cA; const char* nB = has_next ? (const char*)g.Bt + (size_t)nxt.pn * tstepB : cB;
        for (int t = 0; t < nt; t += 2) {
            const bool last = (t == nt - 2);
            const char* a1 = cA + (size_t)(t + 1) * kstep;
            const char* a2 = last ? nA : cA + (size_t)(t + 2) * kstep; const char* b2 = last ? nB : cB + (size_t)(t + 2) * kstep;
            const char* a3 = a2 + kstep; const char* b3 = b2 + kstep;
            if (last && has_next) S.a_ready(nxt);
            if constexpr (SP2) {
            PG8_LDB(B0, 0, 0); PG8_LDB(B1, 0, 1); PG8_SCHED; PG8_LDA(At, 0, 0); PG8_STAGE(PG8_SA(1, 1), a1 + hstepA, voffA);
            PG8_WAIT_V(8); PG8_WAIT_L(0); PG8_BAR; PG8_MMA(0, 0, At, B0); PG8_MMA(0, 1, At, B1); PG8_BAR; PG8_SCHED;
            PG8_LDA(At, 0, 1); PG8_STAGE(PG8_SB(0, 0), b2, voffB); PG8_STAGE(PG8_SB(0, 1), b2 + hstepB, voffB); PG8_STAGE(PG8_SA(0, 0), a2, voffA);
            PG8_WAIT_V(8); PG8_WAIT_L(0); PG8_BAR; PG8_MMA(1, 0, At, B0); PG8_MMA(1, 1, At, B1); PG8_BAR; PG8_SCHED;
            PG8_LDB(B0, 1, 0); PG8_LDB(B1, 1, 1); PG8_SCHED; PG8_LDA(At, 1, 0); PG8_STAGE(PG8_SA(0, 1), a2 + hstepA, voffA);
            PG8_WAIT_V(8); PG8_WAIT_L(0); PG8_BAR; PG8_MMA(0, 0, At, B0); PG8_MMA(0, 1, At, B1); PG8_BAR; PG8_SCHED;
            PG8_LDA(At, 1, 1); PG8_STAGE(PG8_SB(1, 0), b3, voffB); PG8_STAGE(PG8_SB(1, 1), b3 + hstepB, voffB); PG8_STAGE(PG8_SA(1, 0), a3, voffA);
            PG8_WAIT_V(8); PG8_WAIT_L(0); PG8_BAR; PG8_MMA(1, 0, At, B0); PG8_MMA(1, 1, At, B1); PG8_BAR; PG8_SCHED;
            } else {
            PG8_LDB(B0, 0, 0); PG8_SCHED; PG8_LDA(At, 0, 0); PG8_STAGE(PG8_SA(1, 1), a1 + hstepA, voffA);
            PG8_WAIT_L(8); PG8_BAR; PG8_WAIT_L(0); PG8_MMA(0, 0, At, B0); PG8_BAR; PG8_SCHED;
            PG8_LDB(B1, 0, 1); PG8_STAGE(PG8_SB(0, 0), b2, voffB);
            PG8_BAR; PG8_WAIT_L(0); PG8_MMA(0, 1, At, B1); PG8_BAR;
            PG8_LDA(At, 0, 1); PG8_STAGE(PG8_SA(0, 0), a2, voffA);
            PG8_BAR; PG8_WAIT_L(0); PG8_MMA(1, 0, At, B0); PG8_BAR; PG8_SCHED;
            PG8_STAGE(PG8_SB(0, 1), b2 + hstepB, voffB);
            PG8_WAIT_V(6); PG8_BAR; PG8_MMA(1, 1, At, B1); PG8_BAR;
            PG8_LDB(B0, 1, 0); PG8_SCHED; PG8_LDA(At, 1, 0); PG8_STAGE(PG8_SA(0, 1), a2 + hstepA, voffA);
            PG8_WAIT_L(8); PG8_BAR; PG8_WAIT_L(0); PG8_MMA(0, 0, At, B0); PG8_BAR; PG8_SCHED;
            PG8_LDB(B1, 1, 1); PG8_STAGE(PG8_SB(1, 0), b3, voffB);
            PG8_BAR; PG8_WAIT_L(0); PG8_MMA(0, 1, At, B1); PG8_BAR;
            PG8_LDA(At, 1, 1); PG8_STAGE(PG8_SA(1, 0), a3, voffA);
            PG8_BAR; PG8_WAIT_L(0); PG8_MMA(1, 0, At, B0); PG8_BAR; PG8_SCHED;
            PG8_STAGE(PG8_SB(1, 1), b3 + hstepB, voffB);
            PG8_WAIT_V(6); PG8_BAR; PG8_MMA(1, 1, At, B1); PG8_BAR;
            }
        }
        if constexpr (ALIGN_EPI) { if (wr == 0) PG8_BAR; }
        if constexpr (!Epi::AFTER_DRAIN) { E(acc, cur, wr, wc, fr, fq); S.done(cur); }
        if (!has_next) break;
#pragma unroll
        for (int a = 0; a < 2; ++a)
#pragma unroll
            for (int b = 0; b < 2; ++b)
#pragma unroll
                for (int m = 0; m < 4; ++m)
#pragma unroll
                    for (int n = 0; n < 2; ++n) acc[a][b][m][n] = (f32x4){0.f, 0.f, 0.f, 0.f};
        cur = nxt; cA = nA; cB = nB; ++ui;
        if constexpr (ALIGN_EPI) { if (wr == 1) PG8_BAR; }
    }
    PG8_WAIT_V(0);
    if constexpr (!ALIGN_EPI) { if (wr == 0) PG8_BAR; }
    PG8_BAR;
    if constexpr (Epi::AFTER_DRAIN) { E.fused(acc, cur, wr, wc, fr, fq, lds, wid, lane); S.done(cur); }
#undef PG8_SA
#undef PG8_SB
#undef PG8_STAGE
#undef PG8_LDA
#undef PG8_LDB
#undef PG8_MMA
#undef PG8_WAIT_V
#undef PG8_WAIT_L
#undef PG8_BAR
#undef PG8_SCHED
}
}
#ifndef PG8_SP2
#define PG8_SP2 true
#endif
#ifndef PG8_ALIGN
#define PG8_ALIGN true
#endif
namespace att {
constexpr int KSTR = 400, VSTR = 320;
constexpr int KBUF = 64 * KSTR, VBUF = 64 * VSTR;
constexpr int OFF_K = 0, OFF_V = 2 * KBUF, OFF_WS = OFF_V + 2 * VBUF, LDS_NEED = OFF_WS + NWAVES * 256;
constexpr float C2 = 0.07216878364870322f * 1.4426950408889634f;
static_assert(LDS_NEED <= RING_BYTES, "attention LDS");
typedef float f32x2_t __attribute__((ext_vector_type(2))); typedef __bf16 bf16x2_t __attribute__((ext_vector_type(2)));
typedef short v4i16_t __attribute__((ext_vector_type(4)));
__device__ __forceinline__ unsigned cvtpk(float lo, float hi) { f32x2_t v = {lo, hi}; bf16x2_t b = __builtin_convertvector(v, bf16x2_t); return __builtin_bit_cast(unsigned, b); }
__device__ __forceinline__ s16x4 trd(const LAS unsigned char* p) { return __builtin_bit_cast(s16x4, __builtin_amdgcn_ds_read_tr16_b64_v4i16((LAS v4i16_t*)p)); }
__device__ __forceinline__ int crow(int r, int hi) { return (r & 3) + 8 * (r >> 2) + 4 * hi; }
#define ATT_MFMA(a, b, c) __builtin_amdgcn_mfma_f32_32x32x16_bf16((a), (b), (c), 0, 0, 0)

__device__ __forceinline__ void attn_block(int b, int h, int qb, const bf16* __restrict__ Q, const bf16* __restrict__ KV, const bf16* __restrict__ KPE, const float* __restrict__ cosT, const float* __restrict__ sinT, bf16* __restrict__ MIXo, LAS unsigned char* lds) {
    int tid_l = threadIdx.x; asm volatile("" : "+v"(tid_l));
    const int tid = tid_l, lane = tid & 63, c = lane & 31, hi = lane >> 5;
    const int wid = __builtin_amdgcn_readfirstlane(tid >> 6);
    const size_t rowbase = (size_t)b * SEQ; const int q0 = qb * 256, qlo = q0 + wid * 32;
    const int NT = 4 * qb + 4;
    const bf16* qrow = Q + (rowbase + qlo + c) * QW + h * QKD + 8 * hi;
    bf16x8 qr[12];
#pragma unroll
    for (int d = 0; d < 12; ++d) qr[d] = *(const bf16x8*)(qrow + 16 * d);
    {
        const float* ct = cosT + (rowbase + qlo + c) * 32 + 4 * hi; const float* st = sinT + (rowbase + qlo + c) * 32 + 4 * hi;
#pragma unroll
        for (int dd = 0; dd < 4; ++dd) { const f32x4 cs = *(const f32x4*)(ct + 8 * dd), sn = *(const f32x4*)(st + 8 * dd);
            v4u w = __builtin_bit_cast(v4u, qr[8 + dd]);
#pragma unroll
            for (int e = 0; e < 4; ++e) { const float x1 = bflo(w[e]), x2 = bfhi(w[e]); w[e] = cvtpk(x1 * cs[e] - x2 * sn[e], x2 * cs[e] + x1 * sn[e]); }
            qr[8 + dd] = __builtin_bit_cast(bf16x8, w); }
    }
    const int kkey = tid >> 4, kch = tid & 15, pkey = tid >> 3, pch = tid & 7;
    const bf16* gk = KV + (rowbase + kkey) * KVW + h * 256 + kch * 8;
    const bf16* gv = gk + 128;
    const bf16* gp = KPE + (rowbase + pkey) * 64 + pch * 8;
    const int lk0 = kkey * KSTR + kch * 16, lk1 = lk0 + 32 * KSTR, lp = pkey * KSTR + 256 + pch * 16;
    const int lv0 = kkey * VSTR + kch * 16, lv1 = lv0 + 32 * VSTR;
    v4u sk0, sk1, sp, sv0, sv1;
#define ATT_LOAD(t) do { const size_t o_ = (size_t)(t) * 64 * KVW; sk0 = *(const v4u*)(gk + o_); sk1 = *(const v4u*)(gk + o_ + 32 * KVW); \
        sv0 = *(const v4u*)(gv + o_); sv1 = *(const v4u*)(gv + o_ + 32 * KVW); sp = *(const v4u*)(gp + (size_t)(t) * 64 * 64); } while (0)
#define ATT_WRITE(bi) do { LAS unsigned char* kb_ = lds + OFF_K + (bi) * KBUF; LAS unsigned char* vb_ = lds + OFF_V + (bi) * VBUF; \
        *(LAS v4u*)(kb_ + lk0) = sk0; *(LAS v4u*)(kb_ + lk1) = sk1; *(LAS v4u*)(kb_ + lp) = sp; *(LAS v4u*)(vb_ + lv0) = sv0; *(LAS v4u*)(vb_ + lv1) = sv1; } while (0)
    LAS float* wsf = (LAS float*)(lds + OFF_WS) + wid * 64;
    float m_run = -1e30f, l_run = 0.f;
    f32x16 o[4];
#pragma unroll
    for (int d0 = 0; d0 < 4; ++d0)
#pragma unroll
        for (int r = 0; r < 16; ++r) o[d0][r] = 0.f;
    const int i16 = lane & 15, qq = i16 >> 2, pp = i16 & 3, blk = (lane >> 4) & 1;
    const int voff = (4 * hi + qq) * VSTR + 32 * blk + 8 * pp;
    const int koff = c * KSTR + hi * 16;
    ATT_LOAD(0); ATT_WRITE(0); __syncthreads();
    for (int t = 0; t < NT; ++t) {
        const int cur = t & 1, kb0 = 64 * t;
        if (t + 1 < NT) ATT_LOAD(t + 1);
        if (kb0 <= qlo + 31) {
            f32x16 p0, p1;
#pragma unroll
            for (int r = 0; r < 16; ++r) { p0[r] = 0.f; p1[r] = 0.f; }
            const LAS unsigned char* kp = lds + OFF_K + cur * KBUF + koff;
#pragma unroll
            for (int dg = 0; dg < 3; ++dg) {
                bf16x8 k0[4], k1[4];
#pragma unroll
                for (int j = 0; j < 4; ++j) { k0[j] = *(const LAS bf16x8*)(kp + (4 * dg + j) * 32); k1[j] = *(const LAS bf16x8*)(kp + 32 * KSTR + (4 * dg + j) * 32); }
                __builtin_amdgcn_sched_barrier(0);
#pragma unroll
                for (int j = 0; j < 4; ++j) { p0 = ATT_MFMA(k0[j], qr[4 * dg + j], p0); p1 = ATT_MFMA(k1[j], qr[4 * dg + j], p1); }
            }
            if (kb0 + 63 > qlo) {
                const int dq = qlo + c - kb0 - 4 * hi; const float NEG = -__builtin_inff();
#pragma unroll
                for (int r = 0; r < 16; ++r) { const int cr = (r & 3) + 8 * (r >> 2); if (cr > dq) p0[r] = NEG; if (cr + 32 > dq) p1[r] = NEG; }
            }
            float mx = p0[0];
#pragma unroll
            for (int r = 1; r < 16; ++r) mx = fmaxf(mx, p0[r]);
#pragma unroll
            for (int r = 0; r < 16; ++r) mx = fmaxf(mx, p1[r]);
            mx = fmaxf(mx, __shfl_xor(mx, 32));
            float mn = m_run, alpha = 1.0f;
            if (!__all((mx - m_run) * C2 <= 6.0f)) { mn = fmaxf(m_run, mx); alpha = __builtin_amdgcn_exp2f((m_run - mn) * C2); m_run = mn; }
            const float mnc = mn * C2;
            float rs = 0.f;
#pragma unroll
            for (int r = 0; r < 16; ++r) { p0[r] = __builtin_amdgcn_exp2f(p0[r] * C2 - mnc); p1[r] = __builtin_amdgcn_exp2f(p1[r] * C2 - mnc); rs += p0[r] + p1[r]; }
            rs += __shfl_xor(rs, 32);
            l_run = l_run * alpha + rs;
            if (__any(alpha < 1.0f)) {
                if (hi == 0) wsf[c] = alpha;
                LDS_WAIT();
#pragma unroll
                for (int r = 0; r < 16; ++r) { const float a = wsf[crow(r, hi)];
#pragma unroll
                    for (int d0 = 0; d0 < 4; ++d0) o[d0][r] *= a; }
            }
            const LAS unsigned char* vp = lds + OFF_V + cur * VBUF + voff;
#pragma unroll
            for (int kb = 0; kb < 2; ++kb)
#pragma unroll
                for (int s = 0; s < 2; ++s) {
                    v4u pw;
                    if (kb == 0) { pw.x = cvtpk(p0[8 * s + 0], p0[8 * s + 1]); pw.y = cvtpk(p0[8 * s + 2], p0[8 * s + 3]); pw.z = cvtpk(p0[8 * s + 4], p0[8 * s + 5]); pw.w = cvtpk(p0[8 * s + 6], p0[8 * s + 7]); }
                    else         { pw.x = cvtpk(p1[8 * s + 0], p1[8 * s + 1]); pw.y = cvtpk(p1[8 * s + 2], p1[8 * s + 3]); pw.z = cvtpk(p1[8 * s + 4], p1[8 * s + 5]); pw.w = cvtpk(p1[8 * s + 6], p1[8 * s + 7]); }
                    const bf16x8 pa = __builtin_bit_cast(bf16x8, pw);
                    s16x4 lo[4], hh[4];
#pragma unroll
                    for (int d0 = 0; d0 < 4; ++d0) { lo[d0] = trd(vp + (32 * kb + 16 * s) * VSTR + 64 * d0); hh[d0] = trd(vp + (32 * kb + 16 * s + 8) * VSTR + 64 * d0); }
                    __builtin_amdgcn_sched_barrier(0);
#pragma unroll
                    for (int d0 = 0; d0 < 4; ++d0) o[d0] = ATT_MFMA(pa, __builtin_shufflevector(lo[d0], hh[d0], 0, 1, 2, 3, 4, 5, 6, 7), o[d0]);
                }
        }
        if (t + 1 < NT) ATT_WRITE(cur ^ 1);
        __syncthreads();
    }
    if (hi == 0) wsf[32 + c] = l_run;
    LDS_WAIT();
    bf16* ob = MIXo + (rowbase + qlo) * 4096 + h * 128 + c;
#pragma unroll
    for (int r = 0; r < 16; ++r) { const int orow = crow(r, hi); const float rl = 1.0f / wsf[32 + orow];
#pragma unroll
        for (int d0 = 0; d0 < 4; ++d0) { const float v = o[d0][r] * rl, vn = __shfl_xor(v, 1);
            if ((c & 1) == 0) *(unsigned*)(ob + (size_t)orow * 4096 + d0 * 32) = pk2(v, vn); } }
    LDS_WAIT();
#undef ATT_LOAD
#undef ATT_WRITE
}
}
namespace ssd {
constexpr int RS = 272;
constexpr int BUF = 128 * RS + 128 * 64 + 2560;
constexpr int OFF_X = 128 * RS, OFF_SC = OFF_X + 128 * 64, OFF_S = 2 * BUF;
constexpr int SC_ACS = 0, SC_DT = 512, SC_ECS = 1024, SC_WEND = 1536, SC_ETOT = 2048, LDS_NEED = OFF_S + 2 * 32 * RS;
static_assert(LDS_NEED <= RING_BYTES && BUF % 16 == 0, "ssd LDS");
constexpr float LOG2E = 1.4426950408889634f;
#define SSD_MFMA(a, b, c) __builtin_amdgcn_mfma_f32_32x32x16_bf16((a), (b), (c), 0, 0, 0)
#define SSD_BAR() do { asm volatile("s_waitcnt lgkmcnt(0)" ::: "memory"); __builtin_amdgcn_s_barrier(); asm volatile("" ::: "memory"); } while (0)

__device__ __forceinline__ void ssd_unit(int unit, const bf16* __restrict__ XBC, const float* __restrict__ DT, const bf16* __restrict__ PROJ, const float* a_log, const float* d_skip,
                                         bf16* __restrict__ MIXo, LAS unsigned char* lds) {
    int tid_l = threadIdx.x; asm volatile("" : "+v"(tid_l));
    const int tid = tid_l, lane = tid & 63, c = lane & 31, hi = lane >> 5;
    const int wid = __builtin_amdgcn_readfirstlane(tid >> 6);
    const int b = unit >> 6, h = (unit >> 1) & 31, ph = unit & 1, g = h >> 2, pcol0 = h * 64 + 32 * ph;
    const float A2 = -expf(a_log[h]) * LOG2E, Dk = d_skip[h];
    const size_t mb = (size_t)b * SEQ;
    LAS unsigned char* Ss = lds + OFF_S;
    const int srow = tid >> 4, sch = tid & 15, xrow = tid >> 2, xch = tid & 3;
    const bf16* gB = XBC + (mb + srow) * 4096 + 2048 + g * 128 + sch * 8;
    const bf16* gX = XBC + (mb + xrow) * 4096 + pcol0 + xch * 8;
    const float* gD = DT + (mb + 2 * lane) * 32 + h;
    const bf16* gCf = XBC + (mb + 32 * (wid & 3) + c) * 4096 + 3072 + g * 128 + 8 * hi;
    const int lcb = srow * RS + sch * 16, lx = OFF_X + xrow * 64 + xch * 16;
    v4u sb0, sb1, sb2, sb3, sx; float sd0 = 0.f, sd1 = 0.f;
#define SSD_LOAD(ch) do { const size_t o_ = (size_t)(ch) * 128 * 4096; \
        sb0 = *(const v4u*)(gB + o_); sb1 = *(const v4u*)(gB + o_ + 32 * 4096); sb2 = *(const v4u*)(gB + o_ + 64 * 4096); sb3 = *(const v4u*)(gB + o_ + 96 * 4096); \
        sx = *(const v4u*)(gX + o_); if (wid == 0) { sd0 = gD[(size_t)(ch) * 128 * 32]; sd1 = gD[(size_t)(ch) * 128 * 32 + 32]; } } while (0)
#define SSD_WRITE(bufp) do { LAS unsigned char* wb_ = (bufp); \
        *(LAS v4u*)(wb_ + lcb) = sb0; *(LAS v4u*)(wb_ + lcb + 32 * RS) = sb1; *(LAS v4u*)(wb_ + lcb + 64 * RS) = sb2; *(LAS v4u*)(wb_ + lcb + 96 * RS) = sb3; \
        *(LAS v4u*)(wb_ + lx) = sx; \
        if (wid == 0) {     \
            LAS float* sc_ = (LAS float*)(wb_ + OFF_SC); \
            const float a0_ = sd0 * A2, a1_ = sd1 * A2, pr_ = a0_ + a1_; float inc_ = pr_; \
            _Pragma("unroll") for (int o_ = 1; o_ < 64; o_ <<= 1) { const float v_ = __shfl_up(inc_, o_); if (lane >= o_) inc_ += v_; } \
            const float cs0_ = inc_ - pr_ + a0_, cs1_ = inc_, tot_ = __shfl(inc_, 63); \
            *(LAS f32x2*)(sc_ + SC_ACS / 4 + 2 * lane) = (f32x2){cs0_, cs1_}; *(LAS f32x2*)(sc_ + SC_DT / 4 + 2 * lane) = (f32x2){sd0, sd1}; \
            *(LAS f32x2*)(sc_ + SC_ECS / 4 + 2 * lane) = (f32x2){__builtin_amdgcn_exp2f(cs0_), __builtin_amdgcn_exp2f(cs1_)}; \
            *(LAS f32x2*)(sc_ + SC_WEND / 4 + 2 * lane) = (f32x2){sd0 * __builtin_amdgcn_exp2f(tot_ - cs0_), sd1 * __builtin_amdgcn_exp2f(tot_ - cs1_)}; \
            if (lane == 63) sc_[SC_ETOT / 4] = __builtin_amdgcn_exp2f(tot_); } } while (0)
    const int i16 = lane & 15, qq = i16 >> 2, pp = i16 & 3, blk = (lane >> 4) & 1;
    f32x16 ST;
#pragma unroll
    for (int r = 0; r < 16; ++r) ST[r] = 0.f;
    bf16x8 cfn[8];
#pragma unroll
    for (int ks = 0; ks < 8; ++ks) cfn[ks] = *(const bf16x8*)(gCf + 16 * ks);
    SSD_LOAD(0); SSD_WRITE(lds);
    for (int i = tid; i < (32 * RS) / 16; i += NTHREADS) *(LAS v4u*)(Ss + i * 16) = (v4u){0u, 0u, 0u, 0u};
    SSD_BAR();
    for (int ch = 0; ch < SEQ / 128; ++ch) {
        const int chn = ch + 1 < SEQ / 128 ? ch + 1 : ch;
        SSD_LOAD(chn);
        const size_t m0 = mb + (size_t)ch * 128;
        LAS unsigned char* cb = lds + (ch & 1) * BUF;
        LAS unsigned char* Bs = cb; LAS unsigned char* Xs = cb + OFF_X;
        LAS float* acs = (LAS float*)(cb + OFF_SC + SC_ACS); LAS float* dtv = (LAS float*)(cb + OFF_SC + SC_DT); LAS float* ecs = (LAS float*)(cb + OFF_SC + SC_ECS);
        LAS float* wend = (LAS float*)(cb + OFF_SC + SC_WEND); LAS float* etot = (LAS float*)(cb + OFF_SC + SC_ETOT);
        if (wid < 4) {
            const int lb = wid;
            unsigned short zr[16];
            { const bf16* zp = PROJ + (m0 + 32 * lb + 4 * hi) * INCP + O_Z + pcol0 + c;
#pragma unroll
              for (int r = 0; r < 16; ++r) zr[r] = zp[(size_t)((r & 3) + 8 * (r >> 2)) * INCP]; }
            bf16x8 cf[8];
#pragma unroll
            for (int ks = 0; ks < 8; ++ks) cf[ks] = cfn[ks];
#pragma unroll
            for (int ks = 0; ks < 8; ++ks) cfn[ks] = *(const bf16x8*)(gCf + (size_t)chn * 128 * 4096 + 16 * ks);
            f32x16 y;
#pragma unroll
            for (int r = 0; r < 16; ++r) y[r] = 0.f;
            { const LAS unsigned char* sp = Ss + (ch & 1) * 32 * RS + c * RS + hi * 16; bf16x8 sf[8];
#pragma unroll
              for (int ks = 0; ks < 8; ++ks) sf[ks] = *(const LAS bf16x8*)(sp + ks * 32);
              __builtin_amdgcn_sched_barrier(0);
#pragma unroll
              for (int ks = 0; ks < 8; ++ks) y = SSD_MFMA(cf[ks], sf[ks], y); }
#pragma unroll
            for (int g4 = 0; g4 < 4; ++g4) { const f32x4 e = *(const LAS f32x4*)(ecs + 32 * lb + 8 * g4 + 4 * hi);
#pragma unroll
                for (int i = 0; i < 4; ++i) y[4 * g4 + i] *= e[i]; }
            const float acl = acs[32 * lb + c];
            for (int sb = 0; sb <= lb; ++sb) {
                f32x16 gt;
#pragma unroll
                for (int r = 0; r < 16; ++r) gt[r] = 0.f;
                const LAS unsigned char* bp = Bs + (32 * sb + c) * RS + hi * 16;
                const LAS unsigned char* xp0 = Xs + (32 * sb + 4 * hi + qq) * 64 + (16 * blk + 4 * pp) * 2;
                const s16x4 xl0 = att::trd(xp0), xh0 = att::trd(xp0 + 8 * 64), xl1 = att::trd(xp0 + 16 * 64), xh1 = att::trd(xp0 + 24 * 64);
#pragma unroll
                for (int kg = 0; kg < 2; ++kg) { bf16x8 bfr[4];
#pragma unroll
                    for (int k4 = 0; k4 < 4; ++k4) bfr[k4] = *(const LAS bf16x8*)(bp + (4 * kg + k4) * 32);
                    __builtin_amdgcn_sched_barrier(0);
#pragma unroll
                    for (int k4 = 0; k4 < 4; ++k4) gt = SSD_MFMA(bfr[k4], cf[4 * kg + k4], gt); }
                const int dl = 32 * (lb - sb) + c - 4 * hi;
#pragma unroll
                for (int gh = 0; gh < 2; ++gh) { f32x4 as4[2], ds4[2];
#pragma unroll
                    for (int g2 = 0; g2 < 2; ++g2) { as4[g2] = *(const LAS f32x4*)(acs + 32 * sb + 8 * (2 * gh + g2) + 4 * hi); ds4[g2] = *(const LAS f32x4*)(dtv + 32 * sb + 8 * (2 * gh + g2) + 4 * hi); }
#pragma unroll
                    for (int g2 = 0; g2 < 2; ++g2) { const int g4 = 2 * gh + g2;
#pragma unroll
                        for (int i = 0; i < 4; ++i) { const float w = __builtin_amdgcn_exp2f(fminf(acl - as4[g2][i], 0.f)) * ds4[g2][i]; gt[4 * g4 + i] = (8 * g4 + i <= dl) ? gt[4 * g4 + i] * w : 0.f; } } }
#pragma unroll
                for (int s2 = 0; s2 < 2; ++s2) {
                    v4u pw; pw.x = att::cvtpk(gt[8 * s2 + 0], gt[8 * s2 + 1]); pw.y = att::cvtpk(gt[8 * s2 + 2], gt[8 * s2 + 3]); pw.z = att::cvtpk(gt[8 * s2 + 4], gt[8 * s2 + 5]); pw.w = att::cvtpk(gt[8 * s2 + 6], gt[8 * s2 + 7]);
                    const s16x4 lo = s2 ? xl1 : xl0, hh = s2 ? xh1 : xh0;
                    y = SSD_MFMA(__builtin_bit_cast(bf16x8, pw), __builtin_shufflevector(lo, hh, 0, 1, 2, 3, 4, 5, 6, 7), y);
                }
            }
            bf16* op = MIXo + (m0 + 32 * lb + 4 * hi) * 4096 + 2048 + pcol0 + c;
            const LAS unsigned short* xl = (const LAS unsigned short*)(Xs + (32 * lb + 4 * hi) * 64 + 2 * c);
            unsigned short xr[16];
#pragma unroll
            for (int r = 0; r < 16; ++r) xr[r] = xl[((r & 3) + 8 * (r >> 2)) * 32];
            __builtin_amdgcn_sched_barrier(0);
#pragma unroll
            for (int r = 0; r < 16; ++r) { const int lr = (r & 3) + 8 * (r >> 2);
                const float v = (y[r] + Dk * bf1(xr[r])) * silu_f(bf1(zr[r]));
                op[(size_t)lr * 4096] = (bf16)f2bf(v); }
        } else {
            const int nb = wid - 4;
            const float et = etot[0];
#pragma unroll
            for (int r = 0; r < 16; ++r) ST[r] *= et;
            const LAS unsigned char* ap = Bs + (8 * hi + qq) * RS + (32 * nb + 16 * blk + 4 * pp) * 2;
            const LAS unsigned char* xp = Xs + (8 * hi + qq) * 64 + (16 * blk + 4 * pp) * 2;
#pragma unroll
            for (int kg = 0; kg < 2; ++kg) {
                s16x4 alo[4], ahh[4], xlo[4], xhh[4]; f32x4 w0[4], w1[4];
#pragma unroll
                for (int k4 = 0; k4 < 4; ++k4) { const int ks = 4 * kg + k4;
                    alo[k4] = att::trd(ap + 16 * ks * RS); ahh[k4] = att::trd(ap + (16 * ks + 4) * RS);
                    xlo[k4] = att::trd(xp + 16 * ks * 64); xhh[k4] = att::trd(xp + (16 * ks + 4) * 64);
                    w0[k4] = *(const LAS f32x4*)(wend + 16 * ks + 8 * hi); w1[k4] = *(const LAS f32x4*)(wend + 16 * ks + 8 * hi + 4); }
                __builtin_amdgcn_sched_barrier(0);
#pragma unroll
                for (int k4 = 0; k4 < 4; ++k4) {
                    v4u xw;
                    xw.x = att::cvtpk(bf1((bf16)xlo[k4][0]) * w0[k4][0], bf1((bf16)xlo[k4][1]) * w0[k4][1]); xw.y = att::cvtpk(bf1((bf16)xlo[k4][2]) * w0[k4][2], bf1((bf16)xlo[k4][3]) * w0[k4][3]);
                    xw.z = att::cvtpk(bf1((bf16)xhh[k4][0]) * w1[k4][0], bf1((bf16)xhh[k4][1]) * w1[k4][1]); xw.w = att::cvtpk(bf1((bf16)xhh[k4][2]) * w1[k4][2], bf1((bf16)xhh[k4][3]) * w1[k4][3]);
                    ST = SSD_MFMA(__builtin_shufflevector(alo[k4], ahh[k4], 0, 1, 2, 3, 4, 5, 6, 7), __builtin_bit_cast(bf16x8, xw), ST);
                }
            }
            LAS unsigned char* so = Ss + ((ch + 1) & 1) * 32 * RS + c * RS + (32 * nb + 4 * hi) * 2;
#pragma unroll
            for (int g4 = 0; g4 < 4; ++g4) { v2u w; w.x = att::cvtpk(ST[4 * g4], ST[4 * g4 + 1]); w.y = att::cvtpk(ST[4 * g4 + 2], ST[4 * g4 + 3]); *(LAS v2u*)(so + g4 * 16) = w; }
        }
        SSD_WRITE(lds + ((ch + 1) & 1) * BUF);
        SSD_BAR();
    }
    VM_WAIT();
#undef SSD_LOAD
#undef SSD_WRITE
}
}
struct Frame {
    LAS unsigned char* lds;
    volatile LAS unsigned* MISC;
    gu32* ctl;
    int wave;
    int vcu, G;
};

__device__ __forceinline__ void row_copy_ss(const float* xrow, bf16* orow, unsigned long long* ss, int lane) {
    const f32x4* xr = (const f32x4*)xrow + lane;
    f32x4 v[16]; float s = 0.f;
#pragma unroll
    for (int j = 0; j < 16; ++j) { v[j] = xr[64 * j]; s += (v[j].x * v[j].x + v[j].y * v[j].y) + (v[j].z * v[j].z + v[j].w * v[j].w); }
    s = wave_sum(s);
    v2u* o8 = (v2u*)orow + lane;
#pragma unroll
    for (int j = 0; j < 16; ++j) { v2u wb; wb.x = pk2(v[j].x, v[j].y); wb.y = pk2(v[j].z, v[j].w); o8[64 * j] = wb; }
    if (lane == 0) *ss = (unsigned long long)(s * 1048576.0f + 0.5f);
}
__device__ __forceinline__ void rms_row_out(const bf16* xrow, const float* gain, float* orow, int lane) {
    const v4u* xr = (const v4u*)xrow + lane; float v[64]; float s = 0.f;
#pragma unroll
    for (int j = 0; j < 8; ++j) { const v4u w = xr[64 * j];
#pragma unroll
        for (int e = 0; e < 4; ++e) { v[8 * j + 2 * e] = bflo(w[e]); v[8 * j + 2 * e + 1] = bfhi(w[e]); s += v[8 * j + 2 * e] * v[8 * j + 2 * e] + v[8 * j + 2 * e + 1] * v[8 * j + 2 * e + 1]; } }
    const float rstd = 1.0f / sqrtf(wave_sum(s) * (1.0f / DM) + EPS);
#pragma unroll
    for (int j = 0; j < 8; ++j) { const f32x4 g0 = *(const f32x4*)(gain + 512 * j + 8 * lane), g1 = *(const f32x4*)(gain + 512 * j + 8 * lane + 4);
        f32x4 o0, o1;
#pragma unroll
        for (int e = 0; e < 4; ++e) { o0[e] = v[8 * j + e] * rstd * g0[e]; o1[e] = v[8 * j + 4 + e] * rstd * g1[e]; }
        *(f32x4*)(orow + 512 * j + 8 * lane) = o0; *(f32x4*)(orow + 512 * j + 8 * lane + 4) = o1; }
}
__device__ __forceinline__ void prep_rows4(int m0, const bf16* PROJ, const float* cosT, const float* sinT, const float* dt_bias, unsigned long long* SSQ, bf16* KPE, float* DT, int lane) {
    v4u w[4][3]; unsigned short dtr[4];
#pragma unroll
    for (int r = 0; r < 4; ++r) { const bf16* pr = PROJ + (size_t)(m0 + r) * INCP;
        w[r][0] = *(const v4u*)(pr + 8 * lane); w[r][1] = *(const v4u*)(pr + 8 * (64 + lane));
        w[r][2] = lane < 56 ? *(const v4u*)(pr + 8 * (128 + lane)) : (v4u){0u, 0u, 0u, 0u};
        dtr[r] = lane < 32 ? pr[O_DT + lane] : (unsigned short)0; }
#pragma unroll
    for (int r = 0; r < 4; ++r) { const int m = m0 + r;
        float s0 = 0.f, s1 = 0.f, s2 = 0.f;
#pragma unroll
        for (int e = 0; e < 4; ++e) { float a = bflo(w[r][0][e]), b = bfhi(w[r][0][e]); s0 += a * a + b * b; a = bflo(w[r][1][e]); b = bfhi(w[r][1][e]); s1 += a * a + b * b; a = bflo(w[r][2][e]); b = bfhi(w[r][2][e]); s2 += a * a + b * b; }
        const float sq = wave_sum(s0 + (lane < 48 ? s1 : 0.f)), sk = wave_sum((lane < 48 ? 0.f : s1) + (lane < 48 ? s2 : 0.f));
        if (lane == 0) { SSQ[m] = (unsigned long long)(sq * 1048576.0f + 0.5f); SSQ[M + m] = (unsigned long long)(sk * 1048576.0f + 0.5f); }
        if (lane >= 48 && lane < 56) {
            const int ip = 4 * (lane - 48); const f32x4 cs = *(const f32x4*)(cosT + (size_t)m * 32 + ip), sn = *(const f32x4*)(sinT + (size_t)m * 32 + ip);
            v4u o;
#pragma unroll
            for (int e = 0; e < 4; ++e) { const float x1 = bflo(w[r][2][e]), x2 = bfhi(w[r][2][e]); o[e] = pk2(x1 * cs[e] - x2 * sn[e], x2 * cs[e] + x1 * sn[e]); }
            *(v4u*)(KPE + (size_t)m * 64 + 2 * ip) = o; }
        if (lane < 32) { const float v = bf1(dtr[r]) + dt_bias[lane]; DT[(size_t)m * 32 + lane] = fmaxf(v, 0.f) + log1pf(expf(-fabsf(v))); }
    }
}
__device__ __forceinline__ void conv_item(int item, const bf16* PROJ, const float* conv_w, const float* conv_b, bf16* XBC, int lane) {
    const int rr = item >> 3, sl = item & 7, ch0 = sl * 512 + lane * 8, m0 = rr * 32, t0 = m0 & (SEQ - 1);
    const bf16* src = PROJ + (size_t)m0 * INCP + O_XBC + ch0;
    bf16* dst = XBC + (size_t)m0 * 4096 + ch0;
    v4u x[35];
#pragma unroll
    for (int i = 0; i < 3; ++i) x[i] = t0 > 0 ? *(const v4u*)(src + (ptrdiff_t)(i - 3) * INCP) : (v4u){0u, 0u, 0u, 0u};
#pragma unroll
    for (int i = 0; i < 32; ++i) x[3 + i] = *(const v4u*)(src + (size_t)i * INCP);
    float w[4][8], bb[8];
#pragma unroll
    for (int k = 0; k < 4; ++k) { const f32x4 a = *(const f32x4*)(conv_w + k * CONVD + ch0), b2 = *(const f32x4*)(conv_w + k * CONVD + ch0 + 4);
#pragma unroll
        for (int e = 0; e < 4; ++e) { w[k][e] = a[e]; w[k][4 + e] = b2[e]; } }
    { const f32x4 a = *(const f32x4*)(conv_b + ch0), b2 = *(const f32x4*)(conv_b + ch0 + 4);
#pragma unroll
      for (int e = 0; e < 4; ++e) { bb[e] = a[e]; bb[4 + e] = b2[e]; } }
#pragma unroll
    for (int i = 0; i < 32; ++i) { v4u o;
#pragma unroll
        for (int e = 0; e < 4; ++e) {
            const float ya = bb[2 * e] + w[0][2 * e] * bflo(x[i][e]) + w[1][2 * e] * bflo(x[i + 1][e]) + w[2][2 * e] * bflo(x[i + 2][e]) + w[3][2 * e] * bflo(x[i + 3][e]);
            const float yc = bb[2 * e + 1] + w[0][2 * e + 1] * bfhi(x[i][e]) + w[1][2 * e + 1] * bfhi(x[i + 1][e]) + w[2][2 * e + 1] * bfhi(x[i + 2][e]) + w[3][2 * e + 1] * bfhi(x[i + 3][e]);
            o[e] = pk2(silu_f(ya), silu_f(yc)); }
        *(v4u*)(dst + (size_t)i * 4096) = o; }
}
template <int NR> __device__ __forceinline__ void gnorm_rows(bf16* row0, size_t rstride, const float* gw, int lane) {
    v4u w[NR][4];
#pragma unroll
    for (int r = 0; r < NR; ++r) { const v4u* p = (const v4u*)(row0 + r * rstride + 32 * lane);
#pragma unroll
        for (int j = 0; j < 4; ++j) w[r][j] = p[j]; }
    const float* g = gw + 32 * lane;
#pragma unroll
    for (int r = 0; r < NR; ++r) { float s = 0.f;
#pragma unroll
        for (int j = 0; j < 4; ++j)
#pragma unroll
            for (int e = 0; e < 4; ++e) { const float a = bflo(w[r][j][e]), b = bfhi(w[r][j][e]); s += a * a + b * b; }
        s += __shfl_xor(s, 1); s += __shfl_xor(s, 2); s += __shfl_xor(s, 4);
        const float rstd = 1.0f / sqrtf(s * (1.0f / 256.0f) + EPS);
        v4u* p = (v4u*)(row0 + r * rstride + 32 * lane);
#pragma unroll
        for (int j = 0; j < 4; ++j) { v4u o;
#pragma unroll
            for (int e = 0; e < 4; ++e) o[e] = pk2(bflo(w[r][j][e]) * rstd * g[8 * j + 2 * e], bfhi(w[r][j][e]) * rstd * g[8 * j + 2 * e + 1]);
            p[j] = o; } }
}
__device__ __forceinline__ void ssd_item(int item, const bf16* XBC, const float* DT, const bf16* PROJ, const float* a_log, const float* d_skip, bf16* MIXo, int lane) {
    const int pi = lane >> 4, ns = lane & 15;
    const int b = item >> 9, h = (item >> 4) & 31, pq = item & 15, g = h >> 2;
    const float A2 = -expf(a_log[h]) * 1.4426950408889634f, Dk = d_skip[h];
    const int pcol = h * 64 + pq * 4 + pi;
    float st[8];
#pragma unroll
    for (int k = 0; k < 8; ++k) st[k] = 0.f;
    const bf16* xb = XBC + (size_t)b * SEQ * 4096; const float* dtp = DT + (size_t)b * SEQ * 32 + h;
    const bf16* zp = PROJ + (size_t)b * SEQ * INCP + O_Z + pcol; bf16* op = MIXo + (size_t)b * SEQ * 4096 + 2048 + pcol;
#pragma unroll 4
    for (int t = 0; t < SEQ; ++t) {
        const bf16* xr = xb + (size_t)t * 4096;
        const float dtv = dtp[(size_t)t * 32];
        const float xv = bf1(xr[pcol]);
        const v4u Bw = *(const v4u*)(xr + 2048 + g * 128 + ns * 8);
        const v4u Cw = *(const v4u*)(xr + 3072 + g * 128 + ns * 8);
        const float zv = bf1(zp[(size_t)t * INCP]);
        const float dA = __builtin_amdgcn_exp2f(dtv * A2), xdt = dtv * xv;
        float part = 0.f;
#pragma unroll
        for (int e = 0; e < 4; ++e) {
            st[2 * e] = dA * st[2 * e] + xdt * bflo(Bw[e]); part += bflo(Cw[e]) * st[2 * e];
            st[2 * e + 1] = dA * st[2 * e + 1] + xdt * bfhi(Bw[e]); part += bfhi(Cw[e]) * st[2 * e + 1]; }
        part += __shfl_xor(part, 1); part += __shfl_xor(part, 2); part += __shfl_xor(part, 4); part += __shfl_xor(part, 8);
        if (ns == 0) op[(size_t)t * 4096] = (bf16)f2bf((part + Dk * xv) * silu_f(zv));
    }
}
__device__ __forceinline__ int dst_row(int kind, int n) {
    if (kind == 1) return ((n >> 7) << 8) + (n & 127);
    if (kind == 2) return ((n >> 7) << 8) + 128 + (n & 127);
    if (kind == 3) { const int hh = n / QKD, j = n - hh * QKD; if (j < NOPE) return n; const int i = j - NOPE; return hh * QKD + NOPE + (i < 32 ? 2 * i : 2 * (i - 32) + 1); }
    if (kind == 4) { if (n < O_KPE || n >= O_KPE + ROPE) return n; const int i = n - O_KPE; return O_KPE + (i < 32 ? 2 * i : 2 * (i - 32) + 1); }
    return n;
}
__device__ __forceinline__ void p0_transpose_item(const float* W, int K, int N, bf16* WT, int kind, const float* gain, LAS float* scr, int item, int lane) {
    const bool f16w = false;
    const int nblk = N / 32, kb = item / nblk, nb = item - kb * nblk, k0 = 64 * kb, n0 = 32 * nb;
    float v[32];
    const float* wp = W + (size_t)(k0 + (lane >> 5)) * N + n0 + (lane & 31);
#pragma unroll
    for (int i = 0; i < 32; ++i) v[i] = wp[(size_t)(2 * i) * N];
    const int c = lane & 7;
    f32x4 g0 = (f32x4){1.f, 1.f, 1.f, 1.f}, g1 = g0;
    if (gain) { g0 = *(const f32x4*)(gain + k0 + 8 * c); g1 = *(const f32x4*)(gain + k0 + 8 * c + 4); }
#pragma unroll
    for (int i = 0; i < 32; ++i) scr[(2 * i + (lane >> 5)) * 33 + (lane & 31)] = v[i];
    LDS_WAIT(); asm volatile("" ::: "memory");
#pragma unroll
    for (int j = 0; j < 4; ++j) { const int n = (lane >> 3) + 8 * j; const LAS float* s = scr + (8 * c) * 33 + n;
        const float e0 = s[0 * 33] * g0[0], e1 = s[1 * 33] * g0[1], e2 = s[2 * 33] * g0[2], e3 = s[3 * 33] * g0[3], e4 = s[4 * 33] * g1[0], e5 = s[5 * 33] * g1[1], e6 = s[6 * 33] * g1[2], e7 = s[7 * 33] * g1[3];
        v4u o; if (f16w) { o.x = pkh2(e0, e1); o.y = pkh2(e2, e3); o.z = pkh2(e4, e5); o.w = pkh2(e6, e7); } else { o.x = pk2(e0, e1); o.y = pk2(e2, e3); o.z = pk2(e4, e5); o.w = pk2(e6, e7); }
        *(v4u*)(WT + (size_t)dst_row(kind, n0 + n) * K + k0 + 8 * c) = o; }
    LDS_WAIT(); asm volatile("" ::: "memory");
}
struct InPtrs { const float* p[24]; };
#ifndef DEFER_D2
#define DEFER_D2 1
#endif
constexpr int IT_FFN = (DM / 64) * (FF / 32);
constexpr int IT_IN = (DM / 64) * (INC / 32);
constexpr int IT_QU = (QL / 64) * (QW / 32);
constexpr int IT_KVU = (KVL / 64) * (KVW / 32);
constexpr int IT_O = (DM / 64) * (DM / 32);
constexpr int IT_LAYER = 6 * IT_FFN + IT_IN + IT_QU + IT_KVU + IT_O;
__device__ __forceinline__ void p0_prologue(Frame& F, const InPtrs& in, unsigned char* ws, int lane) {
    LAS float* scr = (LAS float*)(F.lds + RING_OFF + F.wave * 16384);
    const int gw = F.vcu * NWAVES + F.wave, NGW = F.G * NWAVES;
    for (int it = gw; it < DEPTH * IT_LAYER; it += NGW) {
        const int l = it / IT_LAYER; int r = it - l * IT_LAYER;
        unsigned char* wl = ws + WS_W + (size_t)l * W_LAYER;
        const size_t lFF = (size_t)l * DM * FF;
        if (r < IT_FFN) { p0_transpose_item(in.p[3] + lFF, DM, FF, (bf16*)(wl + W_GU1), 1, in.p[2] + (size_t)l * DM, scr, r, lane); continue; } r -= IT_FFN;
        if (r < IT_FFN) { p0_transpose_item(in.p[4] + lFF, DM, FF, (bf16*)(wl + W_GU1), 2, in.p[2] + (size_t)l * DM, scr, r, lane); continue; } r -= IT_FFN;
        if (r < IT_FFN) { p0_transpose_item(in.p[5] + lFF, FF, DM, (bf16*)(wl + W_D1), 0, nullptr, scr, r, lane); continue; } r -= IT_FFN;
        if (r < IT_IN) { p0_transpose_item(in.p[7] + (size_t)l * DM * INC, DM, INC, (bf16*)(wl + W_IN), 4, in.p[6] + (size_t)l * DM, scr, r, lane); continue; } r -= IT_IN;
        if (r < IT_QU) { p0_transpose_item(in.p[9] + (size_t)l * QL * QW, QL, QW, (bf16*)(wl + W_QU), 3, in.p[8] + (size_t)l * QL, scr, r, lane); continue; } r -= IT_QU;
        if (r < IT_KVU) { p0_transpose_item(in.p[11] + (size_t)l * KVL * KVW, KVL, KVW, (bf16*)(wl + W_KVU), 0, in.p[10] + (size_t)l * KVL, scr, r, lane); continue; } r -= IT_KVU;
        if (r < IT_O) { p0_transpose_item(in.p[18] + (size_t)l * DM * DM, DM, DM, (bf16*)(wl + W_O), 0, nullptr, scr, r, lane); continue; } r -= IT_O;
        if (r < IT_FFN) { if (!(l >= 1 && DEFER_D2 >= 2)) p0_transpose_item(in.p[20] + lFF, DM, FF, (bf16*)(wl + W_GU2), 1, in.p[19] + (size_t)l * DM, scr, r, lane); continue; } r -= IT_FFN;
        if (r < IT_FFN) { p0_transpose_item(in.p[21] + lFF, DM, FF, (bf16*)(wl + W_GU2), 2, in.p[19] + (size_t)l * DM, scr, r, lane); continue; } r -= IT_FFN;
        if (DEFER_D2) continue;
        p0_transpose_item(in.p[22] + lFF, FF, DM, (bf16*)(wl + W_D2), 0, nullptr, scr, r, lane);
    }
    const int gt = gw * 64 + lane, NGT = NGW * 64;
    for (int i = gt; i < DEPTH * 16384; i += NGT) { const int l = i >> 14, j = i & 16383;
        *(v4u*)(ws + WS_W + (size_t)l * W_LAYER + W_IN + (size_t)INC * DM * 2 + (size_t)j * 16) = (v4u){0u, 0u, 0u, 0u}; }
    const int* pos = (const int*)in.p[1]; float* cosT = (float*)(ws + WS_COS); float* sinT = (float*)(ws + WS_SIN);
    float invf;
    {   const double y = -(double)(lane & 31) * 0.28782313662425575;
        const double kd = __builtin_rint(y * 1.4426950408889634);
        double r = __builtin_fma(-kd, 0.6931471803691238, y); r = __builtin_fma(-kd, 1.9082149292705877e-10, r);
        double e = 1.0;
#pragma unroll
        for (int k = 18; k >= 1; --k) e = 1.0 + e * r * (1.0 / (double)k);
        invf = (float)__builtin_ldexp(e, (int)kd); }
    for (int i = gt; i < M * 32; i += NGT) { const int m = i >> 5;
        const float ang = (float)pos[m] * invf;
        const double x = (double)ang, n = __builtin_rint(x * 0.15915494309189535);
        double r = __builtin_fma(-n, 6.283185307179586, x); r = __builtin_fma(-n, 2.4492935982947064e-16, r);
        const double r2 = r * r; double sn = 1.0, cs = 1.0;
#pragma unroll
        for (int k = 14; k >= 1; --k) { sn = 1.0 - sn * r2 * (1.0 / (double)((2 * k) * (2 * k + 1))); cs = 1.0 - cs * r2 * (1.0 / (double)((2 * k - 1) * (2 * k))); }
        cosT[i] = (float)cs; sinT[i] = (float)(sn * r); }
    for (int m = gw; m < M; m += NGW) row_copy_ss(in.p[0] + (size_t)m * DM, (bf16*)(ws + WS_XN) + (size_t)m * DM, (unsigned long long*)(ws + WS_SS) + m, lane);
}
#ifndef REP_GEMM
#define REP_GEMM 1
#endif
#ifndef REP_RES
#define REP_RES 1
#endif
#ifndef REP_BAR
#define REP_BAR 0
#endif
#ifndef REP_ATT
#define REP_ATT 1
#endif
#ifndef REP_SSD
#define REP_SSD 1
#endif
#ifndef REP_THIN
#define REP_THIN 1
#endif
#ifndef DBG_EN
#define DBG_EN 0xffff
#endif
constexpr int PH_PER_LAYER = 9, N_PHASES = 1 + PH_PER_LAYER * DEPTH + 1;
struct Args { const float* in[24]; float* out; unsigned char* ws; int ph_lo, ph_hi; };
static_assert(sizeof(Args) == 24 * 8 + 16 + 8, "Args has no holes");

__global__ void __launch_bounds__(NTHREADS, 2) trunk_fwd(Args args) {
    extern __shared__ __attribute__((aligned(16))) unsigned char lds[];
    Frame F;
    F.lds = (LAS unsigned char*)lds;
    F.MISC = (volatile LAS unsigned*)(F.lds + MISC_OFF);
    F.wave = __builtin_amdgcn_readfirstlane(threadIdx.x >> 6);
    F.G = gridDim.x; { const int bx = blockIdx.x; F.vcu = (F.G % 8 == 0) ? (bx % 8) * (F.G / 8) + bx / 8 : bx; }
    unsigned char* ws = args.ws;
    F.ctl = (gu32*)(ws + WS_CTL);
    for (int u = threadIdx.x; u < (LDS_BYTES - LDSCTL_OFF) / 4; u += NTHREADS) ((LAS unsigned*)(F.lds + LDSCTL_OFF))[u] = 0u;
    __syncthreads();
    XcdBarrier bar; bar.bar = (unsigned*)(F.ctl + CW_BAR); bar.x = 0; bar.st = nullptr;
    if (MK_ONE_LAUNCH) bar = xcd_barrier_post((unsigned*)(F.ctl + CW_BAR), F.MISC + 8);
#define GRID_BAR() do { if (MK_ONE_LAUNCH) xcd_barrier(bar); } while (0)
    const int lo = args.ph_lo, hi = args.ph_hi;
#define IN(k) (lo <= (k) && (k) < hi)
#ifndef XBAR
#define XBAR 0
#endif
#define SEAM(k) do { if (IN((k) + 1)) { GRID_BAR(); for (int xb_ = 0; xb_ < XBAR; ++xb_) GRID_BAR(); } } while (0)
#define ROWFAC(ssp_, invn_) ({ LAS float* tab_ = (LAS float*)(F.lds + RSTAB_OFF); const int rb_ = 2048 * ((int)blockIdx.x & 7); int t0_ = threadIdx.x; asm volatile("" : "+v"(t0_)); __syncthreads(); \
        for (int r_ = t0_; r_ < 2048; r_ += NTHREADS) tab_[r_] = pg8::row_rstd((ssp_), rb_ + r_, (invn_)); \
        __syncthreads(); pg8::RowFac rf_; rf_.tab = tab_ - rb_; rf_; })
#define LANE_L() ({ int l_ = threadIdx.x; asm volatile("" : "+v"(l_)); l_ & 63; })
#define PH_VARS() const int ln = LANE_L(); int gw_ = F.vcu * NWAVES + F.wave; asm volatile("" : "+s"(gw_)); const int gw = gw_, NGW = F.G * NWAVES; (void)ln; (void)gw; (void)NGW

    bf16* XB = (bf16*)(ws + WS_XN); bf16* HB = (bf16*)(ws + WS_BIG); bf16* PROJ = (bf16*)(ws + WS_BIG);
    bf16* KPE = (bf16*)(ws + WS_KPE); float* DT = (float*)(ws + WS_DT); unsigned long long* SSQ = (unsigned long long*)(ws + WS_SSQ); unsigned long long* SS = (unsigned long long*)(ws + WS_SS);
    bf16* XBC = (bf16*)(ws + WS_XBC); bf16* QB = (bf16*)(ws + WS_Q); bf16* KVB = (bf16*)(ws + WS_KV); bf16* MIX = (bf16*)(ws + WS_MIX);
    const float* cosT = (const float*)(ws + WS_COS); const float* sinT = (const float*)(ws + WS_SIN);

    if ((DBG_EN & 1) && IN(0)) { PH_VARS(); InPtrs ip;
#pragma unroll
        for (int i = 0; i < 24; ++i) ip.p[i] = args.in[i];
        for (int rep = 0; rep < REP_THIN; ++rep) p0_prologue(F, ip, ws, ln); SEAM(0); }

    for (int l = 0; l < DEPTH; ++l) {
        const int pb = 1 + PH_PER_LAYER * l;
        unsigned char* wl = ws + WS_W + (size_t)l * W_LAYER;
        for (int f = 0; f < 2; ++f) {
            if (f == 1) {
                if ((DBG_EN & 4) && IN(pb + 2)) { PH_VARS(); pg8::Gemm g{XB, (const bf16*)(wl + W_IN), M, INCP, DM, DM, DM}; pg8::StaticOrder S; S.init(M, INCP, F.G, (int)blockIdx.x);
                    pg8::EpiStore E{PROJ, INCP, ROWFAC(SS + (size_t)(3 * l + 1) * M, 1.0f / DM)};
                    for (int rep = 0; rep < REP_GEMM; ++rep) { if (REP_BAR && rep) GRID_BAR(); pg8::gemm_phase<pg8::EpiStore, pg8::StaticOrder, PG8_ALIGN, PG8_SP2>(F.lds + RING_OFF, g, S, E); }
                    if (DEFER_D2 && F.G == 256 && blockIdx.x >= 128) {
                        LAS float* scr = (LAS float*)(F.lds + RING_OFF + F.wave * 16384);
                        bf16* wt = (bf16*)(ws + WS_W + (size_t)l * W_LAYER + W_D2); const float* wsrc = args.in[22] + (size_t)l * DM * FF;
                        for (int it = ((int)blockIdx.x - 128) * NWAVES + F.wave; it < IT_FFN; it += 128 * NWAVES) p0_transpose_item(wsrc, FF, DM, wt, 0, nullptr, scr, it, ln);
                        if (DEFER_D2 >= 2) { bf16* wg = (bf16*)(ws + WS_W + (size_t)(l + 1) * W_LAYER + W_GU2); const float* gsrc = args.in[20] + (size_t)(l + 1) * DM * FF; const float* gg = args.in[19] + (size_t)(l + 1) * DM;
                            for (int it = ((int)blockIdx.x - 128) * NWAVES + F.wave; it < IT_FFN; it += 128 * NWAVES) p0_transpose_item(gsrc, DM, FF, wg, 1, gg, scr, it, ln); }
                    } else if (DEFER_D2 && F.G != 256) {
                        LAS float* scr = (LAS float*)(F.lds + RING_OFF + F.wave * 16384);
                        bf16* wt = (bf16*)(ws + WS_W + (size_t)l * W_LAYER + W_D2); const float* wsrc = args.in[22] + (size_t)l * DM * FF;
                        for (int it = gw; it < IT_FFN; it += NGW) p0_transpose_item(wsrc, FF, DM, wt, 0, nullptr, scr, it, ln);
                        if (DEFER_D2 >= 2) { bf16* wg = (bf16*)(ws + WS_W + (size_t)(l + 1) * W_LAYER + W_GU2); const float* gsrc = args.in[20] + (size_t)(l + 1) * DM * FF; const float* gg = args.in[19] + (size_t)(l + 1) * DM;
                            for (int it = gw; it < IT_FFN; it += NGW) p0_transpose_item(gsrc, DM, FF, wg, 1, gg, scr, it, ln); }
                    }
                    SEAM(pb + 2); }
                if ((DBG_EN & 8) && IN(pb + 3)) { PH_VARS();
                    for (int rep = 0; rep < REP_THIN; ++rep) for (int m = 4 * gw; m < M; m += 4 * NGW) prep_rows4(m, PROJ, cosT, sinT, args.in[14] + (size_t)l * SSD_H, SSQ, KPE, DT, ln);
                    for (int rep = 0; rep < REP_THIN; ++rep) for (int it = gw; it < (M / 32) * 8; it += NGW) conv_item(it, PROJ, args.in[12] + (size_t)l * 4 * CONVD, args.in[13] + (size_t)l * CONVD, XBC, ln);
                    SEAM(pb + 3); }
                if ((DBG_EN & 16) && IN(pb + 4)) { PH_VARS();
                    for (int rep = 0; rep < REP_SSD; ++rep) for (int u = F.vcu; u < BATCH * SSD_H * 2; u += F.G) ssd::ssd_unit(u, XBC, DT, PROJ, args.in[15] + (size_t)l * SSD_H, args.in[16] + (size_t)l * SSD_H, MIX, F.lds + RING_OFF);
                    for (int s2 = 0; s2 < 2; ++s2) {
                        const int kk = s2 ? KVL : QL, nn = s2 ? KVW : QW;
                        pg8::Gemm g{PROJ + (s2 ? O_CKV : O_CQ), (const bf16*)(wl + (s2 ? W_KVU : W_QU)), M, nn, kk, INCP, kk}; pg8::StaticOrder S; S.init(M, nn, F.G, (int)blockIdx.x);
                        pg8::EpiStore E{s2 ? KVB : QB, nn, ROWFAC(SSQ + (size_t)s2 * M, 1.0f / (float)kk)};
                        for (int rep = 0; rep < REP_GEMM; ++rep) { if (REP_BAR && rep) GRID_BAR(); pg8::gemm_phase<pg8::EpiStore, pg8::StaticOrder, PG8_ALIGN, PG8_SP2>(F.lds + RING_OFF, g, S, E); } }
                    SEAM(pb + 4); }
                if ((DBG_EN & 32) && IN(pb + 5)) { PH_VARS();
                    for (int rep = 0; rep < REP_ATT; ++rep) for (int u = F.vcu; u < BATCH * NH * 8; u += F.G) { const int bh = u >> 3, xq = u & 7;
                        att::attn_block(bh >> 4, bh & 15, xq, QB, KVB, KPE, cosT, sinT, MIX, F.lds + RING_OFF);
                        att::attn_block(bh >> 4, bh & 15, 15 - xq, QB, KVB, KPE, cosT, sinT, MIX, F.lds + RING_OFF); }
                    { const float* g = args.in[17] + (size_t)l * SSD_W;
                      for (int m = 4 * gw; m < M; m += 4 * NGW) gnorm_rows<4>(MIX + (size_t)m * 4096 + 2048, 4096, g, ln); }
                    SEAM(pb + 5); }
                if ((DBG_EN & 128) && IN(pb + 6)) { PH_VARS(); pg8::Gemm g{MIX, (const bf16*)(wl + W_O), M, DM, DM, DM, DM}; pg8::StaticOrder S; S.init(M, DM, F.G, (int)blockIdx.x);
                    for (int rep = 0; rep < REP_RES; ++rep) { pg8::EpiResid E{XB, rep ? (unsigned long long*)(ws + WS_SSP) : SS + (size_t)(3 * l + 2) * M, DM, rep == 0 ? 1.0f : 0.0f};
                    pg8::gemm_phase<pg8::EpiResid, pg8::StaticOrder, PG8_ALIGN, PG8_SP2>(F.lds + RING_OFF, g, S, E); }
                    SEAM(pb + 6); }
            }
            const int fb = pb + 7 * f;
            if ((DBG_EN & 512) && IN(fb)) { PH_VARS(); pg8::Gemm g{XB, (const bf16*)(wl + (f ? W_GU2 : W_GU1)), M, 2 * FF, DM, DM, DM}; pg8::StaticOrder S; S.init(M, 2 * FF, F.G, (int)blockIdx.x);
                pg8::EpiSwiGLU E{HB, FF, ROWFAC(SS + (size_t)(3 * l + 2 * f) * M, 1.0f / DM)};
                for (int rep = 0; rep < REP_GEMM; ++rep) { if (REP_BAR && rep) GRID_BAR(); pg8::gemm_phase<pg8::EpiSwiGLU, pg8::StaticOrder, PG8_ALIGN, PG8_SP2>(F.lds + RING_OFF, g, S, E); }
                SEAM(fb); }
            if ((DBG_EN & 1024) && IN(fb + 1)) { PH_VARS(); pg8::Gemm g{HB, (const bf16*)(wl + (f ? W_D2 : W_D1)), M, DM, FF, FF, FF}; pg8::StaticOrder S; S.init(M, DM, F.G, (int)blockIdx.x);
                for (int rep = 0; rep < REP_RES; ++rep) { pg8::EpiResid E{XB, rep ? (unsigned long long*)(ws + WS_SSP) : SS + (size_t)(3 * l + 2 * f + 1) * M, DM, rep == 0 ? 0.5f : 0.0f};
                pg8::gemm_phase<pg8::EpiResid, pg8::StaticOrder, PG8_ALIGN, PG8_SP2>(F.lds + RING_OFF, g, S, E); }
                SEAM(fb + 1); }
        }
    }
    if ((DBG_EN & 2048) && IN(N_PHASES - 1)) { PH_VARS(); for (int m = gw; m < M; m += NGW) rms_row_out(XB + (size_t)m * DM, args.in[23], args.out + (size_t)m * DM, ln); }
#undef IN
#undef SEAM
#undef GRID_BAR
}

extern "C" void kernel_launch(void* const* d_in, const int* in_sizes, int n_in, void* d_out, int out_size, void* d_ws, size_t ws_size, hipStream_t stream) {
    static int grid = 0;
    if (grid == 0) {
        if (n_in != 24 || in_sizes[0] != M * DM || out_size != M * DM || ws_size < WS_END) {
            fprintf(stderr, "kernel_launch: built for 24 inputs, x/out of %d floats, >= %zu bytes of workspace; got n_in %d, in0 %d, out %d, ws %zu; nothing launched\n", M * DM, (size_t)WS_END, n_in, n_in > 0 ? in_sizes[0] : -1, out_size, ws_size);
            grid = -1; return; }
        int dev = 0, cus = 0, per_cu = 0;
        if (hipGetDevice(&dev) != hipSuccess || hipDeviceGetAttribute(&cus, hipDeviceAttributeMultiprocessorCount, dev) != hipSuccess) { fprintf(stderr, "kernel_launch: device query failed\n"); grid = -1; return; }
        if (hipFuncSetAttribute((const void*)trunk_fwd, hipFuncAttributeMaxDynamicSharedMemorySize, LDS_BYTES) != hipSuccess) { fprintf(stderr, "kernel_launch: hipFuncSetAttribute failed\n"); grid = -1; return; }
        if (hipOccupancyMaxActiveBlocksPerMultiprocessor(&per_cu, (const void*)trunk_fwd, NTHREADS, LDS_BYTES) != hipSuccess || per_cu < 1)
            fprintf(stderr, "kernel_launch: note: occupancy query reports %d workgroups per CU\n", per_cu);
        (void)hipGetLastError();
        if (cus != 256) { fprintf(stderr, "kernel_launch: built for a 256-CU device (the GEMM epilogues' row-factor tables assume the 256-workgroup unit deal); found %d CUs; nothing launched\n", cus); grid = -1; return; }
        grid = cus;
    }
    if (grid < 0) return;
    if (hipMemsetAsync((char*)d_ws + WS_CTL, 0, CTL_ZERO_BYTES, stream) != hipSuccess) { fprintf(stderr, "kernel_launch: memset failed\n"); return; }
    Args a{};
    for (int i = 0; i < 24; ++i) a.in[i] = (const float*)d_in[i];
    a.out = (float*)d_out; a.ws = (unsigned char*)d_ws;
#if MK_ONE_LAUNCH
    a.ph_lo = 0; a.ph_hi = N_PHASES;
    hipLaunchKernelGGL(trunk_fwd, dim3(grid), dim3(NTHREADS), LDS_BYTES, stream, a);
#else
    for (int p = 0; p < N_PHASES; ++p) { a.ph_lo = p; a.ph_hi = p + 1; hipLaunchKernelGGL(trunk_fwd, dim3(grid), dim3(NTHREADS), LDS_BYTES, stream, a); }
#endif
    const hipError_t le = hipPeekAtLastError();
    if (le != hipSuccess) fprintf(stderr, "kernel_launch: launch failed: %s\n", hipGetErrorName(le));
}
```

```cpp
#include <hip/hip_runtime.h>
#include <cstdio>
#include <cstdint>

#ifndef MK_ONE_LAUNCH
#define MK_ONE_LAUNCH 1
#endif

constexpr int BATCH = 4, SEQ = 4096, DM = 4096, DEPTH = 4, FF = 6144;
constexpr int M = BATCH * SEQ;
constexpr int NH = 16, QL = 896, KVL = 512, NOPE = 128, ROPE = 64, VH = 128, QKD = NOPE + ROPE;
constexpr int QW = NH * QKD;
constexpr int KVW = NH * (NOPE + VH);
constexpr int SSD_P = 64, SSD_H = 32, SSD_G = 8, SSD_N = 128, SSD_W = 2048, CONVD = 4096;
constexpr int INC = 7648, INCP = 7680;
constexpr int O_CQ = 0, O_CKV = 896, O_KPE = 1408, O_Z = 1472, O_XBC = 3520, O_DT = 7616;
constexpr float EPS = 1e-6f;
constexpr int NWAVES = 8, NTHREADS = NWAVES * 64;

constexpr size_t MiB = 1u << 20;
constexpr size_t WS_CTL = 0, CTL_ZERO_BYTES = 3 * MiB;
constexpr size_t WS_SS = 1 * MiB;
constexpr int N_SS = 3 * DEPTH + 1;
static_assert(WS_SS + (size_t)N_SS * M * 8 <= CTL_ZERO_BYTES, "ss arrays inside the memset region");
constexpr size_t WS_COS = 3 * MiB, WS_SIN = 5 * MiB;
constexpr size_t WS_SSQ = 7 * MiB;
constexpr size_t WS_X = 8 * MiB;
constexpr size_t WS_XN = 264 * MiB;
constexpr size_t WS_BIG = 392 * MiB;
constexpr size_t WS_SSP = 632 * MiB;
constexpr size_t WS_KPE = 676 * MiB;
constexpr size_t WS_DT = 678 * MiB;
constexpr size_t WS_XBC = 680 * MiB;
constexpr size_t WS_Q = 808 * MiB;
constexpr size_t WS_KV = 904 * MiB;
constexpr size_t WS_MIX = 1032 * MiB;
constexpr size_t WS_W = 1160 * MiB;
constexpr size_t W_GU1 = 0, W_D1 = 96 * MiB, W_IN = 144 * MiB, W_QU = 204 * MiB, W_KVU = 210 * MiB, W_O = 214 * MiB, W_GU2 = 246 * MiB, W_D2 = 342 * MiB, W_LAYER = 390 * MiB;
constexpr size_t WS_END = WS_W + DEPTH * W_LAYER;
static_assert(WS_BIG + (size_t)M * INCP * 2 <= WS_SSP && WS_SSP + (size_t)M * 64 * 4 <= WS_KPE && WS_XBC + (size_t)M * 4096 * 2 <= WS_Q && WS_Q + (size_t)M * QW * 2 <= WS_KV, "d_ws map");
constexpr int CW_TMO = 0, CW_CODE = 1, CW_BAR = 4096;

constexpr int RING_OFF = 0, RING_BYTES = 131072;
constexpr int LDSCTL_OFF = RING_BYTES, MISC_OFF = LDSCTL_OFF + 320, RSTAB_OFF = LDSCTL_OFF + 1024;
static_assert(RSTAB_OFF + 2048 * 4 <= 147456, "LDS map");
constexpr int LDS_BYTES = 147456;

#define GAS __attribute__((address_space(1)))
#define LAS __attribute__((address_space(3)))
typedef unsigned short bf16;
typedef unsigned v4u __attribute__((ext_vector_type(4)));
typedef unsigned v2u __attribute__((ext_vector_type(2)));
typedef float f32x4 __attribute__((ext_vector_type(4)));
typedef float f32x2 __attribute__((ext_vector_type(2)));
typedef float f32x16 __attribute__((ext_vector_type(16)));
typedef short bf16x8 __attribute__((ext_vector_type(8)));
typedef short s16x4 __attribute__((ext_vector_type(4)));
typedef GAS unsigned gu32;
#define RLX_AGENT __ATOMIC_RELAXED, __HIP_MEMORY_SCOPE_AGENT
#define LDS_WAIT() asm volatile("s_waitcnt lgkmcnt(0)" ::: "memory")
#define VM_WAIT() asm volatile("s_waitcnt vmcnt(0)" ::: "memory")
__device__ __forceinline__ unsigned f2bf(float f) { unsigned u = __builtin_bit_cast(unsigned, f); return (u + 0x7fffu + ((u >> 16) & 1u)) >> 16; }
__device__ __forceinline__ unsigned pk2(float lo, float hi) { return f2bf(lo) | (f2bf(hi) << 16); }
__device__ __forceinline__ float bflo(unsigned w) { return __builtin_bit_cast(float, w << 16); }
__device__ __forceinline__ float bfhi(unsigned w) { return __builtin_bit_cast(float, w & 0xffff0000u); }
__device__ __forceinline__ float bf1(bf16 b) { return __builtin_bit_cast(float, (unsigned)b << 16); }
typedef _Float16 h16x2 __attribute__((ext_vector_type(2)));
__device__ __forceinline__ unsigned pkh2(float lo, float hi) { f32x2 v = {lo, hi}; h16x2 h = __builtin_convertvector(v, h16x2); return __builtin_bit_cast(unsigned, h); }
__device__ __forceinline__ float hlo(unsigned w) { return (float)__builtin_bit_cast(h16x2, w)[0]; }
__device__ __forceinline__ float hhi(unsigned w) { return (float)__builtin_bit_cast(h16x2, w)[1]; }
__device__ __forceinline__ float wave_sum(float v) {
#pragma unroll
    for (int o = 1; o < 64; o <<= 1) v += __shfl_xor(v, o);
    return v;
}
__device__ __forceinline__ float fast_exp(float x) { return __builtin_amdgcn_exp2f(x * 1.4426950408889634f); }
__device__ __forceinline__ float silu_f(float x) { return x * __builtin_amdgcn_rcpf(1.0f + fast_exp(-x)); }
#define XB_TMO      128
#define XB_XCNT(j)  (256  + 64 * (j))
#define XB_XSUB(j)  (1280 + 64 * (j))
#define XB_XGEN(j)  (2304 + 64 * (j))
#define XB_TOP      3328
#define XB_TOPGEN   3392
#define XCD_BAR_WORDS 3456
#define XB_SPIN_CAP (1u << 18)

__device__ __forceinline__ unsigned xb_ld(unsigned* p)              { return __hip_atomic_load(p, __ATOMIC_RELAXED, __HIP_MEMORY_SCOPE_AGENT); }
__device__ __forceinline__ unsigned xb_add(unsigned* p, unsigned v) { return __hip_atomic_fetch_add(p, v, __ATOMIC_RELAXED, __HIP_MEMORY_SCOPE_AGENT); }
__device__ __forceinline__ unsigned xb_xcc_id() { return (unsigned)__builtin_amdgcn_s_getreg((3 << 11) | 20) & 0xFu; }
#define XB_SPIN(cond, bar) do { unsigned _sp = 0; while (cond) { __builtin_amdgcn_s_sleep(1); \
    if ((++_sp & 255u) == 0u) { if (xb_ld(&(bar)[XB_TMO])) break; if (_sp > XB_SPIN_CAP) { atomicAdd(&(bar)[XB_TMO], 1u); break; } } } } while (0)

struct XcdBarrier {
    unsigned* bar; unsigned x;
    volatile LAS unsigned* st;
};

__device__ __forceinline__ XcdBarrier xcd_barrier_post(unsigned* bar, volatile LAS unsigned* st) {
    XcdBarrier b; b.bar = bar; b.x = xb_xcc_id(); b.st = st;
    if (threadIdx.x == 0) (void)xb_add(&bar[XB_XCNT(b.x)], 1u);
    return b;
}
__device__ __forceinline__ void xcd_barrier_complete(unsigned* bar, unsigned x, unsigned& nloc, unsigned& nx) {
    const unsigned G = gridDim.x * gridDim.y * gridDim.z;
    unsigned sum, cnt, mine, sp = 0u;
    for (;;) {
        sum = 0u; cnt = 0u; mine = 0u;
#pragma unroll
        for (unsigned j = 0; j < 16; ++j) { const unsigned c = xb_ld(&bar[XB_XCNT(j)]); sum += c; cnt += (c > 0u) ? 1u : 0u; mine = (j == x) ? c : mine; }
        if (sum == G) break;
        __builtin_amdgcn_s_sleep(1);
        if ((++sp & 255u) == 0u) { if (xb_ld(&bar[XB_TMO])) break; if (sp > XB_SPIN_CAP) { atomicAdd(&bar[XB_TMO], 1u); break; } }
    }
    nloc = mine > 0u ? mine : 1u; nx = cnt > 0u ? cnt : 1u;
}

__device__ __forceinline__ void xcd_barrier(const XcdBarrier& b) {
    asm volatile("s_waitcnt vmcnt(0)" ::: "memory");
    __syncthreads();
    if (threadIdx.x == 0) {
        unsigned* bar = b.bar;
        __builtin_amdgcn_s_waitcnt(0);
        unsigned nloc = b.st[0], nx = b.st[1];
        if (nloc == 0u) { xcd_barrier_complete(bar, b.x, nloc, nx); b.st[0] = nloc; b.st[1] = nx; }
        const unsigned old = xb_add(&bar[XB_XSUB(b.x)], 1u);
        const unsigned gen = old / nloc;
        if (old + 1u == (gen + 1u) * nloc) {
            __builtin_amdgcn_fence(__ATOMIC_RELEASE, "agent");
            asm volatile("s_waitcnt vmcnt(0)" ::: "memory");
            const unsigned og = xb_add(&bar[XB_TOP], 1u);
            const unsigned tg = og / nx;
            if (og + 1u == (tg + 1u) * nx) xb_add(&bar[XB_TOPGEN], 1u);
            else XB_SPIN(xb_ld(&bar[XB_TOPGEN]) == tg, bar);
            __builtin_amdgcn_fence(__ATOMIC_ACQUIRE, "agent");
            xb_add(&bar[XB_XGEN(b.x)], 1u);
            asm volatile("s_waitcnt vmcnt(0)" ::: "memory");
        } else {
            XB_SPIN(xb_ld(&bar[XB_XGEN(b.x)]) == gen, bar);
            __builtin_amdgcn_fence(__ATOMIC_ACQUIRE, "agent");
            asm volatile("s_waitcnt vmcnt(0)" ::: "memory");
        }
    }
    __syncthreads();
}
namespace pg8 {
#define PG8_LAS __attribute__((address_space(3)))
typedef unsigned short bf16_t;
typedef short bf16x8 __attribute__((ext_vector_type(8)));
typedef float f32x4 __attribute__((ext_vector_type(4)));
typedef unsigned u32x4 __attribute__((ext_vector_type(4)));
typedef _Float16 h16x8 __attribute__((ext_vector_type(8)));
constexpr int BM = 256, BK = 64, HALF = 128, HTB = HALF * BK * 2  , STAGE_BYTES = 8 * HTB, NXCD = 8, WGM = 8;

__host__ __device__ __forceinline__ int lds_byte(int r, int c) { const int st = (r >> 4) * 2 + (c >> 5), rr = r & 15, cc = c & 31, ob = rr * 64 + cc * 2; return st * 1024 + (ob ^ (((ob >> 9) & 1) << 5)); }
__host__ __device__ __forceinline__ void stage_rc(int b, int& R, int& C) { const int st = b / 1024, sb = b % 1024, swz = sb ^ (((sb >> 9) & 1) << 5); R = (st >> 1) * 16 + swz / 64; C = (st & 1) * 32 + (swz % 64) / 2; }
__host__ __device__ __forceinline__ int perm32(int rho) { const int n = rho >> 4, i = rho & 15; return 8 * (i >> 2) + 4 * n + (i & 3); }

struct Unit { int pm, pn; };
struct Gemm { const bf16_t* A; const bf16_t* Bt; int M, N, K, lda, ldb; };

struct StaticOrder {
    int nM, nN, nwg, G, c;
    __host__ __device__ void init(int M, int N, int G_, int c_) { nM = M / BM; nN = N / BM; nwg = nM * nN; G = G_; c = c_; }
    __host__ __device__ bool next(int i, Unit& u) const {
        const long L = (long)i * G + c; if (L >= nwg) return false;
        int wgid = (int)L; { const int q = nwg / NXCD, r = nwg % NXCD, xcd = wgid % NXCD, off = wgid / NXCD; wgid = (xcd < r ? xcd * (q + 1) : r * (q + 1) + (xcd - r) * q) + off; }
        const int nig = WGM * nN, gid = wgid / nig, fm = gid * WGM, gsz = (nM - fm) < WGM ? (nM - fm) : WGM;
        u.pm = fm + ((wgid % nig) % gsz); u.pn = (wgid % nig) / gsz; return true;
    }
    __device__ __forceinline__ void a_ready(const Unit&) const {}
    __device__ __forceinline__ void done(const Unit&) const {}
};

__device__ __forceinline__ unsigned cvt_pk_bf16(float lo, float hi) { unsigned r; asm volatile("v_cvt_pk_bf16_f32 %0, %1, %2" : "=v"(r) : "v"(lo), "v"(hi)); return r; }

__device__ __forceinline__ float row_rstd(const unsigned long long* ss, int row, float inv_n) { return 1.0f / sqrtf((float)ss[row] * (inv_n * 9.5367431640625e-07f) + 1e-6f); }
struct RowFac { const PG8_LAS float* tab;
    __device__ __forceinline__ float get(int row) const { return tab[row]; } };
struct EpiStore {
    static constexpr bool PERM = true, AFTER_DRAIN = false;
    bf16_t* O; int ldc; RowFac rf;
    __device__ __forceinline__ void operator()(const f32x4 (&acc)[2][2][4][2], const Unit& u, int wr, int wc, int fr, int fq) const {
        const int row0 = u.pm * BM + wr * 64 + fr, col0 = u.pn * BM + wc * 32 + 8 * fq;
#pragma unroll
        for (int ai = 0; ai < 2; ++ai)
#pragma unroll
            for (int m = 0; m < 4; ++m) { const int row = row0 + ai * HALF + m * 16; bf16_t* rowp = O + (size_t)row * ldc + col0;
                const float rs = rf.get(row);
#pragma unroll
                for (int bj = 0; bj < 2; ++bj) { const f32x4 v0 = acc[ai][bj][m][0] * rs, v1 = acc[ai][bj][m][1] * rs;
                    u32x4 w; w.x = cvt_pk_bf16(v0[0], v0[1]); w.y = cvt_pk_bf16(v0[2], v0[3]); w.z = cvt_pk_bf16(v1[0], v1[1]); w.w = cvt_pk_bf16(v1[2], v1[3]);
                    *(u32x4*)(rowp + bj * HALF) = w; } }
    }
};
struct EpiSwiGLU {
    static constexpr bool PERM = true, AFTER_DRAIN = false;
    bf16_t* O; int ldc; RowFac rf;
    __device__ __forceinline__ void operator()(const f32x4 (&acc)[2][2][4][2], const Unit& u, int wr, int wc, int fr, int fq) const {
        const int row0 = u.pm * BM + wr * 64 + fr, col0 = u.pn * HALF + wc * 32 + 8 * fq;
#pragma unroll
        for (int ai = 0; ai < 2; ++ai)
#pragma unroll
            for (int m = 0; m < 4; ++m) { const int row = row0 + ai * HALF + m * 16; bf16_t* rowp = O + (size_t)row * ldc + col0;
                const float rs = rf.get(row), c1 = rs * -1.4426950408889634f, irs2 = __builtin_amdgcn_rcpf(rs * rs);
                float t[8], h[8];
#pragma unroll
                for (int n = 0; n < 2; ++n)
#pragma unroll
                    for (int i = 0; i < 4; ++i) { t[n * 4 + i] = __builtin_amdgcn_exp2f(acc[ai][0][m][n][i] * c1); h[n * 4 + i] = acc[ai][0][m][n][i] * acc[ai][1][m][n][i]; }
                __builtin_amdgcn_sched_barrier(0);
#pragma unroll
                for (int k = 0; k < 8; ++k) t[k] = __builtin_amdgcn_rcpf(__builtin_fmaf(t[k], irs2, irs2));
                __builtin_amdgcn_sched_barrier(0);
#pragma unroll
                for (int k = 0; k < 8; ++k) h[k] *= t[k];
                u32x4 w; w.x = cvt_pk_bf16(h[0], h[1]); w.y = cvt_pk_bf16(h[2], h[3]); w.z = cvt_pk_bf16(h[4], h[5]); w.w = cvt_pk_bf16(h[6], h[7]);
                *(u32x4*)rowp = w; }
    }
};
struct EpiResid {
    static constexpr bool PERM = true, AFTER_DRAIN = false;
    bf16_t* xb; unsigned long long* ssn; int ldc; float alpha;
    __device__ __forceinline__ void operator()(const f32x4 (&acc)[2][2][4][2], const Unit& u, int wr, int wc, int fr, int fq) const {
        const int row0 = u.pm * BM + wr * 64 + fr, col0 = u.pn * BM + wc * 32 + 8 * fq;
        u32x4 old[2][4][2];
#pragma unroll
        for (int ai = 0; ai < 2; ++ai)
#pragma unroll
            for (int m = 0; m < 4; ++m)
#pragma unroll
                for (int bj = 0; bj < 2; ++bj) old[ai][m][bj] = *(const u32x4*)(xb + (size_t)(row0 + ai * HALF + m * 16) * ldc + col0 + bj * HALF);
#pragma unroll
        for (int ai = 0; ai < 2; ++ai)
#pragma unroll
            for (int m = 0; m < 4; ++m) { const int row = row0 + ai * HALF + m * 16; bf16_t* rowp = xb + (size_t)row * ldc + col0; float sq = 0.f;
#pragma unroll
                for (int bj = 0; bj < 2; ++bj) { const u32x4 b = old[ai][m][bj];
                    float v[8];
#pragma unroll
                    for (int e = 0; e < 4; ++e) { v[2 * e] = __builtin_bit_cast(float, b[e] << 16) + acc[ai][bj][m][e >> 1][2 * (e & 1)] * alpha;
                                                  v[2 * e + 1] = __builtin_bit_cast(float, b[e] & 0xffff0000u) + acc[ai][bj][m][e >> 1][2 * (e & 1) + 1] * alpha; }
#pragma unroll
                    for (int e = 0; e < 8; ++e) sq += v[e] * v[e];
                    u32x4 w; w.x = cvt_pk_bf16(v[0], v[1]); w.y = cvt_pk_bf16(v[2], v[3]); w.z = cvt_pk_bf16(v[4], v[5]); w.w = cvt_pk_bf16(v[6], v[7]);
                    *(u32x4*)(rowp + bj * HALF) = w; }
                sq += __shfl_xor(sq, 16); sq += __shfl_xor(sq, 32);
                if (fq == 0) __hip_atomic_fetch_add(ssn + row, (unsigned long long)(sq * 1048576.0f + 0.5f), __ATOMIC_RELAXED, __HIP_MEMORY_SCOPE_AGENT); }
    }
};

template <class Epi, class Sched, bool ALIGN_EPI = false, bool SP2 = false, bool F16 = false>
__device__ __forceinline__ void gemm_phase(PG8_LAS unsigned char* lds, const Gemm g, const Sched& S, const Epi& E) {
    __builtin_amdgcn_s_waitcnt(0);
    int tid_l = threadIdx.x; asm volatile("" : "+v"(tid_l));
    const int tid = tid_l, wid = __builtin_amdgcn_readfirstlane(tid >> 6), lane = tid & 63, wr = wid >> 2, wc = wid & 3, fr = lane & 15, fq = lane >> 4;
    const int K = g.K, nt = K / BK, lda = g.lda, ldb = g.ldb;
    unsigned voffA[2], voffB[2];
#pragma unroll
    for (int i = 0; i < 2; ++i) { int R, C; stage_rc(tid * 16 + i * 8192, R, C); const int Rb = Epi::PERM ? ((R & ~31) + perm32(R & 31)) : R;
        voffA[i] = (unsigned)(R * lda + C) * 2u; voffB[i] = (unsigned)(Rb * ldb + C) * 2u; }
    const size_t kstep = (size_t)(BK * 2);
    const size_t hstepA = (size_t)HALF * lda * 2, hstepB = (size_t)HALF * ldb * 2;
    const size_t tstepA = 2 * hstepA, tstepB = 2 * hstepB;
    const unsigned ldsw = (unsigned)wid * 1024u;
    const int aoff = lds_byte(wr * 64 + fr, fq * 8), boff = lds_byte(wc * 32 + fr, fq * 8);
#define PG8_SA(b, h) (((b) * 2 + (h)) * HTB)
#define PG8_SB(b, h) ((4 + (b) * 2 + (h)) * HTB)
#define PG8_STAGE(bufoff, gbase, voff) do { _Pragma("unroll") for (int _i = 0; _i < 2; ++_i) \
        __builtin_amdgcn_global_load_lds((const unsigned*)((const char*)(gbase) + (voff)[_i]), (PG8_LAS unsigned*)(lds + (bufoff) + ldsw + _i * 8192), 16, 0, 0); } while (0)
#define PG8_LDA(dst, b, h) do { _Pragma("unroll") for (int m = 0; m < 4; ++m) _Pragma("unroll") for (int k = 0; k < 2; ++k) dst[m][k] = *(const PG8_LAS bf16x8*)(lds + PG8_SA(b, h) + aoff + m * 2048 + k * 1024); } while (0)
#define PG8_LDB(dst, b, h) do { _Pragma("unroll") for (int n = 0; n < 2; ++n) _Pragma("unroll") for (int k = 0; k < 2; ++k) dst[n][k] = *(const PG8_LAS bf16x8*)(lds + PG8_SB(b, h) + boff + n * 2048 + k * 1024); } while (0)
#define PG8_MMA(ai, bj, At, Bt) do { __builtin_amdgcn_s_setprio(1); _Pragma("unroll") for (int m = 0; m < 4; ++m) _Pragma("unroll") for (int n = 0; n < 2; ++n) _Pragma("unroll") for (int k = 0; k < 2; ++k) \
        acc[ai][bj][m][n] = F16 ? __builtin_amdgcn_mfma_f32_16x16x32_f16(__builtin_bit_cast(h16x8, Bt[n][k]), __builtin_bit_cast(h16x8, At[m][k]), acc[ai][bj][m][n], 0, 0, 0) \
                                : __builtin_amdgcn_mfma_f32_16x16x32_bf16(Bt[n][k], At[m][k], acc[ai][bj][m][n], 0, 0, 0); __builtin_amdgcn_s_setprio(0); } while (0)
#define PG8_WAIT_V(n) asm volatile("s_waitcnt vmcnt(" #n ")" ::: "memory")
#define PG8_WAIT_L(n) asm volatile("s_waitcnt lgkmcnt(" #n ")" ::: "memory")
#define PG8_BAR __builtin_amdgcn_s_barrier()
#define PG8_SCHED __builtin_amdgcn_sched_barrier(0)
    Unit cur, nxt; int ui = 0;
    if (!S.next(0, cur)) return;
    f32x4 acc[2][2][4][2];
#pragma unroll
    for (int a = 0; a < 2; ++a)
#pragma unroll
        for (int b = 0; b < 2; ++b)
#pragma unroll
            for (int m = 0; m < 4; ++m)
#pragma unroll
                for (int n = 0; n < 2; ++n) acc[a][b][m][n] = (f32x4){0.f, 0.f, 0.f, 0.f};
    bf16x8 At[4][2], B0[2][2], B1[2][2];
    const char* cA = (const char*)g.A + (size_t)cur.pm * tstepA; const char* cB = (const char*)g.Bt + (size_t)cur.pn * tstepB;
    S.a_ready(cur);
    if constexpr (SP2) {
        PG8_STAGE(PG8_SB(0, 0), cB, voffB); PG8_STAGE(PG8_SB(0, 1), cB + hstepB, voffB); PG8_STAGE(PG8_SA(0, 0), cA, voffA); PG8_STAGE(PG8_SA(0, 1), cA + hstepA, voffA);
        if (wr == 1) PG8_BAR;
        PG8_WAIT_V(2); PG8_BAR;
        PG8_STAGE(PG8_SB(1, 0), cB + kstep, voffB); PG8_STAGE(PG8_SA(1, 0), cA + kstep, voffA); PG8_STAGE(PG8_SB(1, 1), cB + hstepB + kstep, voffB);
        PG8_WAIT_V(6); PG8_BAR;
    } else {
        PG8_STAGE(PG8_SB(0, 0), cB, voffB); PG8_STAGE(PG8_SA(0, 0), cA, voffA); PG8_STAGE(PG8_SB(0, 1), cB + hstepB, voffB); PG8_STAGE(PG8_SA(0, 1), cA + hstepA, voffA);
        if (wr == 1) PG8_BAR;
        PG8_WAIT_V(4); PG8_BAR;
        PG8_STAGE(PG8_SB(1, 0), cB + kstep, voffB); PG8_STAGE(PG8_SA(1, 0), cA + kstep, voffA); PG8_STAGE(PG8_SB(1, 1), cB + hstepB + kstep, voffB);
        PG8_WAIT_V(6); PG8_BAR;
    }
    for (;;) {
        const bool has_next = S.next(ui + 1, nxt);
        const char* nA = has_next ? (const char*)g.A + (size_t)nxt.pm * tstepA : cA; const char* nB = has_next ? (const char*)g.Bt + (size_t)nxt.pn * tstepB : cB;
        for (int t = 0; t < nt; t += 2) {
            const bool last = (t == nt - 2);
            const char* a1 = cA + (size_t)(t + 1) * kstep;
            const char* a2 = last ? nA : cA + (size_t)(t + 2) * kstep; const char* b2 = last ? nB : cB + (size_t)(t + 2) * kstep;
            const char* a3 = a2 + kstep; const char* b3 = b2 + kstep;
            if (last && has_next) S.a_ready(nxt);
            if constexpr (SP2) {
            PG8_LDB(B0, 0, 0); PG8_LDB(B1, 0, 1); PG8_SCHED; PG8_LDA(At, 0, 0); PG8_STAGE(PG8_SA(1, 1), a1 + hstepA, voffA);
            PG8_WAIT_V(8); PG8_WAIT_L(0); PG8_BAR; PG8_MMA(0, 0, At, B0); PG8_MMA(0, 1, At, B1); PG8_BAR; PG8_SCHED;
            PG8_LDA(At, 0, 1); PG8_STAGE(PG8_SB(0, 0), b2, voffB); PG8_STAGE(PG8_SB(0, 1), b2 + hstepB, voffB); PG8_STAGE(PG8_SA(0, 0), a2, voffA);
            PG8_WAIT_V(8); PG8_WAIT_L(0); PG8_BAR; PG8_MMA(1, 0, At, B0); PG8_MMA(1, 1, At, B1); PG8_BAR; PG8_SCHED;
            PG8_LDB(B0, 1, 0); PG8_LDB(B1, 1, 1); PG8_SCHED; PG8_LDA(At, 1, 0); PG8_STAGE(PG8_SA(0, 1), a2 + hstepA, voffA);
            PG8_WAIT_V(8); PG8_WAIT_L(0); PG8_BAR; PG8_MMA(0, 0, At, B0); PG8_MMA(0, 1, At, B1); PG8_BAR; PG8_SCHED;
            PG8_LDA(At, 1, 1); PG8_STAGE(PG8_SB(1, 0), b3, voffB); PG8_STAGE(PG8_SB(1, 1), b3 + hstepB, voffB); PG8_STAGE(PG8_SA(1, 0), a3, voffA);
            PG8_WAIT_V(8); PG8_WAIT_L(0); PG8_BAR; PG8_MMA(1, 0, At, B0); PG8_MMA(1, 1, At, B1); PG8_BAR; PG8_SCHED;
            } else {
            PG8_LDB(B0, 0, 0); PG8_SCHED; PG8_LDA(At, 0, 0); PG8_STAGE(PG8_SA(1, 1), a1 + hstepA, voffA);
            PG8_WAIT_L(8); PG8_BAR; PG8_WAIT_L(0); PG8_MMA(0, 0, At, B0); PG8_BAR; PG8_SCHED;
            PG8_LDB(B1, 0, 1); PG8_STAGE(PG8_SB(0, 0), b2, voffB);
            PG8_BAR; PG8_WAIT_L(0); PG8_MMA(0, 1, At, B1); PG8_BAR;
            PG8_LDA(At, 0, 1); PG8_STAGE(PG8_SA(0, 0), a2, voffA);
            PG8_BAR; PG8_WAIT_L(0); PG8_MMA(1, 0, At, B0); PG8_BAR; PG8_SCHED;
            PG8_STAGE(PG8_SB(0, 1), b2 + hstepB, voffB);
            PG8_WAIT_V(6); PG8_BAR; PG8_MMA(1, 1, At, B1); PG8_BAR;
            PG8_LDB(B0, 1, 0); PG8_SCHED; PG8_LDA(At, 1, 0); PG8_STAGE(PG8_SA(0, 1), a2 + hstepA, voffA);
            PG8_WAIT_L(8); PG8_BAR; PG8_WAIT_L(0); PG8_MMA(0, 0, At, B0); PG8_BAR; PG8_SCHED;
            PG8_LDB(B1, 1, 1); PG8_STAGE(PG8_SB(1, 0), b3, voffB);
            PG8_BAR; PG8_WAIT_L(0); PG8_MMA(0, 1, At, B1); PG8_BAR;
            PG8_LDA(At, 1, 1); PG8_STAGE(PG8_SA(1, 0), a3, voffA);
            PG8_BAR; PG8_WAIT_L(0); PG8_MMA(1, 0, At, B0); PG8_BAR; PG8_SCHED;
            PG8_STAGE(PG8_SB(1, 1), b3 + hstepB, voffB);
            PG8_WAIT_V(6); PG8_BAR; PG8_MMA(1, 1, At, B1); PG8_BAR;
            }
        }
        if constexpr (ALIGN_EPI) { if (wr == 0) PG8_BAR; }
        if constexpr (!Epi::AFTER_DRAIN) { E(acc, cur, wr, wc, fr, fq); S.done(cur); }
        if (!has_next) break;
#pragma unroll
        for (int a = 0; a < 2; ++a)
#pragma unroll
            for (int b = 0; b < 2; ++b)
#pragma unroll
                for (int m = 0; m < 4; ++m)
#pragma unroll
                    for (int n = 0; n < 2; ++n) acc[a][b][m][n] = (f32x4){0.f, 0.f, 0.f, 0.f};
        cur = nxt; cA = nA; cB = nB; ++ui;
        if constexpr (ALIGN_EPI) { if (wr == 1) PG8_BAR; }
    }
    PG8_WAIT_V(0);
    if constexpr (!ALIGN_EPI) { if (wr == 0) PG8_BAR; }
    PG8_BAR;
    if constexpr (Epi::AFTER_DRAIN) { E.fused(acc, cur, wr, wc, fr, fq, lds, wid, lane); S.done(cur); }
#undef PG8_SA
#undef PG8_SB
#undef PG8_STAGE
#undef PG8_LDA
#undef PG8_LDB
#undef PG8_MMA
#undef PG8_WAIT_V
#undef PG8_WAIT_L
#undef PG8_BAR
#undef PG8_SCHED
}
}
#ifndef PG8_SP2
#define PG8_SP2 true
#endif
#ifndef PG8_ALIGN
#define PG8_ALIGN true
#endif
namespace att {
constexpr int KSTR = 400, VSTR = 320;
constexpr int KBUF = 64 * KSTR, VBUF = 64 * VSTR;
constexpr int OFF_K = 0, OFF_V = 2 * KBUF, OFF_WS = OFF_V + 2 * VBUF, LDS_NEED = OFF_WS + NWAVES * 256;
constexpr float C2 = 0.07216878364870322f * 1.4426950408889634f;
static_assert(LDS_NEED <= RING_BYTES, "attention LDS");
typedef float f32x2_t __attribute__((ext_vector_type(2))); typedef __bf16 bf16x2_t __attribute__((ext_vector_type(2)));
typedef short v4i16_t __attribute__((ext_vector_type(4)));
__device__ __forceinline__ unsigned cvtpk(float lo, float hi) { f32x2_t v = {lo, hi}; bf16x2_t b = __builtin_convertvector(v, bf16x2_t); return __builtin_bit_cast(unsigned, b); }
__device__ __forceinline__ s16x4 trd(const LAS unsigned char* p) { return __builtin_bit_cast(s16x4, __builtin_amdgcn_ds_read_tr16_b64_v4i16((LAS v4i16_t*)p)); }
__device__ __forceinline__ int crow(int r, int hi) { return (r & 3) + 8 * (r >> 2) + 4 * hi; }
#define ATT_MFMA(a, b, c) __builtin_amdgcn_mfma_f32_32x32x16_bf16((a), (b), (c), 0, 0, 0)

__device__ __forceinline__ void attn_block(int b, int h, int qb, const bf16* __restrict__ Q, const bf16* __restrict__ KV, const bf16* __restrict__ KPE, const float* __restrict__ cosT, const float* __restrict__ sinT, bf16* __restrict__ MIXo, LAS unsigned char* lds) {
    int tid_l = threadIdx.x; asm volatile("" : "+v"(tid_l));
    const int tid = tid_l, lane = tid & 63, c = lane & 31, hi = lane >> 5;
    const int wid = __builtin_amdgcn_readfirstlane(tid >> 6);
    const size_t rowbase = (size_t)b * SEQ; const int q0 = qb * 256, qlo = q0 + wid * 32;
    const int NT = 4 * qb + 4;
    const bf16* qrow = Q + (rowbase + qlo + c) * QW + h * QKD + 8 * hi;
    bf16x8 qr[12];
#pragma unroll
    for (int d = 0; d < 12; ++d) qr[d] = *(const bf16x8*)(qrow + 16 * d);
    {
        const float* ct = cosT + (rowbase + qlo + c) * 32 + 4 * hi; const float* st = sinT + (rowbase + qlo + c) * 32 + 4 * hi;
#pragma unroll
        for (int dd = 0; dd < 4; ++dd) { const f32x4 cs = *(const f32x4*)(ct + 8 * dd), sn = *(const f32x4*)(st + 8 * dd);
            v4u w = __builtin_bit_cast(v4u, qr[8 + dd]);
#pragma unroll
            for (int e = 0; e < 4; ++e) { const float x1 = bflo(w[e]), x2 = bfhi(w[e]); w[e] = cvtpk(x1 * cs[e] - x2 * sn[e], x2 * cs[e] + x1 * sn[e]); }
            qr[8 + dd] = __builtin_bit_cast(bf16x8, w); }
    }
    const int kkey = tid >> 4, kch = tid & 15, pkey = tid >> 3, pch = tid & 7;
    const bf16* gk = KV + (rowbase + kkey) * KVW + h * 256 + kch * 8;
    const bf16* gv = gk + 128;
    const bf16* gp = KPE + (rowbase + pkey) * 64 + pch * 8;
    const int lk0 = kkey * KSTR + kch * 16, lk1 = lk0 + 32 * KSTR, lp = pkey * KSTR + 256 + pch * 16;
    const int lv0 = kkey * VSTR + kch * 16, lv1 = lv0 + 32 * VSTR;
    v4u sk0, sk1, sp, sv0, sv1;
#define ATT_LOAD(t) do { const size_t o_ = (size_t)(t) * 64 * KVW; sk0 = *(const v4u*)(gk + o_); sk1 = *(const v4u*)(gk + o_ + 32 * KVW); \
        sv0 = *(const v4u*)(gv + o_); sv1 = *(const v4u*)(gv + o_ + 32 * KVW); sp = *(const v4u*)(gp + (size_t)(t) * 64 * 64); } while (0)
#define ATT_WRITE(bi) do { LAS unsigned char* kb_ = lds + OFF_K + (bi) * KBUF; LAS unsigned char* vb_ = lds + OFF_V + (bi) * VBUF; \
        *(LAS v4u*)(kb_ + lk0) = sk0; *(LAS v4u*)(kb_ + lk1) = sk1; *(LAS v4u*)(kb_ + lp) = sp; *(LAS v4u*)(vb_ + lv0) = sv0; *(LAS v4u*)(vb_ + lv1) = sv1; } while (0)
    LAS float* wsf = (LAS float*)(lds + OFF_WS) + wid * 64;
    float m_run = -1e30f, l_run = 0.f;
    f32x16 o[4];
#pragma unroll
    for (int d0 = 0; d0 < 4; ++d0)
#pragma unroll
        for (int r = 0; r < 16; ++r) o[d0][r] = 0.f;
    const int i16 = lane & 15, qq = i16 >> 2, pp = i16 & 3, blk = (lane >> 4) & 1;
    const int voff = (4 * hi + qq) * VSTR + 32 * blk + 8 * pp;
    const int koff = c * KSTR + hi * 16;
    ATT_LOAD(0); ATT_WRITE(0); __syncthreads();
    for (int t = 0; t < NT; ++t) {
        const int cur = t & 1, kb0 = 64 * t;
        if (t + 1 < NT) ATT_LOAD(t + 1);
        if (kb0 <= qlo + 31) {
            f32x16 p0, p1;
#pragma unroll
            for (int r = 0; r < 16; ++r) { p0[r] = 0.f; p1[r] = 0.f; }
            const LAS unsigned char* kp = lds + OFF_K + cur * KBUF + koff;
#pragma unroll
            for (int dg = 0; dg < 3; ++dg) {
                bf16x8 k0[4], k1[4];
#pragma unroll
                for (int j = 0; j < 4; ++j) { k0[j] = *(const LAS bf16x8*)(kp + (4 * dg + j) * 32); k1[j] = *(const LAS bf16x8*)(kp + 32 * KSTR + (4 * dg + j) * 32); }
                __builtin_amdgcn_sched_barrier(0);
#pragma unroll
                for (int j = 0; j < 4; ++j) { p0 = ATT_MFMA(k0[j], qr[4 * dg + j], p0); p1 = ATT_MFMA(k1[j], qr[4 * dg + j], p1); }
            }
            if (kb0 + 63 > qlo) {
                const int dq = qlo + c - kb0 - 4 * hi; const float NEG = -__builtin_inff();
#pragma unroll
                for (int r = 0; r < 16; ++r) { const int cr = (r & 3) + 8 * (r >> 2); if (cr > dq) p0[r] = NEG; if (cr + 32 > dq) p1[r] = NEG; }
            }
            float mx = p0[0];
#pragma unroll
            for (int r = 1; r < 16; ++r) mx = fmaxf(mx, p0[r]);
#pragma unroll
            for (int r = 0; r < 16; ++r) mx = fmaxf(mx, p1[r]);
            mx = fmaxf(mx, __shfl_xor(mx, 32));
            float mn = m_run, alpha = 1.0f;
            if (!__all((mx - m_run) * C2 <= 6.0f)) { mn = fmaxf(m_run, mx); alpha = __builtin_amdgcn_exp2f((m_run - mn) * C2); m_run = mn; }
            const float mnc = mn * C2;
            float rs = 0.f;
#pragma unroll
            for (int r = 0; r < 16; ++r) { p0[r] = __builtin_amdgcn_exp2f(p0[r] * C2 - mnc); p1[r] = __builtin_amdgcn_exp2f(p1[r] * C2 - mnc); rs += p0[r] + p1[r]; }
            rs += __shfl_xor(rs, 32);
            l_run = l_run * alpha + rs;
            if (__any(alpha < 1.0f)) {
                if (hi == 0) wsf[c] = alpha;
                LDS_WAIT();
#pragma unroll
                for (int r = 0; r < 16; ++r) { const float a = wsf[crow(r, hi)];
#pragma unroll
                    for (int d0 = 0; d0 < 4; ++d0) o[d0][r] *= a; }
            }
            const LAS unsigned char* vp = lds + OFF_V + cur * VBUF + voff;
#pragma unroll
            for (int kb = 0; kb < 2; ++kb)
#pragma unroll
                for (int s = 0; s < 2; ++s) {
                    v4u pw;
                    if (kb == 0) { pw.x = cvtpk(p0[8 * s + 0], p0[8 * s + 1]); pw.y = cvtpk(p0[8 * s + 2], p0[8 * s + 3]); pw.z = cvtpk(p0[8 * s + 4], p0[8 * s + 5]); pw.w = cvtpk(p0[8 * s + 6], p0[8 * s + 7]); }
                    else         { pw.x = cvtpk(p1[8 * s + 0], p1[8 * s + 1]); pw.y = cvtpk(p1[8 * s + 2], p1[8 * s + 3]); pw.z = cvtpk(p1[8 * s + 4], p1[8 * s + 5]); pw.w = cvtpk(p1[8 * s + 6], p1[8 * s + 7]); }
                    const bf16x8 pa = __builtin_bit_cast(bf16x8, pw);
                    s16x4 lo[4], hh[4];
#pragma unroll
                    for (int d0 = 0; d0 < 4; ++d0) { lo[d0] = trd(vp + (32 * kb + 16 * s) * VSTR + 64 * d0); hh[d0] = trd(vp + (32 * kb + 16 * s + 8) * VSTR + 64 * d0); }
                    __builtin_amdgcn_sched_barrier(0);
#pragma unroll
                    for (int d0 = 0; d0 < 4; ++d0) o[d0] = ATT_MFMA(pa, __builtin_shufflevector(lo[d0], hh[d0], 0, 1, 2, 3, 4, 5, 6, 7), o[d0]);
                }
        }
        if (t + 1 < NT) ATT_WRITE(cur ^ 1);
        __syncthreads();
    }
    if (hi == 0) wsf[32 + c] = l_run;
    LDS_WAIT();
    bf16* ob = MIXo + (rowbase + qlo) * 4096 + h * 128 + c;
#pragma unroll
    for (int r = 0; r < 16; ++r) { const int orow = crow(r, hi); const float rl = 1.0f / wsf[32 + orow];
#pragma unroll
        for (int d0 = 0; d0 < 4; ++d0) { const float v = o[d0][r] * rl, vn = __shfl_xor(v, 1);
            if ((c & 1) == 0) *(unsigned*)(ob + (size_t)orow * 4096 + d0 * 32) = pk2(v, vn); } }
    LDS_WAIT();
#undef ATT_LOAD
#undef ATT_WRITE
}
}
namespace ssd {
constexpr int RS = 272;
constexpr int BUF = 128 * RS + 128 * 64 + 2560;
constexpr int OFF_X = 128 * RS, OFF_SC = OFF_X + 128 * 64, OFF_S = 2 * BUF;
constexpr int SC_ACS = 0, SC_DT = 512, SC_ECS = 1024, SC_WEND = 1536, SC_ETOT = 2048, LDS_NEED = OFF_S + 2 * 32 * RS;
static_assert(LDS_NEED <= RING_BYTES && BUF % 16 == 0, "ssd LDS");
constexpr float LOG2E = 1.4426950408889634f;
#define SSD_MFMA(a, b, c) __builtin_amdgcn_mfma_f32_32x32x16_bf16((a), (b), (c), 0, 0, 0)
#define SSD_BAR() do { asm volatile("s_waitcnt lgkmcnt(0)" ::: "memory"); __builtin_amdgcn_s_barrier(); asm volatile("" ::: "memory"); } while (0)

__device__ __forceinline__ void ssd_unit(int unit, const bf16* __restrict__ XBC, const float* __restrict__ DT, const bf16* __restrict__ PROJ, const float* a_log, const float* d_skip,
                                         bf16* __restrict__ MIXo, LAS unsigned char* lds) {
    int tid_l = threadIdx.x; asm volatile("" : "+v"(tid_l));
    const int tid = tid_l, lane = tid & 63, c = lane & 31, hi = lane >> 5;
    const int wid = __builtin_amdgcn_readfirstlane(tid >> 6);
    const int b = unit >> 6, h = (unit >> 1) & 31, ph = unit & 1, g = h >> 2, pcol0 = h * 64 + 32 * ph;
    const float A2 = -expf(a_log[h]) * LOG2E, Dk = d_skip[h];
    const size_t mb = (size_t)b * SEQ;
    LAS unsigned char* Ss = lds + OFF_S;
    const int srow = tid >> 4, sch = tid & 15, xrow = tid >> 2, xch = tid & 3;
    const bf16* gB = XBC + (mb + srow) * 4096 + 2048 + g * 128 + sch * 8;
    const bf16* gX = XBC + (mb + xrow) * 4096 + pcol0 + xch * 8;
    const float* gD = DT + (mb + 2 * lane) * 32 + h;
    const bf16* gCf = XBC + (mb + 32 * (wid & 3) + c) * 4096 + 3072 + g * 128 + 8 * hi;
    const int lcb = srow * RS + sch * 16, lx = OFF_X + xrow * 64 + xch * 16;
    v4u sb0, sb1, sb2, sb3, sx; float sd0 = 0.f, sd1 = 0.f;
#define SSD_LOAD(ch) do { const size_t o_ = (size_t)(ch) * 128 * 4096; \
        sb0 = *(const v4u*)(gB + o_); sb1 = *(const v4u*)(gB + o_ + 32 * 4096); sb2 = *(const v4u*)(gB + o_ + 64 * 4096); sb3 = *(const v4u*)(gB + o_ + 96 * 4096); \
        sx = *(const v4u*)(gX + o_); if (wid == 0) { sd0 = gD[(size_t)(ch) * 128 * 32]; sd1 = gD[(size_t)(ch) * 128 * 32 + 32]; } } while (0)
#define SSD_WRITE(bufp) do { LAS unsigned char* wb_ = (bufp); \
        *(LAS v4u*)(wb_ + lcb) = sb0; *(LAS v4u*)(wb_ + lcb + 32 * RS) = sb1; *(LAS v4u*)(wb_ + lcb + 64 * RS) = sb2; *(LAS v4u*)(wb_ + lcb + 96 * RS) = sb3; \
        *(LAS v4u*)(wb_ + lx) = sx; \
        if (wid == 0) {     \
            LAS float* sc_ = (LAS float*)(wb_ + OFF_SC); \
            const float a0_ = sd0 * A2, a1_ = sd1 * A2, pr_ = a0_ + a1_; float inc_ = pr_; \
            _Pragma("unroll") for (int o_ = 1; o_ < 64; o_ <<= 1) { const float v_ = __shfl_up(inc_, o_); if (lane >= o_) inc_ += v_; } \
            const float cs0_ = inc_ - pr_ + a0_, cs1_ = inc_, tot_ = __shfl(inc_, 63); \
            *(LAS f32x2*)(sc_ + SC_ACS / 4 + 2 * lane) = (f32x2){cs0_, cs1_}; *(LAS f32x2*)(sc_ + SC_DT / 4 + 2 * lane) = (f32x2){sd0, sd1}; \
            *(LAS f32x2*)(sc_ + SC_ECS / 4 + 2 * lane) = (f32x2){__builtin_amdgcn_exp2f(cs0_), __builtin_amdgcn_exp2f(cs1_)}; \
            *(LAS f32x2*)(sc_ + SC_WEND / 4 + 2 * lane) = (f32x2){sd0 * __builtin_amdgcn_exp2f(tot_ - cs0_), sd1 * __builtin_amdgcn_exp2f(tot_ - cs1_)}; \
            if (lane == 63) sc_[SC_ETOT / 4] = __builtin_amdgcn_exp2f(tot_); } } while (0)
    const int i16 = lane & 15, qq = i16 >> 2, pp = i16 & 3, blk = (lane >> 4) & 1;
    f32x16 ST;
#pragma unroll
    for (int r = 0; r < 16; ++r) ST[r] = 0.f;
    bf16x8 cfn[8];
#pragma unroll
    for (int ks = 0; ks < 8; ++ks) cfn[ks] = *(const bf16x8*)(gCf + 16 * ks);
    SSD_LOAD(0); SSD_WRITE(lds);
    for (int i = tid; i < (32 * RS) / 16; i += NTHREADS) *(LAS v4u*)(Ss + i * 16) = (v4u){0u, 0u, 0u, 0u};
    SSD_BAR();
    for (int ch = 0; ch < SEQ / 128; ++ch) {
        const int chn = ch + 1 < SEQ / 128 ? ch + 1 : ch;
        SSD_LOAD(chn);
        const size_t m0 = mb + (size_t)ch * 128;
        LAS unsigned char* cb = lds + (ch & 1) * BUF;
        LAS unsigned char* Bs = cb; LAS unsigned char* Xs = cb + OFF_X;
        LAS float* acs = (LAS float*)(cb + OFF_SC + SC_ACS); LAS float* dtv = (LAS float*)(cb + OFF_SC + SC_DT); LAS float* ecs = (LAS float*)(cb + OFF_SC + SC_ECS);
        LAS float* wend = (LAS float*)(cb + OFF_SC + SC_WEND); LAS float* etot = (LAS float*)(cb + OFF_SC + SC_ETOT);
        if (wid < 4) {
            const int lb = wid;
            unsigned short zr[16];
            { const bf16* zp = PROJ + (m0 + 32 * lb + 4 * hi) * INCP + O_Z + pcol0 + c;
#pragma unroll
              for (int r = 0; r < 16; ++r) zr[r] = zp[(size_t)((r & 3) + 8 * (r >> 2)) * INCP]; }
            bf16x8 cf[8];
#pragma unroll
            for (int ks = 0; ks < 8; ++ks) cf[ks] = cfn[ks];
#pragma unroll
            for (int ks = 0; ks < 8; ++ks) cfn[ks] = *(const bf16x8*)(gCf + (size_t)chn * 128 * 4096 + 16 * ks);
            f32x16 y;
#pragma unroll
            for (int r = 0; r < 16; ++r) y[r] = 0.f;
            { const LAS unsigned char* sp = Ss + (ch & 1) * 32 * RS + c * RS + hi * 16; bf16x8 sf[8];
#pragma unroll
              for (int ks = 0; ks < 8; ++ks) sf[ks] = *(const LAS bf16x8*)(sp + ks * 32);
              __builtin_amdgcn_sched_barrier(0);
#pragma unroll
              for (int ks = 0; ks < 8; ++ks) y = SSD_MFMA(cf[ks], sf[ks], y); }
#pragma unroll
            for (int g4 = 0; g4 < 4; ++g4) { const f32x4 e = *(const LAS f32x4*)(ecs + 32 * lb + 8 * g4 + 4 * hi);
#pragma unroll
                for (int i = 0; i < 4; ++i) y[4 * g4 + i] *= e[i]; }
            const float acl = acs[32 * lb + c];
            for (int sb = 0; sb <= lb; ++sb) {
                f32x16 gt;
#pragma unroll
                for (int r = 0; r < 16; ++r) gt[r] = 0.f;
                const LAS unsigned char* bp = Bs + (32 * sb + c) * RS + hi * 16;
                const LAS unsigned char* xp0 = Xs + (32 * sb + 4 * hi + qq) * 64 + (16 * blk + 4 * pp) * 2;
                const s16x4 xl0 = att::trd(xp0), xh0 = att::trd(xp0 + 8 * 64), xl1 = att::trd(xp0 + 16 * 64), xh1 = att::trd(xp0 + 24 * 64);
#pragma unroll
                for (int kg = 0; kg < 2; ++kg) { bf16x8 bfr[4];
#pragma unroll
                    for (int k4 = 0; k4 < 4; ++k4) bfr[k4] = *(const LAS bf16x8*)(bp + (4 * kg + k4) * 32);
                    __builtin_amdgcn_sched_barrier(0);
#pragma unroll
                    for (int k4 = 0; k4 < 4; ++k4) gt = SSD_MFMA(bfr[k4], cf[4 * kg + k4], gt); }
                const int dl = 32 * (lb - sb) + c - 4 * hi;
#pragma unroll
                for (int gh = 0; gh < 2; ++gh) { f32x4 as4[2], ds4[2];
#pragma unroll
                    for (int g2 = 0; g2 < 2; ++g2) { as4[g2] = *(const LAS f32x4*)(acs + 32 * sb + 8 * (2 * gh + g2) + 4 * hi); ds4[g2] = *(const LAS f32x4*)(dtv + 32 * sb + 8 * (2 * gh + g2) + 4 * hi); }
#pragma unroll
                    for (int g2 = 0; g2 < 2; ++g2) { const int g4 = 2 * gh + g2;
#pragma unroll
                        for (int i = 0; i < 4; ++i) { const float w = __builtin_amdgcn_exp2f(fminf(acl - as4[g2][i], 0.f)) * ds4[g2][i]; gt[4 * g4 + i] = (8 * g4 + i <= dl) ? gt[4 * g4 + i] * w : 0.f; } } }
#pragma unroll
                for (int s2 = 0; s2 < 2; ++s2) {
                    v4u pw; pw.x = att::cvtpk(gt[8 * s2 + 0], gt[8 * s2 + 1]); pw.y = att::cvtpk(gt[8 * s2 + 2], gt[8 * s2 + 3]); pw.z = att::cvtpk(gt[8 * s2 + 4], gt[8 * s2 + 5]); pw.w = att::cvtpk(gt[8 * s2 + 6], gt[8 * s2 + 7]);
                    const s16x4 lo = s2 ? xl1 : xl0, hh = s2 ? xh1 : xh0;
                    y = SSD_MFMA(__builtin_bit_cast(bf16x8, pw), __builtin_shufflevector(lo, hh, 0, 1, 2, 3, 4, 5, 6, 7), y);
                }
            }
            bf16* op = MIXo + (m0 + 32 * lb + 4 * hi) * 4096 + 2048 + pcol0 + c;
            const LAS unsigned short* xl = (const LAS unsigned short*)(Xs + (32 * lb + 4 * hi) * 64 + 2 * c);
            unsigned short xr[16];
#pragma unroll
            for (int r = 0; r < 16; ++r) xr[r] = xl[((r & 3) + 8 * (r >> 2)) * 32];
            __builtin_amdgcn_sched_barrier(0);
#pragma unroll
            for (int r = 0; r < 16; ++r) { const int lr = (r & 3) + 8 * (r >> 2);
                const float v = (y[r] + Dk * bf1(xr[r])) * silu_f(bf1(zr[r]));
                op[(size_t)lr * 4096] = (bf16)f2bf(v); }
        } else {
            const int nb = wid - 4;
            const float et = etot[0];
#pragma unroll
            for (int r = 0; r < 16; ++r) ST[r] *= et;
            const LAS unsigned char* ap = Bs + (8 * hi + qq) * RS + (32 * nb + 16 * blk + 4 * pp) * 2;
            const LAS unsigned char* xp = Xs + (8 * hi + qq) * 64 + (16 * blk + 4 * pp) * 2;
#pragma unroll
            for (int kg = 0; kg < 2; ++kg) {
                s16x4 alo[4], ahh[4], xlo[4], xhh[4]; f32x4 w0[4], w1[4];
#pragma unroll
                for (int k4 = 0; k4 < 4; ++k4) { const int ks = 4 * kg + k4;
                    alo[k4] = att::trd(ap + 16 * ks * RS); ahh[k4] = att::trd(ap + (16 * ks + 4) * RS);
                    xlo[k4] = att::trd(xp + 16 * ks * 64); xhh[k4] = att::trd(xp + (16 * ks + 4) * 64);
                    w0[k4] = *(const LAS f32x4*)(wend + 16 * ks + 8 * hi); w1[k4] = *(const LAS f32x4*)(wend + 16 * ks + 8 * hi + 4); }
                __builtin_amdgcn_sched_barrier(0);
#pragma unroll
                for (int k4 = 0; k4 < 4; ++k4) {
                    v4u xw;
                    xw.x = att::cvtpk(bf1((bf16)xlo[k4][0]) * w0[k4][0], bf1((bf16)xlo[k4][1]) * w0[k4][1]); xw.y = att::cvtpk(bf1((bf16)xlo[k4][2]) * w0[k4][2], bf1((bf16)xlo[k4][3]) * w0[k4][3]);
                    xw.z = att::cvtpk(bf1((bf16)xhh[k4][0]) * w1[k4][0], bf1((bf16)xhh[k4][1]) * w1[k4][1]); xw.w = att::cvtpk(bf1((bf16)xhh[k4][2]) * w1[k4][2], bf1((bf16)xhh[k4][3]) * w1[k4][3]);
                    ST = SSD_MFMA(__builtin_shufflevector(alo[k4], ahh[k4], 0, 1, 2, 3, 4, 5, 6, 7), __builtin_bit_cast(bf16x8, xw), ST);
                }
            }
            LAS unsigned char* so = Ss + ((ch + 1) & 1) * 32 * RS + c * RS + (32 * nb + 4 * hi) * 2;
#pragma unroll
            for (int g4 = 0; g4 < 4; ++g4) { v2u w; w.x = att::cvtpk(ST[4 * g4], ST[4 * g4 + 1]); w.y = att::cvtpk(ST[4 * g4 + 2], ST[4 * g4 + 3]); *(LAS v2u*)(so + g4 * 16) = w; }
        }
        SSD_WRITE(lds + ((ch + 1) & 1) * BUF);
        SSD_BAR();
    }
    VM_WAIT();
#undef SSD_LOAD
#undef SSD_WRITE
}
}
struct Frame {
    LAS unsigned char* lds;
    volatile LAS unsigned* MISC;
    gu32* ctl;
    int wave;
    int vcu, G;
};

__device__ __forceinline__ void row_copy_ss(const float* xrow, bf16* orow, unsigned long long* ss, int lane) {
    const f32x4* xr = (const f32x4*)xrow + lane;
    f32x4 v[16]; float s = 0.f;
#pragma unroll
    for (int j = 0; j < 16; ++j) { v[j] = xr[64 * j]; s += (v[j].x * v[j].x + v[j].y * v[j].y) + (v[j].z * v[j].z + v[j].w * v[j].w); }
    s = wave_sum(s);
    v2u* o8 = (v2u*)orow + lane;
#pragma unroll
    for (int j = 0; j < 16; ++j) { v2u wb; wb.x = pk2(v[j].x, v[j].y); wb.y = pk2(v[j].z, v[j].w); o8[64 * j] = wb; }
    if (lane == 0) *ss = (unsigned long long)(s * 1048576.0f + 0.5f);
}
__device__ __forceinline__ void rms_row_out(const bf16* xrow, const float* gain, float* orow, int lane) {
    const v4u* xr = (const v4u*)xrow + lane; float v[64]; float s = 0.f;
#pragma unroll
    for (int j = 0; j < 8; ++j) { const v4u w = xr[64 * j];
#pragma unroll
        for (int e = 0; e < 4; ++e) { v[8 * j + 2 * e] = bflo(w[e]); v[8 * j + 2 * e + 1] = bfhi(w[e]); s += v[8 * j + 2 * e] * v[8 * j + 2 * e] + v[8 * j + 2 * e + 1] * v[8 * j + 2 * e + 1]; } }
    const float rstd = 1.0f / sqrtf(wave_sum(s) * (1.0f / DM) + EPS);
#pragma unroll
    for (int j = 0; j < 8; ++j) { const f32x4 g0 = *(const f32x4*)(gain + 512 * j + 8 * lane), g1 = *(const f32x4*)(gain + 512 * j + 8 * lane + 4);
        f32x4 o0, o1;
#pragma unroll
        for (int e = 0; e < 4; ++e) { o0[e] = v[8 * j + e] * rstd * g0[e]; o1[e] = v[8 * j + 4 + e] * rstd * g1[e]; }
        *(f32x4*)(orow + 512 * j + 8 * lane) = o0; *(f32x4*)(orow + 512 * j + 8 * lane + 4) = o1; }
}
__device__ __forceinline__ void prep_rows4(int m0, const bf16* PROJ, const float* cosT, const float* sinT, const float* dt_bias, unsigned long long* SSQ, bf16* KPE, float* DT, int lane) {
    v4u w[4][3]; unsigned short dtr[4];
#pragma unroll
    for (int r = 0; r < 4; ++r) { const bf16* pr = PROJ + (size_t)(m0 + r) * INCP;
        w[r][0] = *(const v4u*)(pr + 8 * lane); w[r][1] = *(const v4u*)(pr + 8 * (64 + lane));
        w[r][2] = lane < 56 ? *(const v4u*)(pr + 8 * (128 + lane)) : (v4u){0u, 0u, 0u, 0u};
        dtr[r] = lane < 32 ? pr[O_DT + lane] : (unsigned short)0; }
#pragma unroll
    for (int r = 0; r < 4; ++r) { const int m = m0 + r;
        float s0 = 0.f, s1 = 0.f, s2 = 0.f;
#pragma unroll
        for (int e = 0; e < 4; ++e) { float a = bflo(w[r][0][e]), b = bfhi(w[r][0][e]); s0 += a * a + b * b; a = bflo(w[r][1][e]); b = bfhi(w[r][1][e]); s1 += a * a + b * b; a = bflo(w[r][2][e]); b = bfhi(w[r][2][e]); s2 += a * a + b * b; }
        const float sq = wave_sum(s0 + (lane < 48 ? s1 : 0.f)), sk = wave_sum((lane < 48 ? 0.f : s1) + (lane < 48 ? s2 : 0.f));
        if (lane == 0) { SSQ[m] = (unsigned long long)(sq * 1048576.0f + 0.5f); SSQ[M + m] = (unsigned long long)(sk * 1048576.0f + 0.5f); }
        if (lane >= 48 && lane < 56) {
            const int ip = 4 * (lane - 48); const f32x4 cs = *(const f32x4*)(cosT + (size_t)m * 32 + ip), sn = *(const f32x4*)(sinT + (size_t)m * 32 + ip);
            v4u o;
#pragma unroll
            for (int e = 0; e < 4; ++e) { const float x1 = bflo(w[r][2][e]), x2 = bfhi(w[r][2][e]); o[e] = pk2(x1 * cs[e] - x2 * sn[e], x2 * cs[e] + x1 * sn[e]); }
            *(v4u*)(KPE + (size_t)m * 64 + 2 * ip) = o; }
        if (lane < 32) { const float v = bf1(dtr[r]) + dt_bias[lane]; DT[(size_t)m * 32 + lane] = fmaxf(v, 0.f) + log1pf(expf(-fabsf(v))); }
    }
}
__device__ __forceinline__ void conv_item(int item, const bf16* PROJ, const float* conv_w, const float* conv_b, bf16* XBC, int lane) {
    const int rr = item >> 3, sl = item & 7, ch0 = sl * 512 + lane * 8, m0 = rr * 32, t0 = m0 & (SEQ - 1);
    const bf16* src = PROJ + (size_t)m0 * INCP + O_XBC + ch0;
    bf16* dst = XBC + (size_t)m0 * 4096 + ch0;
    v4u x[35];
#pragma unroll
    for (int i = 0; i < 3; ++i) x[i] = t0 > 0 ? *(const v4u*)(src + (ptrdiff_t)(i - 3) * INCP) : (v4u){0u, 0u, 0u, 0u};
#pragma unroll
    for (int i = 0; i < 32; ++i) x[3 + i] = *(const v4u*)(src + (size_t)i * INCP);
    float w[4][8], bb[8];
#pragma unroll
    for (int k = 0; k < 4; ++k) { const f32x4 a = *(const f32x4*)(conv_w + k * CONVD + ch0), b2 = *(const f32x4*)(conv_w + k * CONVD + ch0 + 4);
#pragma unroll
        for (int e = 0; e < 4; ++e) { w[k][e] = a[e]; w[k][4 + e] = b2[e]; } }
    { const f32x4 a = *(const f32x4*)(conv_b + ch0), b2 = *(const f32x4*)(conv_b + ch0 + 4);
#pragma unroll
      for (int e = 0; e < 4; ++e) { bb[e] = a[e]; bb[4 + e] = b2[e]; } }
#pragma unroll
    for (int i = 0; i < 32; ++i) { v4u o;
#pragma unroll
        for (int e = 0; e < 4; ++e) {
            const float ya = bb[2 * e] + w[0][2 * e] * bflo(x[i][e]) + w[1][2 * e] * bflo(x[i + 1][e]) + w[2][2 * e] * bflo(x[i + 2][e]) + w[3][2 * e] * bflo(x[i + 3][e]);
            const float yc = bb[2 * e + 1] + w[0][2 * e + 1] * bfhi(x[i][e]) + w[1][2 * e + 1] * bfhi(x[i + 1][e]) + w[2][2 * e + 1] * bfhi(x[i + 2][e]) + w[3][2 * e + 1] * bfhi(x[i + 3][e]);
            o[e] = pk2(silu_f(ya), silu_f(yc)); }
        *(v4u*)(dst + (size_t)i * 4096) = o; }
}
template <int NR> __device__ __forceinline__ void gnorm_rows(bf16* row0, size_t rstride, const float* gw, int lane) {
    v4u w[NR][4];
#pragma unroll
    for (int r = 0; r < NR; ++r) { const v4u* p = (const v4u*)(row0 + r * rstride + 32 * lane);
#pragma unroll
        for (int j = 0; j < 4; ++j) w[r][j] = p[j]; }
    const float* g = gw + 32 * lane;
#pragma unroll
    for (int r = 0; r < NR; ++r) { float s = 0.f;
#pragma unroll
        for (int j = 0; j < 4; ++j)
#pragma unroll
            for (int e = 0; e < 4; ++e) { const float a = bflo(w[r][j][e]), b = bfhi(w[r][j][e]); s += a * a + b * b; }
        s += __shfl_xor(s, 1); s += __shfl_xor(s, 2); s += __shfl_xor(s, 4);
        const float rstd = 1.0f / sqrtf(s * (1.0f / 256.0f) + EPS);
        v4u* p = (v4u*)(row0 + r * rstride + 32 * lane);
#pragma unroll
        for (int j = 0; j < 4; ++j) { v4u o;
#pragma unroll
            for (int e = 0; e < 4; ++e) o[e] = pk2(bflo(w[r][j][e]) * rstd * g[8 * j + 2 * e], bfhi(w[r][j][e]) * rstd * g[8 * j + 2 * e + 1]);
            p[j] = o; } }
}
__device__ __forceinline__ void ssd_item(int item, const bf16* XBC, const float* DT, const bf16* PROJ, const float* a_log, const float* d_skip, bf16* MIXo, int lane) {
    const int pi = lane >> 4, ns = lane & 15;
    const int b = item >> 9, h = (item >> 4) & 31, pq = item & 15, g = h >> 2;
    const float A2 = -expf(a_log[h]) * 1.4426950408889634f, Dk = d_skip[h];
    const int pcol = h * 64 + pq * 4 + pi;
    float st[8];
#pragma unroll
    for (int k = 0; k < 8; ++k) st[k] = 0.f;
    const bf16* xb = XBC + (size_t)b * SEQ * 4096; const float* dtp = DT + (size_t)b * SEQ * 32 + h;
    const bf16* zp = PROJ + (size_t)b * SEQ * INCP + O_Z + pcol; bf16* op = MIXo + (size_t)b * SEQ * 4096 + 2048 + pcol;
#pragma unroll 4
    for (int t = 0; t < SEQ; ++t) {
        const bf16* xr = xb + (size_t)t * 4096;
        const float dtv = dtp[(size_t)t * 32];
        const float xv = bf1(xr[pcol]);
        const v4u Bw = *(const v4u*)(xr + 2048 + g * 128 + ns * 8);
        const v4u Cw = *(const v4u*)(xr + 3072 + g * 128 + ns * 8);
        const float zv = bf1(zp[(size_t)t * INCP]);
        const float dA = __builtin_amdgcn_exp2f(dtv * A2), xdt = dtv * xv;
        float part = 0.f;
#pragma unroll
        for (int e = 0; e < 4; ++e) {
            st[2 * e] = dA * st[2 * e] + xdt * bflo(Bw[e]); part += bflo(Cw[e]) * st[2 * e];
            st[2 * e + 1] = dA * st[2 * e + 1] + xdt * bfhi(Bw[e]); part += bfhi(Cw[e]) * st[2 * e + 1]; }
        part += __shfl_xor(part, 1); part += __shfl_xor(part, 2); part += __shfl_xor(part, 4); part += __shfl_xor(part, 8);
        if (ns == 0) op[(size_t)t * 4096] = (bf16)f2bf((part + Dk * xv) * silu_f(zv));
    }
}
__device__ __forceinline__ int dst_row(int kind, int n) {
    if (kind == 1) return ((n >> 7) << 8) + (n & 127);
    if (kind == 2) return ((n >> 7) << 8) + 128 + (n & 127);
    if (kind == 3) { const int hh = n / QKD, j = n - hh * QKD; if (j < NOPE) return n; const int i = j - NOPE; return hh * QKD + NOPE + (i < 32 ? 2 * i : 2 * (i - 32) + 1); }
    if (kind == 4) { if (n < O_KPE || n >= O_KPE + ROPE) return n; const int i = n - O_KPE; return O_KPE + (i < 32 ? 2 * i : 2 * (i - 32) + 1); }
    return n;
}
__device__ __forceinline__ void p0_transpose_item(const float* W, int K, int N, bf16* WT, int kind, const float* gain, LAS float* scr, int item, int lane) {
    const bool f16w = false;
    const int nblk = N / 32, kb = item / nblk, nb = item - kb * nblk, k0 = 64 * kb, n0 = 32 * nb;
    float v[32];
    const float* wp = W + (size_t)(k0 + (lane >> 5)) * N + n0 + (lane & 31);
#pragma unroll
    for (int i = 0; i < 32; ++i) v[i] = wp[(size_t)(2 * i) * N];
    const int c = lane & 7;
    f32x4 g0 = (f32x4){1.f, 1.f, 1.f, 1.f}, g1 = g0;
    if (gain) { g0 = *(const f32x4*)(gain + k0 + 8 * c); g1 = *(const f32x4*)(gain + k0 + 8 * c + 4); }
#pragma unroll
    for (int i = 0; i < 32; ++i) scr[(2 * i + (lane >> 5)) * 33 + (lane & 31)] = v[i];
    LDS_WAIT(); asm volatile("" ::: "memory");
#pragma unroll
    for (int j = 0; j < 4; ++j) { const int n = (lane >> 3) + 8 * j; const LAS float* s = scr + (8 * c) * 33 + n;
        const float e0 = s[0 * 33] * g0[0], e1 = s[1 * 33] * g0[1], e2 = s[2 * 33] * g0[2], e3 = s[3 * 33] * g0[3], e4 = s[4 * 33] * g1[0], e5 = s[5 * 33] * g1[1], e6 = s[6 * 33] * g1[2], e7 = s[7 * 33] * g1[3];
        v4u o; if (f16w) { o.x = pkh2(e0, e1); o.y = pkh2(e2, e3); o.z = pkh2(e4, e5); o.w = pkh2(e6, e7); } else { o.x = pk2(e0, e1); o.y = pk2(e2, e3); o.z = pk2(e4, e5); o.w = pk2(e6, e7); }
        *(v4u*)(WT + (size_t)dst_row(kind, n0 + n) * K + k0 + 8 * c) = o; }
    LDS_WAIT(); asm volatile("" ::: "memory");
}
struct InPtrs { const float* p[24]; };
#ifndef DEFER_D2
#define DEFER_D2 1
#endif
#ifndef DEFER_WO
#define DEFER_WO 1
#endif
constexpr int IT_FFN = (DM / 64) * (FF / 32);
constexpr int IT_IN = (DM / 64) * (INC / 32);
constexpr int IT_QU = (QL / 64) * (QW / 32);
constexpr int IT_KVU = (KVL / 64) * (KVW / 32);
constexpr int IT_O = (DM / 64) * (DM / 32);
constexpr int IT_LAYER = 6 * IT_FFN + IT_IN + IT_QU + IT_KVU + IT_O;
__device__ __forceinline__ void p0_prologue(Frame& F, const InPtrs& in, unsigned char* ws, int lane) {
    LAS float* scr = (LAS float*)(F.lds + RING_OFF + F.wave * 16384);
    const int gw = F.vcu * NWAVES + F.wave, NGW = F.G * NWAVES;
    for (int it = gw; it < DEPTH * IT_LAYER; it += NGW) {
        const int l = it / IT_LAYER; int r = it - l * IT_LAYER;
        unsigned char* wl = ws + WS_W + (size_t)l * W_LAYER;
        const size_t lFF = (size_t)l * DM * FF;
        if (r < IT_FFN) { p0_transpose_item(in.p[3] + lFF, DM, FF, (bf16*)(wl + W_GU1), 1, in.p[2] + (size_t)l * DM, scr, r, lane); continue; } r -= IT_FFN;
        if (r < IT_FFN) { p0_transpose_item(in.p[4] + lFF, DM, FF, (bf16*)(wl + W_GU1), 2, in.p[2] + (size_t)l * DM, scr, r, lane); continue; } r -= IT_FFN;
        if (r < IT_FFN) { p0_transpose_item(in.p[5] + lFF, FF, DM, (bf16*)(wl + W_D1), 0, nullptr, scr, r, lane); continue; } r -= IT_FFN;
        if (r < IT_IN) { p0_transpose_item(in.p[7] + (size_t)l * DM * INC, DM, INC, (bf16*)(wl + W_IN), 4, in.p[6] + (size_t)l * DM, scr, r, lane); continue; } r -= IT_IN;
        if (r < IT_QU) { p0_transpose_item(in.p[9] + (size_t)l * QL * QW, QL, QW, (bf16*)(wl + W_QU), 3, in.p[8] + (size_t)l * QL, scr, r, lane); continue; } r -= IT_QU;
        if (r < IT_KVU) { p0_transpose_item(in.p[11] + (size_t)l * KVL * KVW, KVL, KVW, (bf16*)(wl + W_KVU), 0, in.p[10] + (size_t)l * KVL, scr, r, lane); continue; } r -= IT_KVU;
        if (r < IT_O) { if (!(DEFER_WO && F.G == 256)) p0_transpose_item(in.p[18] + (size_t)l * DM * DM, DM, DM, (bf16*)(wl + W_O), 0, nullptr, scr, r, lane); continue; } r -= IT_O;
        if (r < IT_FFN) { if (!(l >= 1 && DEFER_D2 >= 2)) p0_transpose_item(in.p[20] + lFF, DM, FF, (bf16*)(wl + W_GU2), 1, in.p[19] + (size_t)l * DM, scr, r, lane); continue; } r -= IT_FFN;
        if (r < IT_FFN) { p0_transpose_item(in.p[21] + lFF, DM, FF, (bf16*)(wl + W_GU2), 2, in.p[19] + (size_t)l * DM, scr, r, lane); continue; } r -= IT_FFN;
        if (DEFER_D2) continue;
        p0_transpose_item(in.p[22] + lFF, FF, DM, (bf16*)(wl + W_D2), 0, nullptr, scr, r, lane);
    }
    const int gt = gw * 64 + lane, NGT = NGW * 64;
    for (int i = gt; i < DEPTH * 16384; i += NGT) { const int l = i >> 14, j = i & 16383;
        *(v4u*)(ws + WS_W + (size_t)l * W_LAYER + W_IN + (size_t)INC * DM * 2 + (size_t)j * 16) = (v4u){0u, 0u, 0u, 0u}; }
    const int* pos = (const int*)in.p[1]; float* cosT = (float*)(ws + WS_COS); float* sinT = (float*)(ws + WS_SIN);
    float invf;
    {   const double y = -(double)(lane & 31) * 0.28782313662425575;
        const double kd = __builtin_rint(y * 1.4426950408889634);
        double r = __builtin_fma(-kd, 0.6931471803691238, y); r = __builtin_fma(-kd, 1.9082149292705877e-10, r);
        double e = 1.0;
#pragma unroll
        for (int k = 18; k >= 1; --k) e = 1.0 + e * r * (1.0 / (double)k);
        invf = (float)__builtin_ldexp(e, (int)kd); }
    for (int i = gt; i < M * 32; i += NGT) { const int m = i >> 5;
        const float ang = (float)pos[m] * invf;
        const double x = (double)ang, n = __builtin_rint(x * 0.15915494309189535);
        double r = __builtin_fma(-n, 6.283185307179586, x); r = __builtin_fma(-n, 2.4492935982947064e-16, r);
        const double r2 = r * r; double sn = 1.0, cs = 1.0;
#pragma unroll
        for (int k = 14; k >= 1; --k) { sn = 1.0 - sn * r2 * (1.0 / (double)((2 * k) * (2 * k + 1))); cs = 1.0 - cs * r2 * (1.0 / (double)((2 * k - 1) * (2 * k))); }
        cosT[i] = (float)cs; sinT[i] = (float)(sn * r); }
    for (int m = gw; m < M; m += NGW) row_copy_ss(in.p[0] + (size_t)m * DM, (bf16*)(ws + WS_XN) + (size_t)m * DM, (unsigned long long*)(ws + WS_SS) + m, lane);
}
#ifndef REP_GEMM
#define REP_GEMM 1
#endif
#ifndef REP_RES
#define REP_RES 1
#endif
#ifndef REP_BAR
#define REP_BAR 0
#endif
#ifndef REP_ATT
#define REP_ATT 1
#endif
#ifndef REP_SSD
#define REP_SSD 1
#endif
#ifndef REP_THIN
#define REP_THIN 1
#endif
#ifndef DBG_EN
#define DBG_EN 0xffff
#endif
constexpr int PH_PER_LAYER = 9, N_PHASES = 1 + PH_PER_LAYER * DEPTH + 1;
struct Args { const float* in[24]; float* out; unsigned char* ws; int ph_lo, ph_hi; };
static_assert(sizeof(Args) == 24 * 8 + 16 + 8, "Args has no holes");

__global__ void __launch_bounds__(NTHREADS, 2) trunk_fwd(Args args) {
    extern __shared__ __attribute__((aligned(16))) unsigned char lds[];
    Frame F;
    F.lds = (LAS unsigned char*)lds;
    F.MISC = (volatile LAS unsigned*)(F.lds + MISC_OFF);
    F.wave = __builtin_amdgcn_readfirstlane(threadIdx.x >> 6);
    F.G = gridDim.x; { const int bx = blockIdx.x; F.vcu = (F.G % 8 == 0) ? (bx % 8) * (F.G / 8) + bx / 8 : bx; }
    unsigned char* ws = args.ws;
    F.ctl = (gu32*)(ws + WS_CTL);
    for (int u = threadIdx.x; u < (LDS_BYTES - LDSCTL_OFF) / 4; u += NTHREADS) ((LAS unsigned*)(F.lds + LDSCTL_OFF))[u] = 0u;
    __syncthreads();
    XcdBarrier bar; bar.bar = (unsigned*)(F.ctl + CW_BAR); bar.x = 0; bar.st = nullptr;
    if (MK_ONE_LAUNCH) bar = xcd_barrier_post((unsigned*)(F.ctl + CW_BAR), F.MISC + 8);
#define GRID_BAR() do { if (MK_ONE_LAUNCH) xcd_barrier(bar); } while (0)
    const int lo = args.ph_lo, hi = args.ph_hi;
#define IN(k) (lo <= (k) && (k) < hi)
#ifndef XBAR
#define XBAR 0
#endif
#define SEAM(k) do { if (IN((k) + 1)) { GRID_BAR(); for (int xb_ = 0; xb_ < XBAR; ++xb_) GRID_BAR(); } } while (0)
#define ROWFAC(ssp_, invn_) ({ LAS float* tab_ = (LAS float*)(F.lds + RSTAB_OFF); const int rb_ = 2048 * ((int)blockIdx.x & 7); int t0_ = threadIdx.x; asm volatile("" : "+v"(t0_)); __syncthreads(); \
        for (int r_ = t0_; r_ < 2048; r_ += NTHREADS) tab_[r_] = pg8::row_rstd((ssp_), rb_ + r_, (invn_)); \
        __syncthreads(); pg8::RowFac rf_; rf_.tab = tab_ - rb_; rf_; })
#define LANE_L() ({ int l_ = threadIdx.x; asm volatile("" : "+v"(l_)); l_ & 63; })
#define PH_VARS() const int ln = LANE_L(); int gw_ = F.vcu * NWAVES + F.wave; asm volatile("" : "+s"(gw_)); const int gw = gw_, NGW = F.G * NWAVES; (void)ln; (void)gw; (void)NGW

    bf16* XB = (bf16*)(ws + WS_XN); bf16* HB = (bf16*)(ws + WS_BIG); bf16* PROJ = (bf16*)(ws + WS_BIG);
    bf16* KPE = (bf16*)(ws + WS_KPE); float* DT = (float*)(ws + WS_DT); unsigned long long* SSQ = (unsigned long long*)(ws + WS_SSQ); unsigned long long* SS = (unsigned long long*)(ws + WS_SS);
    bf16* XBC = (bf16*)(ws + WS_XBC); bf16* QB = (bf16*)(ws + WS_Q); bf16* KVB = (bf16*)(ws + WS_KV); bf16* MIX = (bf16*)(ws + WS_MIX);
    const float* cosT = (const float*)(ws + WS_COS); const float* sinT = (const float*)(ws + WS_SIN);

    if ((DBG_EN & 1) && IN(0)) { PH_VARS(); InPtrs ip;
#pragma unroll
        for (int i = 0; i < 24; ++i) ip.p[i] = args.in[i];
        for (int rep = 0; rep < REP_THIN; ++rep) p0_prologue(F, ip, ws, ln); SEAM(0); }

    for (int l = 0; l < DEPTH; ++l) {
        const int pb = 1 + PH_PER_LAYER * l;
        unsigned char* wl = ws + WS_W + (size_t)l * W_LAYER;
        for (int f = 0; f < 2; ++f) {
            if (f == 1) {
                if ((DBG_EN & 4) && IN(pb + 2)) { PH_VARS(); pg8::Gemm g{XB, (const bf16*)(wl + W_IN), M, INCP, DM, DM, DM}; pg8::StaticOrder S; S.init(M, INCP, F.G, (int)blockIdx.x);
                    pg8::EpiStore E{PROJ, INCP, ROWFAC(SS + (size_t)(3 * l + 1) * M, 1.0f / DM)};
                    for (int rep = 0; rep < REP_GEMM; ++rep) { if (REP_BAR && rep) GRID_BAR(); pg8::gemm_phase<pg8::EpiStore, pg8::StaticOrder, PG8_ALIGN, PG8_SP2>(F.lds + RING_OFF, g, S, E); }
                    if (DEFER_D2 && F.G == 256 && blockIdx.x >= 128) {
                        LAS float* scr = (LAS float*)(F.lds + RING_OFF + F.wave * 16384);
                        bf16* wt = (bf16*)(ws + WS_W + (size_t)l * W_LAYER + W_D2); const float* wsrc = args.in[22] + (size_t)l * DM * FF;
                        for (int it = ((int)blockIdx.x - 128) * NWAVES + F.wave; it < IT_FFN; it += 128 * NWAVES) p0_transpose_item(wsrc, FF, DM, wt, 0, nullptr, scr, it, ln);
                        if (DEFER_WO) { bf16* wo = (bf16*)(ws + WS_W + (size_t)l * W_LAYER + W_O); const float* osrc = args.in[18] + (size_t)l * DM * DM;
                            for (int it = ((int)blockIdx.x - 128) * NWAVES + F.wave; it < IT_O; it += 128 * NWAVES) p0_transpose_item(osrc, DM, DM, wo, 0, nullptr, scr, it, ln); }
                        if (DEFER_D2 >= 2) { bf16* wg = (bf16*)(ws + WS_W + (size_t)(l + 1) * W_LAYER + W_GU2); const float* gsrc = args.in[20] + (size_t)(l + 1) * DM * FF; const float* gg = args.in[19] + (size_t)(l + 1) * DM;
                            for (int it = ((int)blockIdx.x - 128) * NWAVES + F.wave; it < IT_FFN; it += 128 * NWAVES) p0_transpose_item(gsrc, DM, FF, wg, 1, gg, scr, it, ln); }
                    } else if (DEFER_D2 && F.G != 256) {
                        LAS float* scr = (LAS float*)(F.lds + RING_OFF + F.wave * 16384);
                        bf16* wt = (bf16*)(ws + WS_W + (size_t)l * W_LAYER + W_D2); const float* wsrc = args.in[22] + (size_t)l * DM * FF;
                        for (int it = gw; it < IT_FFN; it += NGW) p0_transpose_item(wsrc, FF, DM, wt, 0, nullptr, scr, it, ln);
                        if (DEFER_D2 >= 2) { bf16* wg = (bf16*)(ws + WS_W + (size_t)(l + 1) * W_LAYER + W_GU2); const float* gsrc = args.in[20] + (size_t)(l + 1) * DM * FF; const float* gg = args.in[19] + (size_t)(l + 1) * DM;
                            for (int it = gw; it < IT_FFN; it += NGW) p0_transpose_item(gsrc, DM, FF, wg, 1, gg, scr, it, ln); }
                    }
                    SEAM(pb + 2); }
                if ((DBG_EN & 8) && IN(pb + 3)) { PH_VARS();
                    for (int rep = 0; rep < REP_THIN; ++rep) for (int m = 4 * gw; m < M; m += 4 * NGW) prep_rows4(m, PROJ, cosT, sinT, args.in[14] + (size_t)l * SSD_H, SSQ, KPE, DT, ln);
                    for (int rep = 0; rep < REP_THIN; ++rep) for (int it = gw; it < (M / 32) * 8; it += NGW) conv_item(it, PROJ, args.in[12] + (size_t)l * 4 * CONVD, args.in[13] + (size_t)l * CONVD, XBC, ln);
                    SEAM(pb + 3); }
                if ((DBG_EN & 16) && IN(pb + 4)) { PH_VARS();
                    for (int rep = 0; rep < REP_SSD; ++rep) for (int u = F.vcu; u < BATCH * SSD_H * 2; u += F.G) ssd::ssd_unit(u, XBC, DT, PROJ, args.in[15] + (size_t)l * SSD_H, args.in[16] + (size_t)l * SSD_H, MIX, F.lds + RING_OFF);
                    for (int s2 = 0; s2 < 2; ++s2) {
                        const int kk = s2 ? KVL : QL, nn = s2 ? KVW : QW;
                        pg8::Gemm g{PROJ + (s2 ? O_CKV : O_CQ), (const bf16*)(wl + (s2 ? W_KVU : W_QU)), M, nn, kk, INCP, kk}; pg8::StaticOrder S; S.init(M, nn, F.G, (int)blockIdx.x);
                        pg8::EpiStore E{s2 ? KVB : QB, nn, ROWFAC(SSQ + (size_t)s2 * M, 1.0f / (float)kk)};
                        for (int rep = 0; rep < REP_GEMM; ++rep) { if (REP_BAR && rep) GRID_BAR(); pg8::gemm_phase<pg8::EpiStore, pg8::StaticOrder, PG8_ALIGN, PG8_SP2>(F.lds + RING_OFF, g, S, E); } }
                    SEAM(pb + 4); }
                if ((DBG_EN & 32) && IN(pb + 5)) { PH_VARS();
                    for (int rep = 0; rep < REP_ATT; ++rep) for (int u = F.vcu; u < BATCH * NH * 8; u += F.G) { const int bh = u >> 3, xq = u & 7;
                        att::attn_block(bh >> 4, bh & 15, xq, QB, KVB, KPE, cosT, sinT, MIX, F.lds + RING_OFF);
                        att::attn_block(bh >> 4, bh & 15, 15 - xq, QB, KVB, KPE, cosT, sinT, MIX, F.lds + RING_OFF); }
                    { const float* g = args.in[17] + (size_t)l * SSD_W;
                      for (int m = 4 * gw; m < M; m += 4 * NGW) gnorm_rows<4>(MIX + (size_t)m * 4096 + 2048, 4096, g, ln); }
                    SEAM(pb + 5); }
                if ((DBG_EN & 128) && IN(pb + 6)) { PH_VARS(); pg8::Gemm g{MIX, (const bf16*)(wl + W_O), M, DM, DM, DM, DM}; pg8::StaticOrder S; S.init(M, DM, F.G, (int)blockIdx.x);
                    for (int rep = 0; rep < REP_RES; ++rep) { pg8::EpiResid E{XB, rep ? (unsigned long long*)(ws + WS_SSP) : SS + (size_t)(3 * l + 2) * M, DM, rep == 0 ? 1.0f : 0.0f};
                    pg8::gemm_phase<pg8::EpiResid, pg8::StaticOrder, PG8_ALIGN, PG8_SP2>(F.lds + RING_OFF, g, S, E); }
                    SEAM(pb + 6); }
            }
            const int fb = pb + 7 * f;
            if ((DBG_EN & 512) && IN(fb)) { PH_VARS(); pg8::Gemm g{XB, (const bf16*)(wl + (f ? W_GU2 : W_GU1)), M, 2 * FF, DM, DM, DM}; pg8::StaticOrder S; S.init(M, 2 * FF, F.G, (int)blockIdx.x);
                pg8::EpiSwiGLU E{HB, FF, ROWFAC(SS + (size_t)(3 * l + 2 * f) * M, 1.0f / DM)};
                for (int rep = 0; rep < REP_GEMM; ++rep) { if (REP_BAR && rep) GRID_BAR(); pg8::gemm_phase<pg8::EpiSwiGLU, pg8::StaticOrder, PG8_ALIGN, PG8_SP2>(F.lds + RING_OFF, g, S, E); }
                SEAM(fb); }
            if ((DBG_EN & 1024) && IN(fb + 1)) { PH_VARS(); pg8::Gemm g{HB, (const bf16*)(wl + (f ? W_D2 : W_D1)), M, DM, FF, FF, FF}; pg8::StaticOrder S; S.init(M, DM, F.G, (int)blockIdx.x);
                for (int rep = 0; rep < REP_RES; ++rep) { pg8::EpiResid E{XB, rep ? (unsigned long long*)(ws + WS_SSP) : SS + (size_t)(3 * l + 2 * f + 1) * M, DM, rep == 0 ? 0.5f : 0.0f};
                pg8::gemm_phase<pg8::EpiResid, pg8::StaticOrder, PG8_ALIGN, PG8_SP2>(F.lds + RING_OFF, g, S, E); }
                SEAM(fb + 1); }
        }
    }
    if ((DBG_EN & 2048) && IN(N_PHASES - 1)) { PH_VARS(); for (int m = gw; m < M; m += NGW) rms_row_out(XB + (size_t)m * DM, args.in[23], args.out + (size_t)m * DM, ln); }
#undef IN
#undef SEAM
#undef GRID_BAR
}

extern "C" void kernel_launch(void* const* d_in, const int* in_sizes, int n_in, void* d_out, int out_size, void* d_ws, size_t ws_size, hipStream_t stream) {
    static int grid = 0;
    if (grid == 0) {
        if (n_in != 24 || in_sizes[0] != M * DM || out_size != M * DM || ws_size < WS_END) {
            fprintf(stderr, "kernel_launch: built for 24 inputs, x/out of %d floats, >= %zu bytes of workspace; got n_in %d, in0 %d, out %d, ws %zu; nothing launched\n", M * DM, (size_t)WS_END, n_in, n_in > 0 ? in_sizes[0] : -1, out_size, ws_size);
            grid = -1; return; }
        int dev = 0, cus = 0, per_cu = 0;
        if (hipGetDevice(&dev) != hipSuccess || hipDeviceGetAttribute(&cus, hipDeviceAttributeMultiprocessorCount, dev) != hipSuccess) { fprintf(stderr, "kernel_launch: device query failed\n"); grid = -1; return; }
        if (hipFuncSetAttribute((const void*)trunk_fwd, hipFuncAttributeMaxDynamicSharedMemorySize, LDS_BYTES) != hipSuccess) { fprintf(stderr, "kernel_launch: hipFuncSetAttribute failed\n"); grid = -1; return; }
        if (hipOccupancyMaxActiveBlocksPerMultiprocessor(&per_cu, (const void*)trunk_fwd, NTHREADS, LDS_BYTES) != hipSuccess || per_cu < 1)
            fprintf(stderr, "kernel_launch: note: occupancy query reports %d workgroups per CU\n", per_cu);
        (void)hipGetLastError();
        if (cus != 256) { fprintf(stderr, "kernel_launch: built for a 256-CU device (the GEMM epilogues' row-factor tables assume the 256-workgroup unit deal); found %d CUs; nothing launched\n", cus); grid = -1; return; }
        grid = cus;
    }
    if (grid < 0) return;
    if (hipMemsetAsync((char*)d_ws + WS_CTL, 0, CTL_ZERO_BYTES, stream) != hipSuccess) { fprintf(stderr, "kernel_launch: memset failed\n"); return; }
    Args a{};
    for (int i = 0; i < 24; ++i) a.in[i] = (const float*)d_in[i];
    a.out = (float*)d_out; a.ws = (unsigned char*)d_ws;
#if MK_ONE_LAUNCH
    a.ph_lo = 0; a.ph_hi = N_PHASES;
    hipLaunchKernelGGL(trunk_fwd, dim3(grid), dim3(NTHREADS), LDS_BYTES, stream, a);
#else
    for (int p = 0; p < N_PHASES; ++p) { a.ph_lo = p; a.ph_hi = p + 1; hipLaunchKernelGGL(trunk_fwd, dim3(grid), dim3(NTHREADS), LDS_BYTES, stream, a); }
#endif
    const hipError_t le = hipPeekAtLastError();
    if (le != hipSuccess) fprintf(stderr, "kernel_launch: launch failed: %s\n", hipGetErrorName(le));
}
```

```cpp
#include <hip/hip_runtime.h>
#include <cstdio>
#include <cstdint>

#ifndef MK_ONE_LAUNCH
#define MK_ONE_LAUNCH 1
#endif

constexpr int BATCH = 4, SEQ = 4096, DM = 4096, DEPTH = 4, FF = 6144;
constexpr int M = BATCH * SEQ;
constexpr int NH = 16, QL = 896, KVL = 512, NOPE = 128, ROPE = 64, VH = 128, QKD = NOPE + ROPE;
constexpr int QW = NH * QKD;
constexpr int KVW = NH * (NOPE + VH);
constexpr int SSD_P = 64, SSD_H = 32, SSD_G = 8, SSD_N = 128, SSD_W = 2048, CONVD = 4096;
constexpr int INC = 7648, INCP = 7680;
constexpr int O_CQ = 0, O_CKV = 896, O_KPE = 1408, O_Z = 1472, O_XBC = 3520, O_DT = 7616;
constexpr float EPS = 1e-6f;
constexpr int NWAVES = 8, NTHREADS = NWAVES * 64;

constexpr size_t MiB = 1u << 20;
constexpr size_t WS_CTL = 0, CTL_ZERO_BYTES = 3 * MiB;
constexpr size_t WS_SS = 1 * MiB;
constexpr int N_SS = 3 * DEPTH + 1;
static_assert(WS_SS + (size_t)N_SS * M * 8 <= CTL_ZERO_BYTES, "ss arrays inside the memset region");
constexpr size_t WS_COS = 3 * MiB, WS_SIN = 5 * MiB;
constexpr size_t WS_SSQ = 7 * MiB;
constexpr size_t WS_X = 8 * MiB;
constexpr size_t WS_XN = 264 * MiB;
constexpr size_t WS_BIG = 392 * MiB;
constexpr size_t WS_SSP = 632 * MiB;
constexpr size_t WS_KPE = 676 * MiB;
constexpr size_t WS_DT = 678 * MiB;
constexpr size_t WS_XBC = 680 * MiB;
constexpr size_t WS_Q = 808 * MiB;
constexpr size_t WS_KV = 904 * MiB;
constexpr size_t WS_MIX = 1032 * MiB;
constexpr size_t WS_W = 1160 * MiB;
constexpr size_t W_GU1 = 0, W_D1 = 96 * MiB, W_IN = 144 * MiB, W_QU = 204 * MiB, W_KVU = 210 * MiB, W_O = 214 * MiB, W_GU2 = 246 * MiB, W_D2 = 342 * MiB, W_LAYER = 390 * MiB;
constexpr size_t WS_END = WS_W + DEPTH * W_LAYER;
static_assert(WS_BIG + (size_t)M * INCP * 2 <= WS_SSP && WS_SSP + (size_t)M * 64 * 4 <= WS_KPE && WS_XBC + (size_t)M * 4096 * 2 <= WS_Q && WS_Q + (size_t)M * QW * 2 <= WS_KV, "d_ws map");
constexpr int CW_TMO = 0, CW_CODE = 1, CW_BAR = 4096;

constexpr int RING_OFF = 0, RING_BYTES = 131072;
constexpr int LDSCTL_OFF = RING_BYTES, MISC_OFF = LDSCTL_OFF + 320, RSTAB_OFF = LDSCTL_OFF + 1024;
static_assert(RSTAB_OFF + 2048 * 4 <= 147456, "LDS map");
constexpr int LDS_BYTES = 147456;

#define GAS __attribute__((address_space(1)))
#define LAS __attribute__((address_space(3)))
typedef unsigned short bf16;
typedef unsigned v4u __attribute__((ext_vector_type(4)));
typedef unsigned v2u __attribute__((ext_vector_type(2)));
typedef float f32x4 __attribute__((ext_vector_type(4)));
typedef float f32x2 __attribute__((ext_vector_type(2)));
typedef float f32x16 __attribute__((ext_vector_type(16)));
typedef short bf16x8 __attribute__((ext_vector_type(8)));
typedef short s16x4 __attribute__((ext_vector_type(4)));
typedef GAS unsigned gu32;
#define RLX_AGENT __ATOMIC_RELAXED, __HIP_MEMORY_SCOPE_AGENT
#define LDS_WAIT() asm volatile("s_waitcnt lgkmcnt(0)" ::: "memory")
#define VM_WAIT() asm volatile("s_waitcnt vmcnt(0)" ::: "memory")
__device__ __forceinline__ unsigned f2bf(float f) { unsigned u = __builtin_bit_cast(unsigned, f); return (u + 0x7fffu + ((u >> 16) & 1u)) >> 16; }
__device__ __forceinline__ unsigned pk2(float lo, float hi) { return f2bf(lo) | (f2bf(hi) << 16); }
__device__ __forceinline__ float bflo(unsigned w) { return __builtin_bit_cast(float, w << 16); }
__device__ __forceinline__ float bfhi(unsigned w) { return __builtin_bit_cast(float, w & 0xffff0000u); }
__device__ __forceinline__ float bf1(bf16 b) { return __builtin_bit_cast(float, (unsigned)b << 16); }
typedef _Float16 h16x2 __attribute__((ext_vector_type(2)));
__device__ __forceinline__ unsigned pkh2(float lo, float hi) { f32x2 v = {lo, hi}; h16x2 h = __builtin_convertvector(v, h16x2); return __builtin_bit_cast(unsigned, h); }
__device__ __forceinline__ float hlo(unsigned w) { return (float)__builtin_bit_cast(h16x2, w)[0]; }
__device__ __forceinline__ float hhi(unsigned w) { return (float)__builtin_bit_cast(h16x2, w)[1]; }
__device__ __forceinline__ float wave_sum(float v) {
#pragma unroll
    for (int o = 1; o < 64; o <<= 1) v += __shfl_xor(v, o);
    return v;
}
__device__ __forceinline__ float fast_exp(float x) { return __builtin_amdgcn_exp2f(x * 1.4426950408889634f); }
__device__ __forceinline__ float silu_f(float x) { return x * __builtin_amdgcn_rcpf(1.0f + fast_exp(-x)); }
#define XB_TMO      128
#define XB_XCNT(j)  (256  + 64 * (j))
#define XB_XSUB(j)  (1280 + 64 * (j))
#define XB_XGEN(j)  (2304 + 64 * (j))
#define XB_TOP      3328
#define XB_TOPGEN   3392
#define XCD_BAR_WORDS 3456
#define XB_SPIN_CAP (1u << 18)

__device__ __forceinline__ unsigned xb_ld(unsigned* p)              { return __hip_atomic_load(p, __ATOMIC_RELAXED, __HIP_MEMORY_SCOPE_AGENT); }
__device__ __forceinline__ unsigned xb_add(unsigned* p, unsigned v) { return __hip_atomic_fetch_add(p, v, __ATOMIC_RELAXED, __HIP_MEMORY_SCOPE_AGENT); }
__device__ __forceinline__ unsigned xb_xcc_id() { return (unsigned)__builtin_amdgcn_s_getreg((3 << 11) | 20) & 0xFu; }
#define XB_SPIN(cond, bar) do { unsigned _sp = 0; while (cond) { __builtin_amdgcn_s_sleep(1); \
    if ((++_sp & 255u) == 0u) { if (xb_ld(&(bar)[XB_TMO])) break; if (_sp > XB_SPIN_CAP) { atomicAdd(&(bar)[XB_TMO], 1u); break; } } } } while (0)

struct XcdBarrier {
    unsigned* bar; unsigned x;
    volatile LAS unsigned* st;
};

__device__ __forceinline__ XcdBarrier xcd_barrier_post(unsigned* bar, volatile LAS unsigned* st) {
    XcdBarrier b; b.bar = bar; b.x = xb_xcc_id(); b.st = st;
    if (threadIdx.x == 0) (void)xb_add(&bar[XB_XCNT(b.x)], 1u);
    return b;
}
__device__ __forceinline__ void xcd_barrier_complete(unsigned* bar, unsigned x, unsigned& nloc, unsigned& nx) {
    const unsigned G = gridDim.x * gridDim.y * gridDim.z;
    unsigned sum, cnt, mine, sp = 0u;
    for (;;) {
        sum = 0u; cnt = 0u; mine = 0u;
#pragma unroll
        for (unsigned j = 0; j < 16; ++j) { const unsigned c = xb_ld(&bar[XB_XCNT(j)]); sum += c; cnt += (c > 0u) ? 1u : 0u; mine = (j == x) ? c : mine; }
        if (sum == G) break;
        __builtin_amdgcn_s_sleep(1);
        if ((++sp & 255u) == 0u) { if (xb_ld(&bar[XB_TMO])) break; if (sp > XB_SPIN_CAP) { atomicAdd(&bar[XB_TMO], 1u); break; } }
    }
    nloc = mine > 0u ? mine : 1u; nx = cnt > 0u ? cnt : 1u;
}

__device__ __forceinline__ void xcd_barrier(const XcdBarrier& b) {
    asm volatile("s_waitcnt vmcnt(0)" ::: "memory");
    __syncthreads();
    if (threadIdx.x == 0) {
        unsigned* bar = b.bar;
        __builtin_amdgcn_s_waitcnt(0);
        unsigned nloc = b.st[0], nx = b.st[1];
        if (nloc == 0u) { xcd_barrier_complete(bar, b.x, nloc, nx); b.st[0] = nloc; b.st[1] = nx; }
        const unsigned old = xb_add(&bar[XB_XSUB(b.x)], 1u);
        const unsigned gen = old / nloc;
        if (old + 1u == (gen + 1u) * nloc) {
            __builtin_amdgcn_fence(__ATOMIC_RELEASE, "agent");
            asm volatile("s_waitcnt vmcnt(0)" ::: "memory");
            const unsigned og = xb_add(&bar[XB_TOP], 1u);
            const unsigned tg = og / nx;
            if (og + 1u == (tg + 1u) * nx) xb_add(&bar[XB_TOPGEN], 1u);
            else XB_SPIN(xb_ld(&bar[XB_TOPGEN]) == tg, bar);
            __builtin_amdgcn_fence(__ATOMIC_ACQUIRE, "agent");
            xb_add(&bar[XB_XGEN(b.x)], 1u);
            asm volatile("s_waitcnt vmcnt(0)" ::: "memory");
        } else {
            XB_SPIN(xb_ld(&bar[XB_XGEN(b.x)]) == gen, bar);
            __builtin_amdgcn_fence(__ATOMIC_ACQUIRE, "agent");
            asm volatile("s_waitcnt vmcnt(0)" ::: "memory");
        }
    }
    __syncthreads();
}

template <class Work> __device__ __forceinline__ void xcd_barrier_work(const XcdBarrier& b, volatile LAS unsigned* bst, Work&& work) {
    asm volatile("s_waitcnt vmcnt(0)" ::: "memory");
    __syncthreads();
    if (threadIdx.x == 0) {
        unsigned* bar = b.bar;
        __builtin_amdgcn_s_waitcnt(0);
        unsigned nloc = b.st[0], nx = b.st[1];
        if (nloc == 0u) { xcd_barrier_complete(bar, b.x, nloc, nx); b.st[0] = nloc; b.st[1] = nx; }
        const unsigned old = xb_add(&bar[XB_XSUB(b.x)], 1u);
        const unsigned gen = old / nloc;
        if (old + 1u == (gen + 1u) * nloc) {
            __builtin_amdgcn_fence(__ATOMIC_RELEASE, "agent");
            asm volatile("s_waitcnt vmcnt(0)" ::: "memory");
            const unsigned og = xb_add(&bar[XB_TOP], 1u);
            const unsigned tg = og / nx;
            if (og + 1u == (tg + 1u) * nx) xb_add(&bar[XB_TOPGEN], 1u);
            else XB_SPIN(xb_ld(&bar[XB_TOPGEN]) == tg, bar);
            __builtin_amdgcn_fence(__ATOMIC_ACQUIRE, "agent");
            xb_add(&bar[XB_XGEN(b.x)], 1u);
            asm volatile("s_waitcnt vmcnt(0)" ::: "memory");
            bst[0] = 0u;
        } else { bst[0] = 1u; bst[1] = gen; }
    }
    __syncthreads();
    if (bst[0]) {
        unsigned* xg = &b.bar[XB_XGEN(b.x)]; const unsigned gen = bst[1]; unsigned sp = 0u;
        while (xb_ld(xg) == gen) {
            if (work()) continue;
            __builtin_amdgcn_s_sleep(1);
            if ((++sp & 255u) == 0u) { if (xb_ld(&b.bar[XB_TMO])) break; if (sp > XB_SPIN_CAP) { atomicAdd(&b.bar[XB_TMO], 1u); break; } }
        }
        __builtin_amdgcn_fence(__ATOMIC_ACQUIRE, "agent");
        asm volatile("s_waitcnt vmcnt(0)" ::: "memory");
    }
    __syncthreads();
}
namespace pg8 {
#define PG8_LAS __attribute__((address_space(3)))
typedef unsigned short bf16_t;
typedef short bf16x8 __attribute__((ext_vector_type(8)));
typedef float f32x4 __attribute__((ext_vector_type(4)));
typedef unsigned u32x4 __attribute__((ext_vector_type(4)));
typedef _Float16 h16x8 __attribute__((ext_vector_type(8)));
constexpr int BM = 256, BK = 64, HALF = 128, HTB = HALF * BK * 2  , STAGE_BYTES = 8 * HTB, NXCD = 8, WGM = 8;

__host__ __device__ __forceinline__ int lds_byte(int r, int c) { const int st = (r >> 4) * 2 + (c >> 5), rr = r & 15, cc = c & 31, ob = rr * 64 + cc * 2; return st * 1024 + (ob ^ (((ob >> 9) & 1) << 5)); }
__host__ __device__ __forceinline__ void stage_rc(int b, int& R, int& C) { const int st = b / 1024, sb = b % 1024, swz = sb ^ (((sb >> 9) & 1) << 5); R = (st >> 1) * 16 + swz / 64; C = (st & 1) * 32 + (swz % 64) / 2; }
__host__ __device__ __forceinline__ int perm32(int rho) { const int n = rho >> 4, i = rho & 15; return 8 * (i >> 2) + 4 * n + (i & 3); }

struct Unit { int pm, pn; };
struct Gemm { const bf16_t* A; const bf16_t* Bt; int M, N, K, lda, ldb; };

struct StaticOrder {
    int nM, nN, nwg, G, c;
    __host__ __device__ void init(int M, int N, int G_, int c_) { nM = M / BM; nN = N / BM; nwg = nM * nN; G = G_; c = c_; }
    __host__ __device__ bool next(int i, Unit& u) const {
        const long L = (long)i * G + c; if (L >= nwg) return false;
        int wgid = (int)L; { const int q = nwg / NXCD, r = nwg % NXCD, xcd = wgid % NXCD, off = wgid / NXCD; wgid = (xcd < r ? xcd * (q + 1) : r * (q + 1) + (xcd - r) * q) + off; }
        const int nig = WGM * nN, gid = wgid / nig, fm = gid * WGM, gsz = (nM - fm) < WGM ? (nM - fm) : WGM;
        u.pm = fm + ((wgid % nig) % gsz); u.pn = (wgid % nig) / gsz; return true;
    }
    __device__ __forceinline__ void a_ready(const Unit&) const {}
    __device__ __forceinline__ void done(const Unit&) const {}
};

__device__ __forceinline__ unsigned cvt_pk_bf16(float lo, float hi) { unsigned r; asm volatile("v_cvt_pk_bf16_f32 %0, %1, %2" : "=v"(r) : "v"(lo), "v"(hi)); return r; }

__device__ __forceinline__ float row_rstd(const unsigned long long* ss, int row, float inv_n) { return 1.0f / sqrtf((float)ss[row] * (inv_n * 9.5367431640625e-07f) + 1e-6f); }
struct RowFac { const PG8_LAS float* tab;
    __device__ __forceinline__ float get(int row) const { return tab[row]; } };
struct EpiStore {
    static constexpr bool PERM = true, AFTER_DRAIN = false;
    bf16_t* O; int ldc; RowFac rf;
    __device__ __forceinline__ void operator()(const f32x4 (&acc)[2][2][4][2], const Unit& u, int wr, int wc, int fr, int fq) const {
        const int row0 = u.pm * BM + wr * 64 + fr, col0 = u.pn * BM + wc * 32 + 8 * fq;
#pragma unroll
        for (int ai = 0; ai < 2; ++ai)
#pragma unroll
            for (int m = 0; m < 4; ++m) { const int row = row0 + ai * HALF + m * 16; bf16_t* rowp = O + (size_t)row * ldc + col0;
                const float rs = rf.get(row);
#pragma unroll
                for (int bj = 0; bj < 2; ++bj) { const f32x4 v0 = acc[ai][bj][m][0] * rs, v1 = acc[ai][bj][m][1] * rs;
                    u32x4 w; w.x = cvt_pk_bf16(v0[0], v0[1]); w.y = cvt_pk_bf16(v0[2], v0[3]); w.z = cvt_pk_bf16(v1[0], v1[1]); w.w = cvt_pk_bf16(v1[2], v1[3]);
                    *(u32x4*)(rowp + bj * HALF) = w; } }
    }
};
struct EpiSwiGLU {
    static constexpr bool PERM = true, AFTER_DRAIN = false;
    bf16_t* O; int ldc; RowFac rf;
    __device__ __forceinline__ void operator()(const f32x4 (&acc)[2][2][4][2], const Unit& u, int wr, int wc, int fr, int fq) const {
        const int row0 = u.pm * BM + wr * 64 + fr, col0 = u.pn * HALF + wc * 32 + 8 * fq;
#pragma unroll
        for (int ai = 0; ai < 2; ++ai)
#pragma unroll
            for (int m = 0; m < 4; ++m) { const int row = row0 + ai * HALF + m * 16; bf16_t* rowp = O + (size_t)row * ldc + col0;
                const float rs = rf.get(row), c1 = rs * -1.4426950408889634f, irs2 = __builtin_amdgcn_rcpf(rs * rs);
                float t[8], h[8];
#pragma unroll
                for (int n = 0; n < 2; ++n)
#pragma unroll
                    for (int i = 0; i < 4; ++i) { t[n * 4 + i] = __builtin_amdgcn_exp2f(acc[ai][0][m][n][i] * c1); h[n * 4 + i] = acc[ai][0][m][n][i] * acc[ai][1][m][n][i]; }
                __builtin_amdgcn_sched_barrier(0);
#pragma unroll
                for (int k = 0; k < 8; ++k) t[k] = __builtin_amdgcn_rcpf(__builtin_fmaf(t[k], irs2, irs2));
                __builtin_amdgcn_sched_barrier(0);
#pragma unroll
                for (int k = 0; k < 8; ++k) h[k] *= t[k];
                u32x4 w; w.x = cvt_pk_bf16(h[0], h[1]); w.y = cvt_pk_bf16(h[2], h[3]); w.z = cvt_pk_bf16(h[4], h[5]); w.w = cvt_pk_bf16(h[6], h[7]);
                *(u32x4*)rowp = w; }
    }
};
struct EpiResid {
    static constexpr bool PERM = true, AFTER_DRAIN = false;
    bf16_t* xb; unsigned long long* ssn; int ldc; float alpha;
    __device__ __forceinline__ void operator()(const f32x4 (&acc)[2][2][4][2], const Unit& u, int wr, int wc, int fr, int fq) const {
        const int row0 = u.pm * BM + wr * 64 + fr, col0 = u.pn * BM + wc * 32 + 8 * fq;
        u32x4 old[2][4][2];
#pragma unroll
        for (int ai = 0; ai < 2; ++ai)
#pragma unroll
            for (int m = 0; m < 4; ++m)
#pragma unroll
                for (int bj = 0; bj < 2; ++bj) old[ai][m][bj] = *(const u32x4*)(xb + (size_t)(row0 + ai * HALF + m * 16) * ldc + col0 + bj * HALF);
#pragma unroll
        for (int ai = 0; ai < 2; ++ai)
#pragma unroll
            for (int m = 0; m < 4; ++m) { const int row = row0 + ai * HALF + m * 16; bf16_t* rowp = xb + (size_t)row * ldc + col0; float sq = 0.f;
#pragma unroll
                for (int bj = 0; bj < 2; ++bj) { const u32x4 b = old[ai][m][bj];
                    float v[8];
#pragma unroll
                    for (int e = 0; e < 4; ++e) { v[2 * e] = __builtin_bit_cast(float, b[e] << 16) + acc[ai][bj][m][e >> 1][2 * (e & 1)] * alpha;
                                                  v[2 * e + 1] = __builtin_bit_cast(float, b[e] & 0xffff0000u) + acc[ai][bj][m][e >> 1][2 * (e & 1) + 1] * alpha; }
#pragma unroll
                    for (int e = 0; e < 8; ++e) sq += v[e] * v[e];
                    u32x4 w; w.x = cvt_pk_bf16(v[0], v[1]); w.y = cvt_pk_bf16(v[2], v[3]); w.z = cvt_pk_bf16(v[4], v[5]); w.w = cvt_pk_bf16(v[6], v[7]);
                    *(u32x4*)(rowp + bj * HALF) = w; }
                sq += __shfl_xor(sq, 16); sq += __shfl_xor(sq, 32);
                if (fq == 0) __hip_atomic_fetch_add(ssn + row, (unsigned long long)(sq * 1048576.0f + 0.5f), __ATOMIC_RELAXED, __HIP_MEMORY_SCOPE_AGENT); }
    }
};

template <class Epi, class Sched, bool ALIGN_EPI = false, bool SP2 = false, bool F16 = false>
__device__ __forceinline__ void gemm_phase(PG8_LAS unsigned char* lds, const Gemm g, const Sched& S, const Epi& E) {
    __builtin_amdgcn_s_waitcnt(0);
    int tid_l = threadIdx.x; asm volatile("" : "+v"(tid_l));
    const int tid = tid_l, wid = __builtin_amdgcn_readfirstlane(tid >> 6), lane = tid & 63, wr = wid >> 2, wc = wid & 3, fr = lane & 15, fq = lane >> 4;
    const int K = g.K, nt = K / BK, lda = g.lda, ldb = g.ldb;
    unsigned voffA[2], voffB[2];
#pragma unroll
    for (int i = 0; i < 2; ++i) { int R, C; stage_rc(tid * 16 + i * 8192, R, C); const int Rb = Epi::PERM ? ((R & ~31) + perm32(R & 31)) : R;
        voffA[i] = (unsigned)(R * lda + C) * 2u; voffB[i] = (unsigned)(Rb * ldb + C) * 2u; }
    const size_t kstep = (size_t)(BK * 2);
    const size_t hstepA = (size_t)HALF * lda * 2, hstepB = (size_t)HALF * ldb * 2;
    const size_t tstepA = 2 * hstepA, tstepB = 2 * hstepB;
    const unsigned ldsw = (unsigned)wid * 1024u;
    const int aoff = lds_byte(wr * 64 + fr, fq * 8), boff = lds_byte(wc * 32 + fr, fq * 8);
#define PG8_SA(b, h) (((b) * 2 + (h)) * HTB)
#define PG8_SB(b, h) ((4 + (b) * 2 + (h)) * HTB)
#define PG8_STAGE(bufoff, gbase, voff) do { _Pragma("unroll") for (int _i = 0; _i < 2; ++_i) \
        __builtin_amdgcn_global_load_lds((const unsigned*)((const char*)(gbase) + (voff)[_i]), (PG8_LAS unsigned*)(lds + (bufoff) + ldsw + _i * 8192), 16, 0, 0); } while (0)
#define PG8_LDA(dst, b, h) do { _Pragma("unroll") for (int m = 0; m < 4; ++m) _Pragma("unroll") for (int k = 0; k < 2; ++k) dst[m][k] = *(const PG8_LAS bf16x8*)(lds + PG8_SA(b, h) + aoff + m * 2048 + k * 1024); } while (0)
#define PG8_LDB(dst, b, h) do { _Pragma("unroll") for (int n = 0; n < 2; ++n) _Pragma("unroll") for (int k = 0; k < 2; ++k) dst[n][k] = *(const PG8_LAS bf16x8*)(lds + PG8_SB(b, h) + boff + n * 2048 + k * 1024); } while (0)
#define PG8_MMA(ai, bj, At, Bt) do { __builtin_amdgcn_s_setprio(1); _Pragma("unroll") for (int m = 0; m < 4; ++m) _Pragma("unroll") for (int n = 0; n < 2; ++n) _Pragma("unroll") for (int k = 0; k < 2; ++k) \
        acc[ai][bj][m][n] = F16 ? __builtin_amdgcn_mfma_f32_16x16x32_f16(__builtin_bit_cast(h16x8, Bt[n][k]), __builtin_bit_cast(h16x8, At[m][k]), acc[ai][bj][m][n], 0, 0, 0) \
                                : __builtin_amdgcn_mfma_f32_16x16x32_bf16(Bt[n][k], At[m][k], acc[ai][bj][m][n], 0, 0, 0); __builtin_amdgcn_s_setprio(0); } while (0)
#define PG8_WAIT_V(n) asm volatile("s_waitcnt vmcnt(" #n ")" ::: "memory")
#define PG8_WAIT_L(n) asm volatile("s_waitcnt lgkmcnt(" #n ")" ::: "memory")
#define PG8_BAR __builtin_amdgcn_s_barrier()
#define PG8_SCHED __builtin_amdgcn_sched_barrier(0)
    Unit cur, nxt; int ui = 0;
    if (!S.next(0, cur)) return;
    f32x4 acc[2][2][4][2];
#pragma unroll
    for (int a = 0; a < 2; ++a)
#pragma unroll
        for (int b = 0; b < 2; ++b)
#pragma unroll
            for (int m = 0; m < 4; ++m)
#pragma unroll
                for (int n = 0; n < 2; ++n) acc[a][b][m][n] = (f32x4){0.f, 0.f, 0.f, 0.f};
    bf16x8 At[4][2], B0[2][2], B1[2][2];
    const char* cA = (const char*)g.A + (size_t)cur.pm * tstepA; const char* cB = (const char*)g.Bt + (size_t)cur.pn * tstepB;
    S.a_ready(cur);
    if constexpr (SP2) {
        PG8_STAGE(PG8_SB(0, 0), cB, voffB); PG8_STAGE(PG8_SB(0, 1), cB + hstepB, voffB); PG8_STAGE(PG8_SA(0, 0), cA, voffA); PG8_STAGE(PG8_SA(0, 1), cA + hstepA, voffA);
        if (wr == 1) PG8_BAR;
        PG8_WAIT_V(2); PG8_BAR;
        PG8_STAGE(PG8_SB(1, 0), cB + kstep, voffB); PG8_STAGE(PG8_SA(1, 0), cA + kstep, voffA); PG8_STAGE(PG8_SB(1, 1), cB + hstepB + kstep, voffB);
        PG8_WAIT_V(6); PG8_BAR;
    } else {
        PG8_STAGE(PG8_SB(0, 0), cB, voffB); PG8_STAGE(PG8_SA(0, 0), cA, voffA); PG8_STAGE(PG8_SB(0, 1), cB + hstepB, voffB); PG8_STAGE(PG8_SA(0, 1), cA + hstepA, voffA);
        if (wr == 1) PG8_BAR;
        PG8_WAIT_V(4); PG8_BAR;
        PG8_STAGE(PG8_SB(1, 0), cB + kstep, voffB); PG8_STAGE(PG8_SA(1, 0), cA + kstep, voffA); PG8_STAGE(PG8_SB(1, 1), cB + hstepB + kstep, voffB);
        PG8_WAIT_V(6); PG8_BAR;
    }
    for (;;) {
        const bool has_next = S.next(ui + 1, nxt);
        const char* nA = has_next ? (const char*)g.A + (size_t)nxt.pm * tstepA : cA; const char* nB = has_next ? (const char*)g.Bt + (size_t)nxt.pn * tstepB : cB;
        for (int t = 0; t < nt; t += 2) {
            const bool last = (t == nt - 2);
            const char* a1 = cA + (size_t)(t + 1) * kstep;
            const char* a2 = last ? nA : cA + (size_t)(t + 2) * kstep; const char* b2 = last ? nB : cB + (size_t)(t + 2) * kstep;
            const char* a3 = a2 + kstep; const char* b3 = b2 + kstep;
            if (last && has_next) S.a_ready(nxt);
            if constexpr (SP2) {
            PG8_LDB(B0, 0, 0); PG8_LDB(B1, 0, 1); PG8_SCHED; PG8_LDA(At, 0, 0); PG8_STAGE(PG8_SA(1, 1), a1 + hstepA, voffA);
            PG8_WAIT_V(8); PG8_WAIT_L(0); PG8_BAR; PG8_MMA(0, 0, At, B0); PG8_MMA(0, 1, At, B1); PG8_BAR; PG8_SCHED;
            PG8_LDA(At, 0, 1); PG8_STAGE(PG8_SB(0, 0), b2, voffB); PG8_STAGE(PG8_SB(0, 1), b2 + hstepB, voffB); PG8_STAGE(PG8_SA(0, 0), a2, voffA);
            PG8_WAIT_V(8); PG8_WAIT_L(0); PG8_BAR; PG8_MMA(1, 0, At, B0); PG8_MMA(1, 1, At, B1); PG8_BAR; PG8_SCHED;
            PG8_LDB(B0, 1, 0); PG8_LDB(B1, 1, 1); PG8_SCHED; PG8_LDA(At, 1, 0); PG8_STAGE(PG8_SA(0, 1), a2 + hstepA, voffA);
            PG8_WAIT_V(8); PG8_WAIT_L(0); PG8_BAR; PG8_MMA(0, 0, At, B0); PG8_MMA(0, 1, At, B1); PG8_BAR; PG8_SCHED;
            PG8_LDA(At, 1, 1); PG8_STAGE(PG8_SB(1, 0), b3, voffB); PG8_STAGE(PG8_SB(1, 1), b3 + hstepB, voffB); PG8_STAGE(PG8_SA(1, 0), a3, voffA);
            PG8_WAIT_V(8); PG8_WAIT_L(0); PG8_BAR; PG8_MMA(1, 0, At, B0); PG8_MMA(1, 1, At, B1); PG8_BAR; PG8_SCHED;
            } else {
            PG8_LDB(B0, 0, 0); PG8_SCHED; PG8_LDA(At, 0, 0); PG8_STAGE(PG8_SA(1, 1), a1 + hstepA, voffA);
            PG8_WAIT_L(8); PG8_BAR; PG8_WAIT_L(0); PG8_MMA(0, 0, At, B0); PG8_BAR; PG8_SCHED;
            PG8_LDB(B1, 0, 1); PG8_STAGE(PG8_SB(0, 0), b2, voffB);
            PG8_BAR; PG8_WAIT_L(0); PG8_MMA(0, 1, At, B1); PG8_BAR;
            PG8_LDA(At, 0, 1); PG8_STAGE(PG8_SA(0, 0), a2, voffA);
            PG8_BAR; PG8_WAIT_L(0); PG8_MMA(1, 0, At, B0); PG8_BAR; PG8_SCHED;
            PG8_STAGE(PG8_SB(0, 1), b2 + hstepB, voffB);
            PG8_WAIT_V(6); PG8_BAR; PG8_MMA(1, 1, At, B1); PG8_BAR;
            PG8_LDB(B0, 1, 0); PG8_SCHED; PG8_LDA(At, 1, 0); PG8_STAGE(PG8_SA(0, 1), a2 + hstepA, voffA);
            PG8_WAIT_L(8); PG8_BAR; PG8_WAIT_L(0); PG8_MMA(0, 0, At, B0); PG8_BAR; PG8_SCHED;
            PG8_LDB(B1, 1, 1); PG8_STAGE(PG8_SB(1, 0), b3, voffB);
            PG8_BAR; PG8_WAIT_L(0); PG8_MMA(0, 1, At, B1); PG8_BAR;
            PG8_LDA(At, 1, 1); PG8_STAGE(PG8_SA(1, 0), a3, voffA);
            PG8_BAR; PG8_WAIT_L(0); PG8_MMA(1, 0, At, B0); PG8_BAR; PG8_SCHED;
            PG8_STAGE(PG8_SB(1, 1), b3 + hstepB, voffB);
            PG8_WAIT_V(6); PG8_BAR; PG8_MMA(1, 1, At, B1); PG8_BAR;
            }
        }
        if constexpr (ALIGN_EPI) { if (wr == 0) PG8_BAR; }
        if constexpr (!Epi::AFTER_DRAIN) { E(acc, cur, wr, wc, fr, fq); S.done(cur); }
        if (!has_next) break;
#pragma unroll
        for (int a = 0; a < 2; ++a)
#pragma unroll
            for (int b = 0; b < 2; ++b)
#pragma unroll
                for (int m = 0; m < 4; ++m)
#pragma unroll
                    for (int n = 0; n < 2; ++n) acc[a][b][m][n] = (f32x4){0.f, 0.f, 0.f, 0.f};
        cur = nxt; cA = nA; cB = nB; ++ui;
        if constexpr (ALIGN_EPI) { if (wr == 1) PG8_BAR; }
    }
    PG8_WAIT_V(0);
    if constexpr (!ALIGN_EPI) { if (wr == 0) PG8_BAR; }
    PG8_BAR;
    if constexpr (Epi::AFTER_DRAIN) { E.fused(acc, cur, wr, wc, fr, fq, lds, wid, lane); S.done(cur); }
#undef PG8_SA
#undef PG8_SB
#undef PG8_STAGE
#undef PG8_LDA
#undef PG8_LDB
#undef PG8_MMA
#undef PG8_WAIT_V
#undef PG8_WAIT_L
#undef PG8_BAR
#undef PG8_SCHED
}
}
#ifndef PG8_SP2
#define PG8_SP2 true
#endif
#ifndef PG8_ALIGN
#define PG8_ALIGN true
#endif
namespace att {
constexpr int KSTR = 400, VSTR = 320;
constexpr int KBUF = 64 * KSTR, VBUF = 64 * VSTR;
constexpr int OFF_K = 0, OFF_V = 2 * KBUF, OFF_WS = OFF_V + 2 * VBUF, LDS_NEED = OFF_WS + NWAVES * 256;
constexpr float C2 = 0.07216878364870322f * 1.4426950408889634f;
static_assert(LDS_NEED <= RING_BYTES, "attention LDS");
typedef float f32x2_t __attribute__((ext_vector_type(2))); typedef __bf16 bf16x2_t __attribute__((ext_vector_type(2)));
typedef short v4i16_t __attribute__((ext_vector_type(4)));
__device__ __forceinline__ unsigned cvtpk(float lo, float hi) { f32x2_t v = {lo, hi}; bf16x2_t b = __builtin_convertvector(v, bf16x2_t); return __builtin_bit_cast(unsigned, b); }
__device__ __forceinline__ s16x4 trd(const LAS unsigned char* p) { return __builtin_bit_cast(s16x4, __builtin_amdgcn_ds_read_tr16_b64_v4i16((LAS v4i16_t*)p)); }
__device__ __forceinline__ int crow(int r, int hi) { return (r & 3) + 8 * (r >> 2) + 4 * hi; }
#define ATT_MFMA(a, b, c) __builtin_amdgcn_mfma_f32_32x32x16_bf16((a), (b), (c), 0, 0, 0)

__device__ __forceinline__ void attn_block(int b, int h, int qb, const bf16* __restrict__ Q, const bf16* __restrict__ KV, const bf16* __restrict__ KPE, const float* __restrict__ cosT, const float* __restrict__ sinT, bf16* __restrict__ MIXo, LAS unsigned char* lds) {
    int tid_l = threadIdx.x; asm volatile("" : "+v"(tid_l));
    const int tid = tid_l, lane = tid & 63, c = lane & 31, hi = lane >> 5;
    const int wid = __builtin_amdgcn_readfirstlane(tid >> 6);
    const size_t rowbase = (size_t)b * SEQ; const int q0 = qb * 256, qlo = q0 + wid * 32;
    const int NT = 4 * qb + 4;
    const bf16* qrow = Q + (rowbase + qlo + c) * QW + h * QKD + 8 * hi;
    bf16x8 qr[12];
#pragma unroll
    for (int d = 0; d < 12; ++d) qr[d] = *(const bf16x8*)(qrow + 16 * d);
    {
        const float* ct = cosT + (rowbase + qlo + c) * 32 + 4 * hi; const float* st = sinT + (rowbase + qlo + c) * 32 + 4 * hi;
#pragma unroll
        for (int dd = 0; dd < 4; ++dd) { const f32x4 cs = *(const f32x4*)(ct + 8 * dd), sn = *(const f32x4*)(st + 8 * dd);
            v4u w = __builtin_bit_cast(v4u, qr[8 + dd]);
#pragma unroll
            for (int e = 0; e < 4; ++e) { const float x1 = bflo(w[e]), x2 = bfhi(w[e]); w[e] = cvtpk(x1 * cs[e] - x2 * sn[e], x2 * cs[e] + x1 * sn[e]); }
            qr[8 + dd] = __builtin_bit_cast(bf16x8, w); }
    }
    const int kkey = tid >> 4, kch = tid & 15, pkey = tid >> 3, pch = tid & 7;
    const bf16* gk = KV + (rowbase + kkey) * KVW + h * 256 + kch * 8;
    const bf16* gv = gk + 128;
    const bf16* gp = KPE + (rowbase + pkey) * 64 + pch * 8;
    const int lk0 = kkey * KSTR + kch * 16, lk1 = lk0 + 32 * KSTR, lp = pkey * KSTR + 256 + pch * 16;
    const int lv0 = kkey * VSTR + kch * 16, lv1 = lv0 + 32 * VSTR;
    v4u sk0, sk1, sp, sv0, sv1;
#define ATT_LOAD(t) do { const size_t o_ = (size_t)(t) * 64 * KVW; sk0 = *(const v4u*)(gk + o_); sk1 = *(const v4u*)(gk + o_ + 32 * KVW); \
        sv0 = *(const v4u*)(gv + o_); sv1 = *(const v4u*)(gv + o_ + 32 * KVW); sp = *(const v4u*)(gp + (size_t)(t) * 64 * 64); } while (0)
#define ATT_WRITE(bi) do { LAS unsigned char* kb_ = lds + OFF_K + (bi) * KBUF; LAS unsigned char* vb_ = lds + OFF_V + (bi) * VBUF; \
        *(LAS v4u*)(kb_ + lk0) = sk0; *(LAS v4u*)(kb_ + lk1) = sk1; *(LAS v4u*)(kb_ + lp) = sp; *(LAS v4u*)(vb_ + lv0) = sv0; *(LAS v4u*)(vb_ + lv1) = sv1; } while (0)
    LAS float* wsf = (LAS float*)(lds + OFF_WS) + wid * 64;
    float m_run = -1e30f, l_run = 0.f;
    f32x16 o[4];
#pragma unroll
    for (int d0 = 0; d0 < 4; ++d0)
#pragma unroll
        for (int r = 0; r < 16; ++r) o[d0][r] = 0.f;
    const int i16 = lane & 15, qq = i16 >> 2, pp = i16 & 3, blk = (lane >> 4) & 1;
    const int voff = (4 * hi + qq) * VSTR + 32 * blk + 8 * pp;
    const int koff = c * KSTR + hi * 16;
    ATT_LOAD(0); ATT_WRITE(0); __syncthreads();
    for (int t = 0; t < NT; ++t) {
        const int cur = t & 1, kb0 = 64 * t;
        if (t + 1 < NT) ATT_LOAD(t + 1);
        if (kb0 <= qlo + 31) {
            f32x16 p0, p1;
#pragma unroll
            for (int r = 0; r < 16; ++r) { p0[r] = 0.f; p1[r] = 0.f; }
            const LAS unsigned char* kp = lds + OFF_K + cur * KBUF + koff;
#pragma unroll
            for (int dg = 0; dg < 3; ++dg) {
                bf16x8 k0[4], k1[4];
#pragma unroll
                for (int j = 0; j < 4; ++j) { k0[j] = *(const LAS bf16x8*)(kp + (4 * dg + j) * 32); k1[j] = *(const LAS bf16x8*)(kp + 32 * KSTR + (4 * dg + j) * 32); }
                __builtin_amdgcn_sched_barrier(0);
#pragma unroll
                for (int j = 0; j < 4; ++j) { p0 = ATT_MFMA(k0[j], qr[4 * dg + j], p0); p1 = ATT_MFMA(k1[j], qr[4 * dg + j], p1); }
            }
            if (kb0 + 63 > qlo) {
                const int dq = qlo + c - kb0 - 4 * hi; const float NEG = -__builtin_inff();
#pragma unroll
                for (int r = 0; r < 16; ++r) { const int cr = (r & 3) + 8 * (r >> 2); if (cr > dq) p0[r] = NEG; if (cr + 32 > dq) p1[r] = NEG; }
            }
            float mx = p0[0];
#pragma unroll
            for (int r = 1; r < 16; ++r) mx = fmaxf(mx, p0[r]);
#pragma unroll
            for (int r = 0; r < 16; ++r) mx = fmaxf(mx, p1[r]);
            mx = fmaxf(mx, __shfl_xor(mx, 32));
            float mn = m_run, alpha = 1.0f;
            if (!__all((mx - m_run) * C2 <= 6.0f)) { mn = fmaxf(m_run, mx); alpha = __builtin_amdgcn_exp2f((m_run - mn) * C2); m_run = mn; }
            const float mnc = mn * C2;
            float rs = 0.f;
#pragma unroll
            for (int r = 0; r < 16; ++r) { p0[r] = __builtin_amdgcn_exp2f(p0[r] * C2 - mnc); p1[r] = __builtin_amdgcn_exp2f(p1[r] * C2 - mnc); rs += p0[r] + p1[r]; }
            rs += __shfl_xor(rs, 32);
            l_run = l_run * alpha + rs;
            if (__any(alpha < 1.0f)) {
                if (hi == 0) wsf[c] = alpha;
                LDS_WAIT();
#pragma unroll
                for (int r = 0; r < 16; ++r) { const float a = wsf[crow(r, hi)];
#pragma unroll
                    for (int d0 = 0; d0 < 4; ++d0) o[d0][r] *= a; }
            }
            const LAS unsigned char* vp = lds + OFF_V + cur * VBUF + voff;
#pragma unroll
            for (int kb = 0; kb < 2; ++kb)
#pragma unroll
                for (int s = 0; s < 2; ++s) {
                    v4u pw;
                    if (kb == 0) { pw.x = cvtpk(p0[8 * s + 0], p0[8 * s + 1]); pw.y = cvtpk(p0[8 * s + 2], p0[8 * s + 3]); pw.z = cvtpk(p0[8 * s + 4], p0[8 * s + 5]); pw.w = cvtpk(p0[8 * s + 6], p0[8 * s + 7]); }
                    else         { pw.x = cvtpk(p1[8 * s + 0], p1[8 * s + 1]); pw.y = cvtpk(p1[8 * s + 2], p1[8 * s + 3]); pw.z = cvtpk(p1[8 * s + 4], p1[8 * s + 5]); pw.w = cvtpk(p1[8 * s + 6], p1[8 * s + 7]); }
                    const bf16x8 pa = __builtin_bit_cast(bf16x8, pw);
                    s16x4 lo[4], hh[4];
#pragma unroll
                    for (int d0 = 0; d0 < 4; ++d0) { lo[d0] = trd(vp + (32 * kb + 16 * s) * VSTR + 64 * d0); hh[d0] = trd(vp + (32 * kb + 16 * s + 8) * VSTR + 64 * d0); }
                    __builtin_amdgcn_sched_barrier(0);
#pragma unroll
                    for (int d0 = 0; d0 < 4; ++d0) o[d0] = ATT_MFMA(pa, __builtin_shufflevector(lo[d0], hh[d0], 0, 1, 2, 3, 4, 5, 6, 7), o[d0]);
                }
        }
        if (t + 1 < NT) ATT_WRITE(cur ^ 1);
        __syncthreads();
    }
    if (hi == 0) wsf[32 + c] = l_run;
    LDS_WAIT();
    bf16* ob = MIXo + (rowbase + qlo) * 4096 + h * 128 + c;
#pragma unroll
    for (int r = 0; r < 16; ++r) { const int orow = crow(r, hi); const float rl = 1.0f / wsf[32 + orow];
#pragma unroll
        for (int d0 = 0; d0 < 4; ++d0) { const float v = o[d0][r] * rl, vn = __shfl_xor(v, 1);
            if ((c & 1) == 0) *(unsigned*)(ob + (size_t)orow * 4096 + d0 * 32) = pk2(v, vn); } }
    LDS_WAIT();
#undef ATT_LOAD
#undef ATT_WRITE
}
}
namespace ssd {
constexpr int RS = 272;
constexpr int BUF = 128 * RS + 128 * 64 + 2560;
constexpr int OFF_X = 128 * RS, OFF_SC = OFF_X + 128 * 64, OFF_S = 2 * BUF;
constexpr int SC_ACS = 0, SC_DT = 512, SC_ECS = 1024, SC_WEND = 1536, SC_ETOT = 2048, LDS_NEED = OFF_S + 2 * 32 * RS;
static_assert(LDS_NEED <= RING_BYTES && BUF % 16 == 0, "ssd LDS");
constexpr float LOG2E = 1.4426950408889634f;
#define SSD_MFMA(a, b, c) __builtin_amdgcn_mfma_f32_32x32x16_bf16((a), (b), (c), 0, 0, 0)
#define SSD_BAR() do { asm volatile("s_waitcnt lgkmcnt(0)" ::: "memory"); __builtin_amdgcn_s_barrier(); asm volatile("" ::: "memory"); } while (0)

__device__ __forceinline__ void ssd_unit(int unit, const bf16* __restrict__ XBC, const float* __restrict__ DT, const bf16* __restrict__ PROJ, const float* a_log, const float* d_skip,
                                         bf16* __restrict__ MIXo, LAS unsigned char* lds) {
    int tid_l = threadIdx.x; asm volatile("" : "+v"(tid_l));
    const int tid = tid_l, lane = tid & 63, c = lane & 31, hi = lane >> 5;
    const int wid = __builtin_amdgcn_readfirstlane(tid >> 6);
    const int b = unit >> 6, h = (unit >> 1) & 31, ph = unit & 1, g = h >> 2, pcol0 = h * 64 + 32 * ph;
    const float A2 = -expf(a_log[h]) * LOG2E, Dk = d_skip[h];
    const size_t mb = (size_t)b * SEQ;
    LAS unsigned char* Ss = lds + OFF_S;
    const int srow = tid >> 4, sch = tid & 15, xrow = tid >> 2, xch = tid & 3;
    const bf16* gB = XBC + (mb + srow) * 4096 + 2048 + g * 128 + sch * 8;
    const bf16* gX = XBC + (mb + xrow) * 4096 + pcol0 + xch * 8;
    const float* gD = DT + (mb + 2 * lane) * 32 + h;
    const bf16* gCf = XBC + (mb + 32 * (wid & 3) + c) * 4096 + 3072 + g * 128 + 8 * hi;
    const int lcb = srow * RS + sch * 16, lx = OFF_X + xrow * 64 + xch * 16;
    v4u sb0, sb1, sb2, sb3, sx; float sd0 = 0.f, sd1 = 0.f;
#define SSD_LOAD(ch) do { const size_t o_ = (size_t)(ch) * 128 * 4096; \
        sb0 = *(const v4u*)(gB + o_); sb1 = *(const v4u*)(gB + o_ + 32 * 4096); sb2 = *(const v4u*)(gB + o_ + 64 * 4096); sb3 = *(const v4u*)(gB + o_ + 96 * 4096); \
        sx = *(const v4u*)(gX + o_); if (wid == 0) { sd0 = gD[(size_t)(ch) * 128 * 32]; sd1 = gD[(size_t)(ch) * 128 * 32 + 32]; } } while (0)
#define SSD_WRITE(bufp) do { LAS unsigned char* wb_ = (bufp); \
        *(LAS v4u*)(wb_ + lcb) = sb0; *(LAS v4u*)(wb_ + lcb + 32 * RS) = sb1; *(LAS v4u*)(wb_ + lcb + 64 * RS) = sb2; *(LAS v4u*)(wb_ + lcb + 96 * RS) = sb3; \
        *(LAS v4u*)(wb_ + lx) = sx; \
        if (wid == 0) {     \
            LAS float* sc_ = (LAS float*)(wb_ + OFF_SC); \
            const float a0_ = sd0 * A2, a1_ = sd1 * A2, pr_ = a0_ + a1_; float inc_ = pr_; \
            _Pragma("unroll") for (int o_ = 1; o_ < 64; o_ <<= 1) { const float v_ = __shfl_up(inc_, o_); if (lane >= o_) inc_ += v_; } \
            const float cs0_ = inc_ - pr_ + a0_, cs1_ = inc_, tot_ = __shfl(inc_, 63); \
            *(LAS f32x2*)(sc_ + SC_ACS / 4 + 2 * lane) = (f32x2){cs0_, cs1_}; *(LAS f32x2*)(sc_ + SC_DT / 4 + 2 * lane) = (f32x2){sd0, sd1}; \
            *(LAS f32x2*)(sc_ + SC_ECS / 4 + 2 * lane) = (f32x2){__builtin_amdgcn_exp2f(cs0_), __builtin_amdgcn_exp2f(cs1_)}; \
            *(LAS f32x2*)(sc_ + SC_WEND / 4 + 2 * lane) = (f32x2){sd0 * __builtin_amdgcn_exp2f(tot_ - cs0_), sd1 * __builtin_amdgcn_exp2f(tot_ - cs1_)}; \
            if (lane == 63) sc_[SC_ETOT / 4] = __builtin_amdgcn_exp2f(tot_); } } while (0)
    const int i16 = lane & 15, qq = i16 >> 2, pp = i16 & 3, blk = (lane >> 4) & 1;
    f32x16 ST;
#pragma unroll
    for (int r = 0; r < 16; ++r) ST[r] = 0.f;
    bf16x8 cfn[8];
#pragma unroll
    for (int ks = 0; ks < 8; ++ks) cfn[ks] = *(const bf16x8*)(gCf + 16 * ks);
    SSD_LOAD(0); SSD_WRITE(lds);
    for (int i = tid; i < (32 * RS) / 16; i += NTHREADS) *(LAS v4u*)(Ss + i * 16) = (v4u){0u, 0u, 0u, 0u};
    SSD_BAR();
    for (int ch = 0; ch < SEQ / 128; ++ch) {
        const int chn = ch + 1 < SEQ / 128 ? ch + 1 : ch;
        SSD_LOAD(chn);
        const size_t m0 = mb + (size_t)ch * 128;
        LAS unsigned char* cb = lds + (ch & 1) * BUF;
        LAS unsigned char* Bs = cb; LAS unsigned char* Xs = cb + OFF_X;
        LAS float* acs = (LAS float*)(cb + OFF_SC + SC_ACS); LAS float* dtv = (LAS float*)(cb + OFF_SC + SC_DT); LAS float* ecs = (LAS float*)(cb + OFF_SC + SC_ECS);
        LAS float* wend = (LAS float*)(cb + OFF_SC + SC_WEND); LAS float* etot = (LAS float*)(cb + OFF_SC + SC_ETOT);
        if (wid < 4) {
            const int lb = wid;
            unsigned short zr[16];
            { const bf16* zp = PROJ + (m0 + 32 * lb + 4 * hi) * INCP + O_Z + pcol0 + c;
#pragma unroll
              for (int r = 0; r < 16; ++r) zr[r] = zp[(size_t)((r & 3) + 8 * (r >> 2)) * INCP]; }
            bf16x8 cf[8];
#pragma unroll
            for (int ks = 0; ks < 8; ++ks) cf[ks] = cfn[ks];
#pragma unroll
            for (int ks = 0; ks < 8; ++ks) cfn[ks] = *(const bf16x8*)(gCf + (size_t)chn * 128 * 4096 + 16 * ks);
            f32x16 y;
#pragma unroll
            for (int r = 0; r < 16; ++r) y[r] = 0.f;
            { const LAS unsigned char* sp = Ss + (ch & 1) * 32 * RS + c * RS + hi * 16; bf16x8 sf[8];
#pragma unroll
              for (int ks = 0; ks < 8; ++ks) sf[ks] = *(const LAS bf16x8*)(sp + ks * 32);
              __builtin_amdgcn_sched_barrier(0);
#pragma unroll
              for (int ks = 0; ks < 8; ++ks) y = SSD_MFMA(cf[ks], sf[ks], y); }
#pragma unroll
            for (int g4 = 0; g4 < 4; ++g4) { const f32x4 e = *(const LAS f32x4*)(ecs + 32 * lb + 8 * g4 + 4 * hi);
#pragma unroll
                for (int i = 0; i < 4; ++i) y[4 * g4 + i] *= e[i]; }
            const float acl = acs[32 * lb + c];
            for (int sb = 0; sb <= lb; ++sb) {
                f32x16 gt;
#pragma unroll
                for (int r = 0; r < 16; ++r) gt[r] = 0.f;
                const LAS unsigned char* bp = Bs + (32 * sb + c) * RS + hi * 16;
                const LAS unsigned char* xp0 = Xs + (32 * sb + 4 * hi + qq) * 64 + (16 * blk + 4 * pp) * 2;
                const s16x4 xl0 = att::trd(xp0), xh0 = att::trd(xp0 + 8 * 64), xl1 = att::trd(xp0 + 16 * 64), xh1 = att::trd(xp0 + 24 * 64);
#pragma unroll
                for (int kg = 0; kg < 2; ++kg) { bf16x8 bfr[4];
#pragma unroll
                    for (int k4 = 0; k4 < 4; ++k4) bfr[k4] = *(const LAS bf16x8*)(bp + (4 * kg + k4) * 32);
                    __builtin_amdgcn_sched_barrier(0);
#pragma unroll
                    for (int k4 = 0; k4 < 4; ++k4) gt = SSD_MFMA(bfr[k4], cf[4 * kg + k4], gt); }
                const int dl = 32 * (lb - sb) + c - 4 * hi;
#pragma unroll
                for (int gh = 0; gh < 2; ++gh) { f32x4 as4[2], ds4[2];
#pragma unroll
                    for (int g2 = 0; g2 < 2; ++g2) { as4[g2] = *(const LAS f32x4*)(acs + 32 * sb + 8 * (2 * gh + g2) + 4 * hi); ds4[g2] = *(const LAS f32x4*)(dtv + 32 * sb + 8 * (2 * gh + g2) + 4 * hi); }
#pragma unroll
                    for (int g2 = 0; g2 < 2; ++g2) { const int g4 = 2 * gh + g2;
#pragma unroll
                        for (int i = 0; i < 4; ++i) { const float w = __builtin_amdgcn_exp2f(fminf(acl - as4[g2][i], 0.f)) * ds4[g2][i]; gt[4 * g4 + i] = (8 * g4 + i <= dl) ? gt[4 * g4 + i] * w : 0.f; } } }
#pragma unroll
                for (int s2 = 0; s2 < 2; ++s2) {
                    v4u pw; pw.x = att::cvtpk(gt[8 * s2 + 0], gt[8 * s2 + 1]); pw.y = att::cvtpk(gt[8 * s2 + 2], gt[8 * s2 + 3]); pw.z = att::cvtpk(gt[8 * s2 + 4], gt[8 * s2 + 5]); pw.w = att::cvtpk(gt[8 * s2 + 6], gt[8 * s2 + 7]);
                    const s16x4 lo = s2 ? xl1 : xl0, hh = s2 ? xh1 : xh0;
                    y = SSD_MFMA(__builtin_bit_cast(bf16x8, pw), __builtin_shufflevector(lo, hh, 0, 1, 2, 3, 4, 5, 6, 7), y);
                }
            }
            bf16* op = MIXo + (m0 + 32 * lb + 4 * hi) * 4096 + 2048 + pcol0 + c;
            const LAS unsigned short* xl = (const LAS unsigned short*)(Xs + (32 * lb + 4 * hi) * 64 + 2 * c);
            unsigned short xr[16];
#pragma unroll
            for (int r = 0; r < 16; ++r) xr[r] = xl[((r & 3) + 8 * (r >> 2)) * 32];
            __builtin_amdgcn_sched_barrier(0);
#pragma unroll
            for (int r = 0; r < 16; ++r) { const int lr = (r & 3) + 8 * (r >> 2);
                const float v = (y[r] + Dk * bf1(xr[r])) * silu_f(bf1(zr[r]));
                op[(size_t)lr * 4096] = (bf16)f2bf(v); }
        } else {
            const int nb = wid - 4;
            const float et = etot[0];
#pragma unroll
            for (int r = 0; r < 16; ++r) ST[r] *= et;
            const LAS unsigned char* ap = Bs + (8 * hi + qq) * RS + (32 * nb + 16 * blk + 4 * pp) * 2;
            const LAS unsigned char* xp = Xs + (8 * hi + qq) * 64 + (16 * blk + 4 * pp) * 2;
#pragma unroll
            for (int kg = 0; kg < 2; ++kg) {
                s16x4 alo[4], ahh[4], xlo[4], xhh[4]; f32x4 w0[4], w1[4];
#pragma unroll
                for (int k4 = 0; k4 < 4; ++k4) { const int ks = 4 * kg + k4;
                    alo[k4] = att::trd(ap + 16 * ks * RS); ahh[k4] = att::trd(ap + (16 * ks + 4) * RS);
                    xlo[k4] = att::trd(xp + 16 * ks * 64); xhh[k4] = att::trd(xp + (16 * ks + 4) * 64);
                    w0[k4] = *(const LAS f32x4*)(wend + 16 * ks + 8 * hi); w1[k4] = *(const LAS f32x4*)(wend + 16 * ks + 8 * hi + 4); }
                __builtin_amdgcn_sched_barrier(0);
#pragma unroll
                for (int k4 = 0; k4 < 4; ++k4) {
                    v4u xw;
                    xw.x = att::cvtpk(bf1((bf16)xlo[k4][0]) * w0[k4][0], bf1((bf16)xlo[k4][1]) * w0[k4][1]); xw.y = att::cvtpk(bf1((bf16)xlo[k4][2]) * w0[k4][2], bf1((bf16)xlo[k4][3]) * w0[k4][3]);
                    xw.z = att::cvtpk(bf1((bf16)xhh[k4][0]) * w1[k4][0], bf1((bf16)xhh[k4][1]) * w1[k4][1]); xw.w = att::cvtpk(bf1((bf16)xhh[k4][2]) * w1[k4][2], bf1((bf16)xhh[k4][3]) * w1[k4][3]);
                    ST = SSD_MFMA(__builtin_shufflevector(alo[k4], ahh[k4], 0, 1, 2, 3, 4, 5, 6, 7), __builtin_bit_cast(bf16x8, xw), ST);
                }
            }
            LAS unsigned char* so = Ss + ((ch + 1) & 1) * 32 * RS + c * RS + (32 * nb + 4 * hi) * 2;
#pragma unroll
            for (int g4 = 0; g4 < 4; ++g4) { v2u w; w.x = att::cvtpk(ST[4 * g4], ST[4 * g4 + 1]); w.y = att::cvtpk(ST[4 * g4 + 2], ST[4 * g4 + 3]); *(LAS v2u*)(so + g4 * 16) = w; }
        }
        SSD_WRITE(lds + ((ch + 1) & 1) * BUF);
        SSD_BAR();
    }
    VM_WAIT();
#undef SSD_LOAD
#undef SSD_WRITE
}
}
struct Frame {
    LAS unsigned char* lds;
    volatile LAS unsigned* MISC;
    gu32* ctl;
    int wave;
    int vcu, G;
};

__device__ __forceinline__ void row_copy_ss(const float* xrow, bf16* orow, unsigned long long* ss, int lane) {
    const f32x4* xr = (const f32x4*)xrow + lane;
    f32x4 v[16]; float s = 0.f;
#pragma unroll
    for (int j = 0; j < 16; ++j) { v[j] = xr[64 * j]; s += (v[j].x * v[j].x + v[j].y * v[j].y) + (v[j].z * v[j].z + v[j].w * v[j].w); }
    s = wave_sum(s);
    v2u* o8 = (v2u*)orow + lane;
#pragma unroll
    for (int j = 0; j < 16; ++j) { v2u wb; wb.x = pk2(v[j].x, v[j].y); wb.y = pk2(v[j].z, v[j].w); o8[64 * j] = wb; }
    if (lane == 0) *ss = (unsigned long long)(s * 1048576.0f + 0.5f);
}
__device__ __forceinline__ void rms_row_out(const bf16* xrow, const float* gain, float* orow, int lane) {
    const v4u* xr = (const v4u*)xrow + lane; float v[64]; float s = 0.f;
#pragma unroll
    for (int j = 0; j < 8; ++j) { const v4u w = xr[64 * j];
#pragma unroll
        for (int e = 0; e < 4; ++e) { v[8 * j + 2 * e] = bflo(w[e]); v[8 * j + 2 * e + 1] = bfhi(w[e]); s += v[8 * j + 2 * e] * v[8 * j + 2 * e] + v[8 * j + 2 * e + 1] * v[8 * j + 2 * e + 1]; } }
    const float rstd = 1.0f / sqrtf(wave_sum(s) * (1.0f / DM) + EPS);
#pragma unroll
    for (int j = 0; j < 8; ++j) { const f32x4 g0 = *(const f32x4*)(gain + 512 * j + 8 * lane), g1 = *(const f32x4*)(gain + 512 * j + 8 * lane + 4);
        f32x4 o0, o1;
#pragma unroll
        for (int e = 0; e < 4; ++e) { o0[e] = v[8 * j + e] * rstd * g0[e]; o1[e] = v[8 * j + 4 + e] * rstd * g1[e]; }
        *(f32x4*)(orow + 512 * j + 8 * lane) = o0; *(f32x4*)(orow + 512 * j + 8 * lane + 4) = o1; }
}
__device__ __forceinline__ void prep_rows4(int m0, const bf16* PROJ, const float* cosT, const float* sinT, const float* dt_bias, unsigned long long* SSQ, bf16* KPE, float* DT, int lane) {
    v4u w[4][3]; unsigned short dtr[4];
#pragma unroll
    for (int r = 0; r < 4; ++r) { const bf16* pr = PROJ + (size_t)(m0 + r) * INCP;
        w[r][0] = *(const v4u*)(pr + 8 * lane); w[r][1] = *(const v4u*)(pr + 8 * (64 + lane));
        w[r][2] = lane < 56 ? *(const v4u*)(pr + 8 * (128 + lane)) : (v4u){0u, 0u, 0u, 0u};
        dtr[r] = lane < 32 ? pr[O_DT + lane] : (unsigned short)0; }
#pragma unroll
    for (int r = 0; r < 4; ++r) { const int m = m0 + r;
        float s0 = 0.f, s1 = 0.f, s2 = 0.f;
#pragma unroll
        for (int e = 0; e < 4; ++e) { float a = bflo(w[r][0][e]), b = bfhi(w[r][0][e]); s0 += a * a + b * b; a = bflo(w[r][1][e]); b = bfhi(w[r][1][e]); s1 += a * a + b * b; a = bflo(w[r][2][e]); b = bfhi(w[r][2][e]); s2 += a * a + b * b; }
        const float sq = wave_sum(s0 + (lane < 48 ? s1 : 0.f)), sk = wave_sum((lane < 48 ? 0.f : s1) + (lane < 48 ? s2 : 0.f));
        if (lane == 0) { SSQ[m] = (unsigned long long)(sq * 1048576.0f + 0.5f); SSQ[M + m] = (unsigned long long)(sk * 1048576.0f + 0.5f); }
        if (lane >= 48 && lane < 56) {
            const int ip = 4 * (lane - 48); const f32x4 cs = *(const f32x4*)(cosT + (size_t)m * 32 + ip), sn = *(const f32x4*)(sinT + (size_t)m * 32 + ip);
            v4u o;
#pragma unroll
            for (int e = 0; e < 4; ++e) { const float x1 = bflo(w[r][2][e]), x2 = bfhi(w[r][2][e]); o[e] = pk2(x1 * cs[e] - x2 * sn[e], x2 * cs[e] + x1 * sn[e]); }
            *(v4u*)(KPE + (size_t)m * 64 + 2 * ip) = o; }
        if (lane < 32) { const float v = bf1(dtr[r]) + dt_bias[lane]; DT[(size_t)m * 32 + lane] = fmaxf(v, 0.f) + log1pf(expf(-fabsf(v))); }
    }
}
__device__ __forceinline__ void conv_item(int item, const bf16* PROJ, const float* conv_w, const float* conv_b, bf16* XBC, int lane) {
    const int rr = item >> 3, sl = item & 7, ch0 = sl * 512 + lane * 8, m0 = rr * 32, t0 = m0 & (SEQ - 1);
    const bf16* src = PROJ + (size_t)m0 * INCP + O_XBC + ch0;
    bf16* dst = XBC + (size_t)m0 * 4096 + ch0;
    v4u x[35];
#pragma unroll
    for (int i = 0; i < 3; ++i) x[i] = t0 > 0 ? *(const v4u*)(src + (ptrdiff_t)(i - 3) * INCP) : (v4u){0u, 0u, 0u, 0u};
#pragma unroll
    for (int i = 0; i < 32; ++i) x[3 + i] = *(const v4u*)(src + (size_t)i * INCP);
    float w[4][8], bb[8];
#pragma unroll
    for (int k = 0; k < 4; ++k) { const f32x4 a = *(const f32x4*)(conv_w + k * CONVD + ch0), b2 = *(const f32x4*)(conv_w + k * CONVD + ch0 + 4);
#pragma unroll
        for (int e = 0; e < 4; ++e) { w[k][e] = a[e]; w[k][4 + e] = b2[e]; } }
    { const f32x4 a = *(const f32x4*)(conv_b + ch0), b2 = *(const f32x4*)(conv_b + ch0 + 4);
#pragma unroll
      for (int e = 0; e < 4; ++e) { bb[e] = a[e]; bb[4 + e] = b2[e]; } }
#pragma unroll
    for (int i = 0; i < 32; ++i) { v4u o;
#pragma unroll
        for (int e = 0; e < 4; ++e) {
            const float ya = bb[2 * e] + w[0][2 * e] * bflo(x[i][e]) + w[1][2 * e] * bflo(x[i + 1][e]) + w[2][2 * e] * bflo(x[i + 2][e]) + w[3][2 * e] * bflo(x[i + 3][e]);
            const float yc = bb[2 * e + 1] + w[0][2 * e + 1] * bfhi(x[i][e]) + w[1][2 * e + 1] * bfhi(x[i + 1][e]) + w[2][2 * e + 1] * bfhi(x[i + 2][e]) + w[3][2 * e + 1] * bfhi(x[i + 3][e]);
            o[e] = pk2(silu_f(ya), silu_f(yc)); }
        *(v4u*)(dst + (size_t)i * 4096) = o; }
}
template <int NR> __device__ __forceinline__ void gnorm_rows(bf16* row0, size_t rstride, const float* gw, int lane) {
    v4u w[NR][4];
#pragma unroll
    for (int r = 0; r < NR; ++r) { const v4u* p = (const v4u*)(row0 + r * rstride + 32 * lane);
#pragma unroll
        for (int j = 0; j < 4; ++j) w[r][j] = p[j]; }
    const float* g = gw + 32 * lane;
#pragma unroll
    for (int r = 0; r < NR; ++r) { float s = 0.f;
#pragma unroll
        for (int j = 0; j < 4; ++j)
#pragma unroll
            for (int e = 0; e < 4; ++e) { const float a = bflo(w[r][j][e]), b = bfhi(w[r][j][e]); s += a * a + b * b; }
        s += __shfl_xor(s, 1); s += __shfl_xor(s, 2); s += __shfl_xor(s, 4);
        const float rstd = 1.0f / sqrtf(s * (1.0f / 256.0f) + EPS);
        v4u* p = (v4u*)(row0 + r * rstride + 32 * lane);
#pragma unroll
        for (int j = 0; j < 4; ++j) { v4u o;
#pragma unroll
            for (int e = 0; e < 4; ++e) o[e] = pk2(bflo(w[r][j][e]) * rstd * g[8 * j + 2 * e], bfhi(w[r][j][e]) * rstd * g[8 * j + 2 * e + 1]);
            p[j] = o; } }
}
__device__ __forceinline__ void ssd_item(int item, const bf16* XBC, const float* DT, const bf16* PROJ, const float* a_log, const float* d_skip, bf16* MIXo, int lane) {
    const int pi = lane >> 4, ns = lane & 15;
    const int b = item >> 9, h = (item >> 4) & 31, pq = item & 15, g = h >> 2;
    const float A2 = -expf(a_log[h]) * 1.4426950408889634f, Dk = d_skip[h];
    const int pcol = h * 64 + pq * 4 + pi;
    float st[8];
#pragma unroll
    for (int k = 0; k < 8; ++k) st[k] = 0.f;
    const bf16* xb = XBC + (size_t)b * SEQ * 4096; const float* dtp = DT + (size_t)b * SEQ * 32 + h;
    const bf16* zp = PROJ + (size_t)b * SEQ * INCP + O_Z + pcol; bf16* op = MIXo + (size_t)b * SEQ * 4096 + 2048 + pcol;
#pragma unroll 4
    for (int t = 0; t < SEQ; ++t) {
        const bf16* xr = xb + (size_t)t * 4096;
        const float dtv = dtp[(size_t)t * 32];
        const float xv = bf1(xr[pcol]);
        const v4u Bw = *(const v4u*)(xr + 2048 + g * 128 + ns * 8);
        const v4u Cw = *(const v4u*)(xr + 3072 + g * 128 + ns * 8);
        const float zv = bf1(zp[(size_t)t * INCP]);
        const float dA = __builtin_amdgcn_exp2f(dtv * A2), xdt = dtv * xv;
        float part = 0.f;
#pragma unroll
        for (int e = 0; e < 4; ++e) {
            st[2 * e] = dA * st[2 * e] + xdt * bflo(Bw[e]); part += bflo(Cw[e]) * st[2 * e];
            st[2 * e + 1] = dA * st[2 * e + 1] + xdt * bfhi(Bw[e]); part += bfhi(Cw[e]) * st[2 * e + 1]; }
        part += __shfl_xor(part, 1); part += __shfl_xor(part, 2); part += __shfl_xor(part, 4); part += __shfl_xor(part, 8);
        if (ns == 0) op[(size_t)t * 4096] = (bf16)f2bf((part + Dk * xv) * silu_f(zv));
    }
}
__device__ __forceinline__ int dst_row(int kind, int n) {
    if (kind == 1) return ((n >> 7) << 8) + (n & 127);
    if (kind == 2) return ((n >> 7) << 8) + 128 + (n & 127);
    if (kind == 3) { const int hh = n / QKD, j = n - hh * QKD; if (j < NOPE) return n; const int i = j - NOPE; return hh * QKD + NOPE + (i < 32 ? 2 * i : 2 * (i - 32) + 1); }
    if (kind == 4) { if (n < O_KPE || n >= O_KPE + ROPE) return n; const int i = n - O_KPE; return O_KPE + (i < 32 ? 2 * i : 2 * (i - 32) + 1); }
    return n;
}
__device__ __forceinline__ void p0_transpose_item(const float* W, int K, int N, bf16* WT, int kind, const float* gain, LAS float* scr, int item, int lane) {
    const bool f16w = false;
    const int nblk = N / 32, kb = item / nblk, nb = item - kb * nblk, k0 = 64 * kb, n0 = 32 * nb;
    float v[32];
    const float* wp = W + (size_t)(k0 + (lane >> 5)) * N + n0 + (lane & 31);
#pragma unroll
    for (int i = 0; i < 32; ++i) v[i] = wp[(size_t)(2 * i) * N];
    const int c = lane & 7;
    f32x4 g0 = (f32x4){1.f, 1.f, 1.f, 1.f}, g1 = g0;
    if (gain) { g0 = *(const f32x4*)(gain + k0 + 8 * c); g1 = *(const f32x4*)(gain + k0 + 8 * c + 4); }
#pragma unroll
    for (int i = 0; i < 32; ++i) scr[(2 * i + (lane >> 5)) * 33 + (lane & 31)] = v[i];
    LDS_WAIT(); asm volatile("" ::: "memory");
#pragma unroll
    for (int j = 0; j < 4; ++j) { const int n = (lane >> 3) + 8 * j; const LAS float* s = scr + (8 * c) * 33 + n;
        const float e0 = s[0 * 33] * g0[0], e1 = s[1 * 33] * g0[1], e2 = s[2 * 33] * g0[2], e3 = s[3 * 33] * g0[3], e4 = s[4 * 33] * g1[0], e5 = s[5 * 33] * g1[1], e6 = s[6 * 33] * g1[2], e7 = s[7 * 33] * g1[3];
        v4u o; if (f16w) { o.x = pkh2(e0, e1); o.y = pkh2(e2, e3); o.z = pkh2(e4, e5); o.w = pkh2(e6, e7); } else { o.x = pk2(e0, e1); o.y = pk2(e2, e3); o.z = pk2(e4, e5); o.w = pk2(e6, e7); }
        *(v4u*)(WT + (size_t)dst_row(kind, n0 + n) * K + k0 + 8 * c) = o; }
    LDS_WAIT(); asm volatile("" ::: "memory");
}
struct InPtrs { const float* p[24]; };
#ifndef DEFER_D2
#define DEFER_D2 1
#endif
#ifndef DEFER_WO
#define DEFER_WO 1
#endif
constexpr int IT_FFN = (DM / 64) * (FF / 32);
constexpr int IT_IN = (DM / 64) * (INC / 32);
constexpr int IT_QU = (QL / 64) * (QW / 32);
constexpr int IT_KVU = (KVL / 64) * (KVW / 32);
constexpr int IT_O = (DM / 64) * (DM / 32);
constexpr int IT_LAYER = 6 * IT_FFN + IT_IN + IT_QU + IT_KVU + IT_O;
#ifndef QUEUE_CONV
#define QUEUE_CONV 1
#endif
constexpr int NSQ = 64, Q_ITEMS = 2 * IT_FFN, SQ_ITEMS = Q_ITEMS / NSQ, QCTR_WORD = 32768;
static_assert(Q_ITEMS % NSQ == 0 && SQ_ITEMS % 2 == 0, "queue split");
__device__ __forceinline__ bool conv_work(const InPtrs& in, unsigned char* ws, int l, int home, int& tries, LAS float* scr, int lane) {
    while (tries < 4) {
        const int j = (home + tries) & (NSQ - 1);
        unsigned t = 0; if (lane == 0) t = __hip_atomic_fetch_add((unsigned*)(ws + WS_CTL) + QCTR_WORD + 64 * (l * NSQ + j), 1u, __ATOMIC_RELAXED, __HIP_MEMORY_SCOPE_AGENT);
        const int r0 = 2 * (int)__builtin_amdgcn_readfirstlane(t);
        if (r0 < SQ_ITEMS) {
#pragma nounroll
            for (int e = 0; e < 2; ++e) { const int item = j * SQ_ITEMS + r0 + e, up = item >= IT_FFN ? 1 : 0;
                p0_transpose_item((up ? in.p[21] : in.p[20]) + (size_t)l * DM * FF, DM, FF, (bf16*)(ws + WS_W + (size_t)l * W_LAYER + W_GU2), 1 + up, in.p[19] + (size_t)l * DM, scr, item - up * IT_FFN, lane); }
            return true; }
        ++tries;
    }
    return false;
}
__device__ __forceinline__ void p0_prologue(Frame& F, const InPtrs& in, unsigned char* ws, int lane) {
    LAS float* scr = (LAS float*)(F.lds + RING_OFF + F.wave * 16384);
    const int gw = F.vcu * NWAVES + F.wave, NGW = F.G * NWAVES;
    for (int it = gw; it < DEPTH * IT_LAYER; it += NGW) {
        const int l = it / IT_LAYER; int r = it - l * IT_LAYER;
        unsigned char* wl = ws + WS_W + (size_t)l * W_LAYER;
        const size_t lFF = (size_t)l * DM * FF;
        if (r < IT_FFN) { p0_transpose_item(in.p[3] + lFF, DM, FF, (bf16*)(wl + W_GU1), 1, in.p[2] + (size_t)l * DM, scr, r, lane); continue; } r -= IT_FFN;
        if (r < IT_FFN) { p0_transpose_item(in.p[4] + lFF, DM, FF, (bf16*)(wl + W_GU1), 2, in.p[2] + (size_t)l * DM, scr, r, lane); continue; } r -= IT_FFN;
        if (r < IT_FFN) { p0_transpose_item(in.p[5] + lFF, FF, DM, (bf16*)(wl + W_D1), 0, nullptr, scr, r, lane); continue; } r -= IT_FFN;
        if (r < IT_IN) { p0_transpose_item(in.p[7] + (size_t)l * DM * INC, DM, INC, (bf16*)(wl + W_IN), 4, in.p[6] + (size_t)l * DM, scr, r, lane); continue; } r -= IT_IN;
        if (r < IT_QU) { p0_transpose_item(in.p[9] + (size_t)l * QL * QW, QL, QW, (bf16*)(wl + W_QU), 3, in.p[8] + (size_t)l * QL, scr, r, lane); continue; } r -= IT_QU;
        if (r < IT_KVU) { p0_transpose_item(in.p[11] + (size_t)l * KVL * KVW, KVL, KVW, (bf16*)(wl + W_KVU), 0, in.p[10] + (size_t)l * KVL, scr, r, lane); continue; } r -= IT_KVU;
        if (r < IT_O) { if (!(DEFER_WO && F.G == 256)) p0_transpose_item(in.p[18] + (size_t)l * DM * DM, DM, DM, (bf16*)(wl + W_O), 0, nullptr, scr, r, lane); continue; } r -= IT_O;
        if (r < IT_FFN) { if (!(l >= 1 && QUEUE_CONV)) p0_transpose_item(in.p[20] + lFF, DM, FF, (bf16*)(wl + W_GU2), 1, in.p[19] + (size_t)l * DM, scr, r, lane); continue; } r -= IT_FFN;
        if (r < IT_FFN) { if (!(l >= 1 && QUEUE_CONV)) p0_transpose_item(in.p[21] + lFF, DM, FF, (bf16*)(wl + W_GU2), 2, in.p[19] + (size_t)l * DM, scr, r, lane); continue; } r -= IT_FFN;
        if (DEFER_D2) continue;
        p0_transpose_item(in.p[22] + lFF, FF, DM, (bf16*)(wl + W_D2), 0, nullptr, scr, r, lane);
    }
    const int gt = gw * 64 + lane, NGT = NGW * 64;
    for (int i = gt; i < DEPTH * 16384; i += NGT) { const int l = i >> 14, j = i & 16383;
        *(v4u*)(ws + WS_W + (size_t)l * W_LAYER + W_IN + (size_t)INC * DM * 2 + (size_t)j * 16) = (v4u){0u, 0u, 0u, 0u}; }
    const int* pos = (const int*)in.p[1]; float* cosT = (float*)(ws + WS_COS); float* sinT = (float*)(ws + WS_SIN);
    float invf;
    {   const double y = -(double)(lane & 31) * 0.28782313662425575;
        const double kd = __builtin_rint(y * 1.4426950408889634);
        double r = __builtin_fma(-kd, 0.6931471803691238, y); r = __builtin_fma(-kd, 1.9082149292705877e-10, r);
        double e = 1.0;
#pragma unroll
        for (int k = 18; k >= 1; --k) e = 1.0 + e * r * (1.0 / (double)k);
        invf = (float)__builtin_ldexp(e, (int)kd); }
    for (int i = gt; i < M * 32; i += NGT) { const int m = i >> 5;
        const float ang = (float)pos[m] * invf;
        const double x = (double)ang, n = __builtin_rint(x * 0.15915494309189535);
        double r = __builtin_fma(-n, 6.283185307179586, x); r = __builtin_fma(-n, 2.4492935982947064e-16, r);
        const double r2 = r * r; double sn = 1.0, cs = 1.0;
#pragma unroll
        for (int k = 14; k >= 1; --k) { sn = 1.0 - sn * r2 * (1.0 / (double)((2 * k) * (2 * k + 1))); cs = 1.0 - cs * r2 * (1.0 / (double)((2 * k - 1) * (2 * k))); }
        cosT[i] = (float)cs; sinT[i] = (float)(sn * r); }
    for (int m = gw; m < M; m += NGW) row_copy_ss(in.p[0] + (size_t)m * DM, (bf16*)(ws + WS_XN) + (size_t)m * DM, (unsigned long long*)(ws + WS_SS) + m, lane);
}
#ifndef REP_GEMM
#define REP_GEMM 1
#endif
#ifndef REP_RES
#define REP_RES 1
#endif
#ifndef REP_BAR
#define REP_BAR 0
#endif
#ifndef REP_ATT
#define REP_ATT 1
#endif
#ifndef REP_SSD
#define REP_SSD 1
#endif
#ifndef REP_THIN
#define REP_THIN 1
#endif
#ifndef DBG_EN
#define DBG_EN 0xffff
#endif
constexpr int PH_PER_LAYER = 9, N_PHASES = 1 + PH_PER_LAYER * DEPTH + 1;
struct Args { const float* in[24]; float* out; unsigned char* ws; int ph_lo, ph_hi; };
static_assert(sizeof(Args) == 24 * 8 + 16 + 8, "Args has no holes");

__global__ void __launch_bounds__(NTHREADS, 2) trunk_fwd(Args args) {
    extern __shared__ __attribute__((aligned(16))) unsigned char lds[];
    Frame F;
    F.lds = (LAS unsigned char*)lds;
    F.MISC = (volatile LAS unsigned*)(F.lds + MISC_OFF);
    F.wave = __builtin_amdgcn_readfirstlane(threadIdx.x >> 6);
    F.G = gridDim.x; { const int bx = blockIdx.x; F.vcu = (F.G % 8 == 0) ? (bx % 8) * (F.G / 8) + bx / 8 : bx; }
    unsigned char* ws = args.ws;
    F.ctl = (gu32*)(ws + WS_CTL);
    for (int u = threadIdx.x; u < (LDS_BYTES - LDSCTL_OFF) / 4; u += NTHREADS) ((LAS unsigned*)(F.lds + LDSCTL_OFF))[u] = 0u;
    __syncthreads();
    XcdBarrier bar; bar.bar = (unsigned*)(F.ctl + CW_BAR); bar.x = 0; bar.st = nullptr;
    if (MK_ONE_LAUNCH) bar = xcd_barrier_post((unsigned*)(F.ctl + CW_BAR), F.MISC + 8);
#define GRID_BAR() do { if (MK_ONE_LAUNCH) xcd_barrier(bar); } while (0)
    const int lo = args.ph_lo, hi = args.ph_hi;
#define IN(k) (lo <= (k) && (k) < hi)
#ifndef XBAR
#define XBAR 0
#endif
#define SEAM(k) do { if (IN((k) + 1)) { GRID_BAR(); for (int xb_ = 0; xb_ < XBAR; ++xb_) GRID_BAR(); } } while (0)
#define ROWFAC(ssp_, invn_) ({ LAS float* tab_ = (LAS float*)(F.lds + RSTAB_OFF); const int rb_ = 2048 * ((int)blockIdx.x & 7); int t0_ = threadIdx.x; asm volatile("" : "+v"(t0_)); __syncthreads(); \
        for (int r_ = t0_; r_ < 2048; r_ += NTHREADS) tab_[r_] = pg8::row_rstd((ssp_), rb_ + r_, (invn_)); \
        __syncthreads(); pg8::RowFac rf_; rf_.tab = tab_ - rb_; rf_; })
#define LANE_L() ({ int l_ = threadIdx.x; asm volatile("" : "+v"(l_)); l_ & 63; })
#define PH_VARS() const int ln = LANE_L(); int gw_ = F.vcu * NWAVES + F.wave; asm volatile("" : "+s"(gw_)); const int gw = gw_, NGW = F.G * NWAVES; (void)ln; (void)gw; (void)NGW

    bf16* XB = (bf16*)(ws + WS_XN); bf16* HB = (bf16*)(ws + WS_BIG); bf16* PROJ = (bf16*)(ws + WS_BIG);
    bf16* KPE = (bf16*)(ws + WS_KPE); float* DT = (float*)(ws + WS_DT); unsigned long long* SSQ = (unsigned long long*)(ws + WS_SSQ); unsigned long long* SS = (unsigned long long*)(ws + WS_SS);
    bf16* XBC = (bf16*)(ws + WS_XBC); bf16* QB = (bf16*)(ws + WS_Q); bf16* KVB = (bf16*)(ws + WS_KV); bf16* MIX = (bf16*)(ws + WS_MIX);
    const float* cosT = (const float*)(ws + WS_COS); const float* sinT = (const float*)(ws + WS_SIN);

    if ((DBG_EN & 1) && IN(0)) { PH_VARS(); InPtrs ip;
#pragma unroll
        for (int i = 0; i < 24; ++i) ip.p[i] = args.in[i];
        for (int rep = 0; rep < REP_THIN; ++rep) p0_prologue(F, ip, ws, ln); SEAM(0); }

    for (int l = 0; l < DEPTH; ++l) {
        const int pb = 1 + PH_PER_LAYER * l;
        unsigned char* wl = ws + WS_W + (size_t)l * W_LAYER;
        for (int f = 0; f < 2; ++f) {
            if (f == 1) {
                if ((DBG_EN & 4) && IN(pb + 2)) { PH_VARS(); pg8::Gemm g{XB, (const bf16*)(wl + W_IN), M, INCP, DM, DM, DM}; pg8::StaticOrder S; S.init(M, INCP, F.G, (int)blockIdx.x);
                    pg8::EpiStore E{PROJ, INCP, ROWFAC(SS + (size_t)(3 * l + 1) * M, 1.0f / DM)};
                    for (int rep = 0; rep < REP_GEMM; ++rep) { if (REP_BAR && rep) GRID_BAR(); pg8::gemm_phase<pg8::EpiStore, pg8::StaticOrder, PG8_ALIGN, PG8_SP2>(F.lds + RING_OFF, g, S, E); }
                    if (DEFER_D2 && F.G == 256 && blockIdx.x >= 128) {
                        LAS float* scr = (LAS float*)(F.lds + RING_OFF + F.wave * 16384);
                        bf16* wt = (bf16*)(ws + WS_W + (size_t)l * W_LAYER + W_D2); const float* wsrc = args.in[22] + (size_t)l * DM * FF;
                        for (int it = ((int)blockIdx.x - 128) * NWAVES + F.wave; it < IT_FFN; it += 128 * NWAVES) p0_transpose_item(wsrc, FF, DM, wt, 0, nullptr, scr, it, ln);
                        if (DEFER_WO) { bf16* wo = (bf16*)(ws + WS_W + (size_t)l * W_LAYER + W_O); const float* osrc = args.in[18] + (size_t)l * DM * DM;
                            for (int it = ((int)blockIdx.x - 128) * NWAVES + F.wave; it < IT_O; it += 128 * NWAVES) p0_transpose_item(osrc, DM, DM, wo, 0, nullptr, scr, it, ln); }
                        if (DEFER_D2 >= 2) { bf16* wg = (bf16*)(ws + WS_W + (size_t)(l + 1) * W_LAYER + W_GU2); const float* gsrc = args.in[20] + (size_t)(l + 1) * DM * FF; const float* gg = args.in[19] + (size_t)(l + 1) * DM;
                            for (int it = ((int)blockIdx.x - 128) * NWAVES + F.wave; it < IT_FFN; it += 128 * NWAVES) p0_transpose_item(gsrc, DM, FF, wg, 1, gg, scr, it, ln); }
                    } else if (DEFER_D2 && F.G != 256) {
                        LAS float* scr = (LAS float*)(F.lds + RING_OFF + F.wave * 16384);
                        bf16* wt = (bf16*)(ws + WS_W + (size_t)l * W_LAYER + W_D2); const float* wsrc = args.in[22] + (size_t)l * DM * FF;
                        for (int it = gw; it < IT_FFN; it += NGW) p0_transpose_item(wsrc, FF, DM, wt, 0, nullptr, scr, it, ln);
                        if (DEFER_D2 >= 2) { bf16* wg = (bf16*)(ws + WS_W + (size_t)(l + 1) * W_LAYER + W_GU2); const float* gsrc = args.in[20] + (size_t)(l + 1) * DM * FF; const float* gg = args.in[19] + (size_t)(l + 1) * DM;
                            for (int it = gw; it < IT_FFN; it += NGW) p0_transpose_item(gsrc, DM, FF, wg, 1, gg, scr, it, ln); }
                    }
                    SEAM(pb + 2); }
                if ((DBG_EN & 8) && IN(pb + 3)) { PH_VARS();
                    for (int rep = 0; rep < REP_THIN; ++rep) for (int m = 4 * gw; m < M; m += 4 * NGW) prep_rows4(m, PROJ, cosT, sinT, args.in[14] + (size_t)l * SSD_H, SSQ, KPE, DT, ln);
                    for (int rep = 0; rep < REP_THIN; ++rep) for (int it = gw; it < (M / 32) * 8; it += NGW) conv_item(it, PROJ, args.in[12] + (size_t)l * 4 * CONVD, args.in[13] + (size_t)l * CONVD, XBC, ln);
                    SEAM(pb + 3); }
                if ((DBG_EN & 16) && IN(pb + 4)) { PH_VARS();
                    for (int rep = 0; rep < REP_SSD; ++rep) for (int u = F.vcu; u < BATCH * SSD_H * 2; u += F.G) ssd::ssd_unit(u, XBC, DT, PROJ, args.in[15] + (size_t)l * SSD_H, args.in[16] + (size_t)l * SSD_H, MIX, F.lds + RING_OFF);
                    for (int s2 = 0; s2 < 2; ++s2) {
                        const int kk = s2 ? KVL : QL, nn = s2 ? KVW : QW;
                        pg8::Gemm g{PROJ + (s2 ? O_CKV : O_CQ), (const bf16*)(wl + (s2 ? W_KVU : W_QU)), M, nn, kk, INCP, kk}; pg8::StaticOrder S; S.init(M, nn, F.G, (int)blockIdx.x);
                        pg8::EpiStore E{s2 ? KVB : QB, nn, ROWFAC(SSQ + (size_t)s2 * M, 1.0f / (float)kk)};
                        for (int rep = 0; rep < REP_GEMM; ++rep) { if (REP_BAR && rep) GRID_BAR(); pg8::gemm_phase<pg8::EpiStore, pg8::StaticOrder, PG8_ALIGN, PG8_SP2>(F.lds + RING_OFF, g, S, E); } }
                    SEAM(pb + 4); }
                if ((DBG_EN & 32) && IN(pb + 5)) { PH_VARS();
                    for (int rep = 0; rep < REP_ATT; ++rep) for (int u = F.vcu; u < BATCH * NH * 8; u += F.G) { const int bh = u >> 3, xq = u & 7;
                        att::attn_block(bh >> 4, bh & 15, xq, QB, KVB, KPE, cosT, sinT, MIX, F.lds + RING_OFF);
                        att::attn_block(bh >> 4, bh & 15, 15 - xq, QB, KVB, KPE, cosT, sinT, MIX, F.lds + RING_OFF); }
                    { const float* g = args.in[17] + (size_t)l * SSD_W;
                      for (int m = 4 * gw; m < M; m += 4 * NGW) gnorm_rows<4>(MIX + (size_t)m * 4096 + 2048, 4096, g, ln); }
                    SEAM(pb + 5); }
                if ((DBG_EN & 128) && IN(pb + 6)) { PH_VARS(); pg8::Gemm g{MIX, (const bf16*)(wl + W_O), M, DM, DM, DM, DM}; pg8::StaticOrder S; S.init(M, DM, F.G, (int)blockIdx.x);
                    for (int rep = 0; rep < REP_RES; ++rep) { pg8::EpiResid E{XB, rep ? (unsigned long long*)(ws + WS_SSP) : SS + (size_t)(3 * l + 2) * M, DM, rep == 0 ? 1.0f : 0.0f};
                    pg8::gemm_phase<pg8::EpiResid, pg8::StaticOrder, PG8_ALIGN, PG8_SP2>(F.lds + RING_OFF, g, S, E); }
                    SEAM(pb + 6); }
            }
            const int fb = pb + 7 * f;
            if ((DBG_EN & 512) && IN(fb)) { PH_VARS(); pg8::Gemm g{XB, (const bf16*)(wl + (f ? W_GU2 : W_GU1)), M, 2 * FF, DM, DM, DM}; pg8::StaticOrder S; S.init(M, 2 * FF, F.G, (int)blockIdx.x);
                pg8::EpiSwiGLU E{HB, FF, ROWFAC(SS + (size_t)(3 * l + 2 * f) * M, 1.0f / DM)};
                for (int rep = 0; rep < REP_GEMM; ++rep) { if (REP_BAR && rep) GRID_BAR(); pg8::gemm_phase<pg8::EpiSwiGLU, pg8::StaticOrder, PG8_ALIGN, PG8_SP2>(F.lds + RING_OFF, g, S, E); }
                if (IN(fb + 1) && MK_ONE_LAUNCH) {
                    if (QUEUE_CONV && l + 1 < DEPTH) { InPtrs ip;
#pragma unroll
                        for (int i = 0; i < 24; ++i) ip.p[i] = args.in[i];
                        LAS float* scr = (LAS float*)(F.lds + RING_OFF + F.wave * 16384); int tries = 0; const int home = gw & (NSQ - 1);
                        xcd_barrier_work(bar, F.MISC + 12, [&]() -> bool { return conv_work(ip, ws, l + 1, home, tries, scr, ln); }); }
                    else GRID_BAR(); } }
            if ((DBG_EN & 1024) && IN(fb + 1)) { PH_VARS(); pg8::Gemm g{HB, (const bf16*)(wl + (f ? W_D2 : W_D1)), M, DM, FF, FF, FF}; pg8::StaticOrder S; S.init(M, DM, F.G, (int)blockIdx.x);
                for (int rep = 0; rep < REP_RES; ++rep) { pg8::EpiResid E{XB, rep ? (unsigned long long*)(ws + WS_SSP) : SS + (size_t)(3 * l + 2 * f + 1) * M, DM, rep == 0 ? 0.5f : 0.0f};
                pg8::gemm_phase<pg8::EpiResid, pg8::StaticOrder, PG8_ALIGN, PG8_SP2>(F.lds + RING_OFF, g, S, E); }
                if (QUEUE_CONV && f == 1 && l + 1 < DEPTH) { InPtrs ip;
#pragma unroll
                    for (int i = 0; i < 24; ++i) ip.p[i] = args.in[i];
                    LAS float* scr = (LAS float*)(F.lds + RING_OFF + F.wave * 16384); int tries = 0; const int home = gw & (NSQ - 1);
                    while (conv_work(ip, ws, l + 1, home, tries, scr, ln)) {} }
                SEAM(fb + 1); }
        }
    }
    if ((DBG_EN & 2048) && IN(N_PHASES - 1)) { PH_VARS(); for (int m = gw; m < M; m += NGW) rms_row_out(XB + (size_t)m * DM, args.in[23], args.out + (size_t)m * DM, ln); }
#undef IN
#undef SEAM
#undef GRID_BAR
}

extern "C" void kernel_launch(void* const* d_in, const int* in_sizes, int n_in, void* d_out, int out_size, void* d_ws, size_t ws_size, hipStream_t stream) {
    static int grid = 0;
    if (grid == 0) {
        if (n_in != 24 || in_sizes[0] != M * DM || out_size != M * DM || ws_size < WS_END) {
            fprintf(stderr, "kernel_launch: built for 24 inputs, x/out of %d floats, >= %zu bytes of workspace; got n_in %d, in0 %d, out %d, ws %zu; nothing launched\n", M * DM, (size_t)WS_END, n_in, n_in > 0 ? in_sizes[0] : -1, out_size, ws_size);
            grid = -1; return; }
        int dev = 0, cus = 0, per_cu = 0;
        if (hipGetDevice(&dev) != hipSuccess || hipDeviceGetAttribute(&cus, hipDeviceAttributeMultiprocessorCount, dev) != hipSuccess) { fprintf(stderr, "kernel_launch: device query failed\n"); grid = -1; return; }
        if (hipFuncSetAttribute((const void*)trunk_fwd, hipFuncAttributeMaxDynamicSharedMemorySize, LDS_BYTES) != hipSuccess) { fprintf(stderr, "kernel_launch: hipFuncSetAttribute failed\n"); grid = -1; return; }
        if (hipOccupancyMaxActiveBlocksPerMultiprocessor(&per_cu, (const void*)trunk_fwd, NTHREADS, LDS_BYTES) != hipSuccess || per_cu < 1)
            fprintf(stderr, "kernel_launch: note: occupancy query reports %d workgroups per CU\n", per_cu);
        (void)hipGetLastError();
        if (cus != 256) { fprintf(stderr, "kernel_launch: built for a 256-CU device (the GEMM epilogues' row-factor tables assume the 256-workgroup unit deal); found %d CUs; nothing launched\n", cus); grid = -1; return; }
        grid = cus;
    }
    if (grid < 0) return;
    if (hipMemsetAsync((char*)d_ws + WS_CTL, 0, CTL_ZERO_BYTES, stream) != hipSuccess) { fprintf(stderr, "kernel_launch: memset failed\n"); return; }
    Args a{};
    for (int i = 0; i < 24; ++i) a.in[i] = (const float*)d_in[i];
    a.out = (float*)d_out; a.ws = (unsigned char*)d_ws;
#if MK_ONE_LAUNCH
    a.ph_lo = 0; a.ph_hi = N_PHASES;
    hipLaunchKernelGGL(trunk_fwd, dim3(grid), dim3(NTHREADS), LDS_BYTES, stream, a);
#else
    for (int p = 0; p < N_PHASES; ++p) { a.ph_lo = p; a.ph_hi = p + 1; hipLaunchKernelGGL(trunk_fwd, dim3(grid), dim3(NTHREADS), LDS_BYTES, stream, a); }
#endif
    const hipError_t le = hipPeekAtLastError();
    if (le != hipSuccess) fprintf(stderr, "kernel_launch: launch failed: %s\n", hipGetErrorName(le));
}
```
